# Optimizing an MI355X kernel written in HIP

```python
import math
import jax, jax.numpy as jnp
from jax import lax
import numpy as np

D_MODEL = 1024
BATCH = 2
SEQ = 8192
DEPTH = 2
DEC_BATCH = 8
DEC_SEQ = 32
PAST_LEN = 4096

CHUNK = 64
N_EVEN = (DEPTH + 1) // 2
N_ODD = DEPTH // 2
PLE_DIM = 256
D_FF = -(-8 * D_MODEL // (3 * 256)) * 256
DEEPNORM_ALPHA = (2 * DEPTH) ** 0.25
DEEPNORM_BETA = (8 * DEPTH) ** -0.25

POOL_WIDTH = D_MODEL // 2
POOL_WINDOWS = (2, 4, 8, 16)
POOL_GROUP = POOL_WIDTH // len(POOL_WINDOWS)
POOL_HIST = max(POOL_WINDOWS) - 1
CONV_WIDTH = D_MODEL // 2
CONV_K = 3
EVEN_PROJ = POOL_WIDTH + 3 * CONV_WIDTH
SGU_WIDTH = D_MODEL // 2
SGU_BLOCK = 128
SGU_GROUPS = 4
SGU_GDIM = SGU_WIDTH // SGU_GROUPS
SSM_INNER = D_MODEL // 2
SSM_HEADDIM = 64
SSM_HEADS = SSM_INNER // SSM_HEADDIM
SSM_GROUPS = 2
SSM_STATE = 128
SSM_CONV_K = 4
SSM_XBC = SSM_INNER + 2 * SSM_GROUPS * SSM_STATE
ODD_PROJ = 2 * SGU_WIDTH + SSM_INNER + SSM_XBC + SSM_HEADS
MIX_WIDTH = D_MODEL

kernel_name = 'hybrid_pool_conv_sgu_ssd_stream_step'


def layer_norm(x, g, b, eps=1e-5):
    xf = x.astype(jnp.float32)
    mu = jnp.mean(xf, -1, keepdims=True)
    var = jnp.mean(jnp.square(xf - mu), -1, keepdims=True)
    return ((xf - mu) * lax.rsqrt(var + eps) * g + b).astype(x.dtype)


def causal_dw_conv(hist, x, w):
    K, L = w.shape[0], x.shape[1]
    xp = jnp.concatenate([hist.astype(x.dtype), x], axis=1)
    y = w[0] * xp[:, 0:L]
    for k in range(1, K):
        y = y + w[k] * xp[:, k:k + L]
    return y, xp[:, L:]


def pool_mixer(hist, u, pos0, w_grp, scale):
    b, L, c = u.shape
    up = jnp.concatenate([hist.astype(u.dtype), u], axis=1)
    cs = jnp.pad(jnp.cumsum(up.astype(jnp.float32), axis=1), ((0, 0), (1, 0), (0, 0)))
    pos = pos0 + jnp.arange(L)
    uf = u.astype(jnp.float32)
    outs = []
    for gi, win in enumerate(POOL_WINDOWS):
        sl = slice(gi * POOL_GROUP, (gi + 1) * POOL_GROUP)
        end = cs[:, POOL_HIST + 1:POOL_HIST + 1 + L, sl]
        start = cs[:, POOL_HIST + 1 - win:POOL_HIST + 1 - win + L, sl]
        cnt = jnp.minimum(win, pos + 1).astype(jnp.float32)[None, :, None]
        outs.append((end - start) / cnt - uf[..., sl])
    d = jnp.stack(outs, axis=2)
    y = jnp.einsum('blgc,gcd->blgd', d, w_grp.astype(jnp.float32)).reshape(b, L, c) * scale
    return y.astype(u.dtype), up[:, L:]


def short_conv_mixer(hist, b_gate, c_gate, h, w_conv):
    cv, new_hist = causal_dw_conv(hist, c_gate * h, w_conv)
    return b_gate * cv, new_hist


def sgu_mixer(u, v, w_s, b_s, ln_g, ln_b):
    v = layer_norm(v, ln_g, ln_b)
    b, L, _ = u.shape
    blk = min(SGU_BLOCK, L)
    nb = L // blk
    mask = jnp.tril(jnp.ones((blk, blk), bool))
    ws = jnp.where(mask, w_s[:, :blk, :blk], 0.0)
    vb = v.reshape(b, nb, blk, SGU_GROUPS, SGU_GDIM)
    mixed = jnp.einsum('gts,bnsgd->bntgd', ws, vb) + b_s[:, :blk].T[None, None, :, :, None]
    return u * mixed.reshape(b, L, SGU_WIDTH), v


def ssd_scan(x, dt, a, bm, cm, h0):
    f32 = jnp.float32
    b, L, H, P = x.shape
    G, N = bm.shape[2], bm.shape[3]
    R = H // G
    Q = min(CHUNK, L)
    nc = L // Q
    xc = x.astype(f32).reshape(b, nc, Q, G, R, P)
    dtc = dt.astype(f32).reshape(b, nc, Q, G, R)
    bc = bm.astype(f32).reshape(b, nc, Q, G, N)
    cc = cm.astype(f32).reshape(b, nc, Q, G, N)
    acum = jnp.cumsum(dtc * a.reshape(G, R), axis=2)
    causal = jnp.tril(jnp.ones((Q, Q), bool))[:, :, None, None]
    seg = acum[:, :, :, None] - acum[:, :, None, :]
    decay = jnp.exp(jnp.where(causal, seg, -jnp.inf))
    cb = jnp.einsum('bctgn,bcsgn->bctsg', cc, bc)
    m = cb[..., None] * decay * dtc[:, :, None]
    y = jnp.einsum('bctsgr,bcsgrp->bctgrp', m, xc)
    to_end = jnp.exp(acum[:, :, -1:] - acum) * dtc
    s_blk = jnp.einsum('bcsgn,bcsgrp->bcgrpn', bc, xc * to_end[..., None])
    blk_decay = jnp.exp(acum[:, :, -1])

    def step(h, inp):
        s, dcy = inp
        return h * dcy[..., None, None] + s, h

    h_last, h_in = lax.scan(step, h0.astype(f32).reshape(b, G, R, P, N),
                            (jnp.moveaxis(s_blk, 1, 0), jnp.moveaxis(blk_decay, 1, 0)))
    h_in = jnp.moveaxis(h_in, 0, 1)
    y = y + jnp.einsum('bctgn,bcgrpn->bctgrp', cc, h_in) * jnp.exp(acum)[..., None]
    return y.reshape(b, L, H, P), h_last.reshape(b, H, P, N)


def gated_rmsnorm(y, z, w, eps=1e-5):
    g = y * jax.nn.silu(z.astype(jnp.float32))
    gs = g.reshape(*g.shape[:-1], SSM_GROUPS, SSM_INNER // SSM_GROUPS)
    gs = gs * lax.rsqrt(jnp.mean(jnp.square(gs), -1, keepdims=True) + eps)
    return gs.reshape(g.shape) * w


def mamba2_mixer(hist, h0, z, xbc, dt_raw, conv_w, conv_b, dt_bias, a_log, d_skip, norm_w):
    b, L, _ = z.shape
    xc, new_hist = causal_dw_conv(hist, xbc, conv_w)
    xc = jax.nn.silu(xc + conv_b)
    gn = SSM_GROUPS * SSM_STATE
    xs = xc[..., :SSM_INNER].reshape(b, L, SSM_HEADS, SSM_HEADDIM)
    bm = xc[..., SSM_INNER:SSM_INNER + gn].reshape(b, L, SSM_GROUPS, SSM_STATE)
    cm = xc[..., SSM_INNER + gn:].reshape(b, L, SSM_GROUPS, SSM_STATE)
    dt = jax.nn.softplus(dt_raw.astype(jnp.float32) + dt_bias.astype(jnp.float32))
    a = -jnp.exp(a_log.astype(jnp.float32))
    y, h_last = ssd_scan(xs, dt, a, bm, cm, h0)
    y = y + d_skip.astype(jnp.float32)[:, None] * xs.astype(jnp.float32)
    y = gated_rmsnorm(y.reshape(b, L, SSM_INNER), z, norm_w)
    return y.astype(z.dtype), new_hist, h_last.astype(h0.dtype)


def swiglu(x, w1, w3, w2):
    return (jax.nn.silu(x @ w1) * (x @ w3)) @ w2


def trunk(x, ple, pos0, st_pool, st_conv, st_ssm_conv, st_ssm, w):
    new_pool, new_conv, new_v, new_ssm_conv, new_ssm = [], [], [], [], []
    for i in range(DEPTH):
        j = i // 2
        if i % 2 == 0:
            hcat = x @ w['w_in_even'][j]
            a_in = hcat[..., :POOL_WIDTH]
            b_gate = hcat[..., POOL_WIDTH:POOL_WIDTH + CONV_WIDTH]
            c_gate = hcat[..., POOL_WIDTH + CONV_WIDTH:POOL_WIDTH + 2 * CONV_WIDTH]
            h_in = hcat[..., POOL_WIDTH + 2 * CONV_WIDTH:]
            ya, hp = pool_mixer(st_pool[j], a_in, pos0, w['pool_mix_w'][j], w['pool_scale'][j])
            yb, hc = short_conv_mixer(st_conv[j], b_gate, c_gate, h_in, w['conv_w'][j])
            mix = jnp.concatenate([ya, yb], -1) @ w['w_out_even'][j]
            new_pool.append(hp)
            new_conv.append(hc)
        else:
            hcat = x @ w['w_in_odd'][j]
            o1 = 2 * SGU_WIDTH
            o2 = o1 + SSM_INNER
            o3 = o2 + SSM_XBC
            u = jax.nn.gelu(hcat[..., :SGU_WIDTH])
            v = jax.nn.gelu(hcat[..., SGU_WIDTH:o1])
            yc, v_n = sgu_mixer(u, v, w['sgu_w'][j], w['sgu_b'][j], w['sgu_ln_g'][j], w['sgu_ln_b'][j])
            yd, hc, hs = mamba2_mixer(st_ssm_conv[j], st_ssm[j], hcat[..., o1:o2], hcat[..., o2:o3],
                                      hcat[..., o3:], w['ssm_conv_w'][j], w['ssm_conv_b'][j],
                                      w['ssm_dt_bias'][j], w['ssm_a_log'][j], w['ssm_d'][j],
                                      w['ssm_norm_w'][j])
            mix = jnp.concatenate([yc, yd], -1) @ w['w_out_odd'][j]
            new_v.append(v_n)
            new_ssm_conv.append(hc)
            new_ssm.append(hs)
        x = layer_norm(DEEPNORM_ALPHA * x + mix, w['ln1_g'][i], w['ln1_b'][i])
        x = layer_norm(DEEPNORM_ALPHA * x + swiglu(x, w['w_ff1'][i], w['w_ff3'][i], w['w_ff2'][i]),
                       w['ln2_g'][i], w['ln2_b'][i])
        x = x + (ple[i] @ w['w_ple'][i]) * jax.nn.sigmoid(x @ w['w_ple_gate'][i])
    return (x, jnp.stack(new_pool), jnp.stack(new_conv), jnp.stack(new_v),
            jnp.stack(new_ssm_conv), jnp.stack(new_ssm))


def setup_inputs(seed: int = 0) -> dict:
    key = jax.random.key(seed)
    ks = iter(jax.random.split(key, 64))
    f32 = jnp.float32
    NE, NO = N_EVEN, N_ODD

    def nrm(shape, scale):
        return jax.random.normal(next(ks), shape, f32) * scale

    def gain(shape):
        return 1.0 + nrm(shape, 0.02)

    dt0 = jnp.exp(jax.random.uniform(next(ks), (NO, SSM_HEADS), f32, math.log(1e-3), math.log(1e-1)))
    a0 = jax.random.uniform(next(ks), (NO, SSM_HEADS), f32, 1.0, 16.0)
    return {
        'x_prompt': nrm((BATCH, SEQ, D_MODEL), 1.0),
        'x_sample': nrm((DEC_BATCH, DEC_SEQ, D_MODEL), 1.0),
        'p_prompt': nrm((DEPTH, BATCH, SEQ, PLE_DIM), 1.0),
        'p_sample': nrm((DEPTH, DEC_BATCH, DEC_SEQ, PLE_DIM), 1.0),
        'state_pool': nrm((NE, DEC_BATCH, POOL_HIST, POOL_WIDTH), 1.0),
        'state_conv': nrm((NE, DEC_BATCH, CONV_K - 1, CONV_WIDTH), 1.0),
        'state_ssm_conv': nrm((NO, DEC_BATCH, SSM_CONV_K - 1, SSM_XBC), 1.0),
        'state_ssm': nrm((NO, DEC_BATCH, SSM_HEADS, SSM_HEADDIM, SSM_STATE), 0.5),
        'w_in_even': nrm((NE, D_MODEL, EVEN_PROJ), D_MODEL ** -0.5),
        'pool_mix_w': nrm((NE, len(POOL_WINDOWS), POOL_GROUP, POOL_GROUP), POOL_GROUP ** -0.5),
        'pool_scale': 1.0 + nrm((NE, POOL_WIDTH), 0.1),
        'conv_w': nrm((NE, CONV_K, CONV_WIDTH), CONV_K ** -0.5),
        'w_out_even': nrm((NE, MIX_WIDTH, D_MODEL), MIX_WIDTH ** -0.5 * DEEPNORM_BETA),
        'w_in_odd': nrm((NO, D_MODEL, ODD_PROJ), D_MODEL ** -0.5),
        'sgu_w': nrm((NO, SGU_GROUPS, SGU_BLOCK, SGU_BLOCK), SGU_BLOCK ** -0.5),
        'sgu_b': gain((NO, SGU_GROUPS, SGU_BLOCK)),
        'sgu_ln_g': gain((NO, SGU_WIDTH)),
        'sgu_ln_b': nrm((NO, SGU_WIDTH), 0.02),
        'ssm_conv_w': nrm((NO, SSM_CONV_K, SSM_XBC), SSM_CONV_K ** -0.5),
        'ssm_conv_b': nrm((NO, SSM_XBC), 0.02),
        'ssm_dt_bias': dt0 + jnp.log(-jnp.expm1(-dt0)),
        'ssm_a_log': jnp.log(a0),
        'ssm_d': gain((NO, SSM_HEADS)),
        'ssm_norm_w': gain((NO, SSM_INNER)),
        'w_out_odd': nrm((NO, MIX_WIDTH, D_MODEL), MIX_WIDTH ** -0.5 * DEEPNORM_BETA),
        'ln1_g': gain((DEPTH, D_MODEL)),
        'ln1_b': nrm((DEPTH, D_MODEL), 0.02),
        'ln2_g': gain((DEPTH, D_MODEL)),
        'ln2_b': nrm((DEPTH, D_MODEL), 0.02),
        'w_ff1': nrm((DEPTH, D_MODEL, D_FF), D_MODEL ** -0.5),
        'w_ff3': nrm((DEPTH, D_MODEL, D_FF), D_MODEL ** -0.5),
        'w_ff2': nrm((DEPTH, D_FF, D_MODEL), D_FF ** -0.5 * DEEPNORM_BETA),
        'w_ple': nrm((DEPTH, PLE_DIM, D_MODEL), PLE_DIM ** -0.5),
        'w_ple_gate': nrm((DEPTH, D_MODEL, D_MODEL), D_MODEL ** -0.5),
    }


def reference(x_prompt, x_sample, p_prompt, p_sample, state_pool, state_conv, state_ssm_conv, state_ssm,
              w_in_even, pool_mix_w, pool_scale, conv_w, w_out_even,
              w_in_odd, sgu_w, sgu_b, sgu_ln_g, sgu_ln_b, ssm_conv_w, ssm_conv_b, ssm_dt_bias,
              ssm_a_log, ssm_d, ssm_norm_w, w_out_odd,
              ln1_g, ln1_b, ln2_g, ln2_b, w_ff1, w_ff3, w_ff2, w_ple, w_ple_gate):
    w = {
        'w_in_even': w_in_even, 'pool_mix_w': pool_mix_w, 'pool_scale': pool_scale,
        'conv_w': conv_w, 'w_out_even': w_out_even,
        'w_in_odd': w_in_odd, 'sgu_w': sgu_w, 'sgu_b': sgu_b, 'sgu_ln_g': sgu_ln_g, 'sgu_ln_b': sgu_ln_b,
        'ssm_conv_w': ssm_conv_w, 'ssm_conv_b': ssm_conv_b, 'ssm_dt_bias': ssm_dt_bias,
        'ssm_a_log': ssm_a_log, 'ssm_d': ssm_d, 'ssm_norm_w': ssm_norm_w, 'w_out_odd': w_out_odd,
        'ln1_g': ln1_g, 'ln1_b': ln1_b, 'ln2_g': ln2_g, 'ln2_b': ln2_b,
        'w_ff1': w_ff1, 'w_ff3': w_ff3, 'w_ff2': w_ff2, 'w_ple': w_ple, 'w_ple_gate': w_ple_gate,
    }
    bp = x_prompt.shape[0]
    dtp = x_prompt.dtype
    z_pool = jnp.zeros((N_EVEN, bp, POOL_HIST, POOL_WIDTH), dtp)
    z_conv = jnp.zeros((N_EVEN, bp, CONV_K - 1, CONV_WIDTH), dtp)
    z_ssm_conv = jnp.zeros((N_ODD, bp, SSM_CONV_K - 1, SSM_XBC), dtp)
    z_ssm = jnp.zeros((N_ODD, bp, SSM_HEADS, SSM_HEADDIM, SSM_STATE), state_ssm.dtype)
    y_prompt, pool_p, conv_p, _, ssm_conv_p, ssm_p = trunk(
        x_prompt, p_prompt, 0, z_pool, z_conv, z_ssm_conv, z_ssm, w)
    y_sample, pool_s, conv_s, sgu_v_s, ssm_conv_s, ssm_s = trunk(
        x_sample, p_sample, PAST_LEN, state_pool, state_conv, state_ssm_conv, state_ssm, w)
    return (y_prompt, y_sample, pool_p, pool_s, conv_p, conv_s, sgu_v_s, ssm_conv_p, ssm_conv_s, ssm_p, ssm_s)
```

```cpp
#include <hip/hip_runtime.h>
#include <hip/hip_cooperative_groups.h>
#include <cstdio>
#include <cstdint>
namespace cg = cooperative_groups;
namespace pg8 {
#define PG8_LAS __attribute__((address_space(3)))
typedef unsigned short bf16_t;
typedef short bf16x8 __attribute__((ext_vector_type(8)));
typedef float f32x4 __attribute__((ext_vector_type(4)));
typedef unsigned u32x4 __attribute__((ext_vector_type(4)));
constexpr int BM = 256, BK = 64, HALF = 128, HTB = HALF * BK * 2  , STAGE_BYTES = 8 * HTB, NXCD = 8, WGM = 8;

__host__ __device__ __forceinline__ int lds_byte(int r, int c) { const int st = (r >> 4) * 2 + (c >> 5), rr = r & 15, cc = c & 31, ob = rr * 64 + cc * 2; return st * 1024 + (ob ^ (((ob >> 9) & 1) << 5)); }
__host__ __device__ __forceinline__ void stage_rc(int b, int& R, int& C) { const int st = b / 1024, sb = b % 1024, swz = sb ^ (((sb >> 9) & 1) << 5); R = (st >> 1) * 16 + swz / 64; C = (st & 1) * 32 + (swz % 64) / 2; }
__host__ __device__ __forceinline__ int perm32(int rho) { const int n = rho >> 4, i = rho & 15; return 8 * (i >> 2) + 4 * n + (i & 3); }

struct Unit { int pm, pn, ko; };
struct Gemm { const bf16_t* A; const bf16_t* Bt; int M, N, K, KL; };

struct StaticOrder {
    int nM, nN, nwg, G, c;
    __host__ __device__ void init(int M, int N, int G_, int c_) { nM = M / BM; nN = N / BM; nwg = nM * nN; G = G_; c = c_; }
    __host__ __device__ bool next(int i, Unit& u) const {
        const long L = (long)i * G + c; if (L >= nwg) return false;
        int wgid = (int)L; { const int q = nwg / NXCD, r = nwg % NXCD, xcd = wgid % NXCD, off = wgid / NXCD; wgid = (xcd < r ? xcd * (q + 1) : r * (q + 1) + (xcd - r) * q) + off; }
        const int nig = WGM * nN, gid = wgid / nig, fm = gid * WGM, gsz = (nM - fm) < WGM ? (nM - fm) : WGM;
        u.pm = fm + ((wgid % nig) % gsz); u.pn = (wgid % nig) / gsz; u.ko = 0; return true;
    }
    __device__ __forceinline__ void a_ready(const Unit&) const {}
    __device__ __forceinline__ void done(const Unit&) const {}
};
__device__ __forceinline__ unsigned cvt_pk_bf16(float lo, float hi) { unsigned r; asm volatile("v_cvt_pk_bf16_f32 %0, %1, %2" : "=v"(r) : "v"(lo), "v"(hi)); return r; }
template <class Epi, class Sched, bool ALIGN_EPI = false, bool SP2 = false>
__device__ __forceinline__ void gemm_phase(int wid_s, PG8_LAS unsigned char* lds, const Gemm g, const Sched& S, const Epi& E) {
    int lane_ = (int)__builtin_amdgcn_mbcnt_hi(~0u, __builtin_amdgcn_mbcnt_lo(~0u, 0u)); asm volatile("" : "+v"(lane_)); const int wid = wid_s, lane = lane_, tid = wid * 64 + lane, wr = wid >> 2, wc = wid & 3, fr = lane & 15, fq = lane >> 4;
    const int K = g.K, nt = g.KL / BK;
    unsigned voffA[2], voffB[2];
#pragma unroll
    for (int i = 0; i < 2; ++i) { int R, C; stage_rc(tid * 16 + i * 8192, R, C); const int Rb = Epi::PERM ? ((R & ~31) + perm32(R & 31)) : R;
        voffA[i] = (unsigned)(R * K + C) * 2u; voffB[i] = (unsigned)(Rb * K + C) * 2u; }
    const size_t kstep = (size_t)(BK * 2);
    const size_t hstep = (size_t)HALF * K * 2;
    const size_t tstep = 2 * hstep;
    const unsigned ldsw = (unsigned)wid * 1024u;
    const int aoff = lds_byte(wr * 64 + fr, fq * 8), boff = lds_byte(wc * 32 + fr, fq * 8);
#define PG8_SA(b, h) (((b) * 2 + (h)) * HTB)
#define PG8_SB(b, h) ((4 + (b) * 2 + (h)) * HTB)
#define PG8_STAGE(bufoff, gbase, voff) do { _Pragma("unroll") for (int _i = 0; _i < 2; ++_i) \
        __builtin_amdgcn_global_load_lds((const unsigned*)((const char*)(gbase) + (voff)[_i]), (PG8_LAS unsigned*)(lds + (bufoff) + ldsw + _i * 8192), 16, 0, 0); } while (0)
#define PG8_LDA(dst, b, h) do { _Pragma("unroll") for (int m = 0; m < 4; ++m) _Pragma("unroll") for (int k = 0; k < 2; ++k) dst[m][k] = *(const PG8_LAS bf16x8*)(lds + PG8_SA(b, h) + aoff + m * 2048 + k * 1024); } while (0)
#define PG8_LDB(dst, b, h) do { _Pragma("unroll") for (int n = 0; n < 2; ++n) _Pragma("unroll") for (int k = 0; k < 2; ++k) dst[n][k] = *(const PG8_LAS bf16x8*)(lds + PG8_SB(b, h) + boff + n * 2048 + k * 1024); } while (0)
#define PG8_MMA(ai, bj, At, Bt) do { __builtin_amdgcn_s_setprio(1); _Pragma("unroll") for (int m = 0; m < 4; ++m) _Pragma("unroll") for (int n = 0; n < 2; ++n) _Pragma("unroll") for (int k = 0; k < 2; ++k) \
        acc[ai][bj][m][n] = __builtin_amdgcn_mfma_f32_16x16x32_bf16(Bt[n][k], At[m][k], acc[ai][bj][m][n], 0, 0, 0); __builtin_amdgcn_s_setprio(0); } while (0)
#define PG8_WAIT_V(n) asm volatile("s_waitcnt vmcnt(" #n ")" ::: "memory")
#define PG8_WAIT_L(n) asm volatile("s_waitcnt lgkmcnt(" #n ")" ::: "memory")
#define PG8_BAR __builtin_amdgcn_s_barrier()
#define PG8_SCHED __builtin_amdgcn_sched_barrier(0)
    Unit cur, nxt; int ui = 0;
    if (!S.next(0, cur)) return;
    f32x4 acc[2][2][4][2];
#pragma unroll
    for (int a = 0; a < 2; ++a)
#pragma unroll
        for (int b = 0; b < 2; ++b)
#pragma unroll
            for (int m = 0; m < 4; ++m)
#pragma unroll
                for (int n = 0; n < 2; ++n) acc[a][b][m][n] = (f32x4){0.f, 0.f, 0.f, 0.f};
    bf16x8 At[4][2], B0[2][2], B1[2][2];
    const char* cA = (const char*)g.A + (size_t)cur.pm * tstep + (size_t)cur.ko * 2; const char* cB = (const char*)g.Bt + (size_t)cur.pn * tstep + (size_t)cur.ko * 2;
    S.a_ready(cur);
    if constexpr (SP2) {
        PG8_STAGE(PG8_SB(0, 0), cB, voffB); PG8_STAGE(PG8_SB(0, 1), cB + hstep, voffB); PG8_STAGE(PG8_SA(0, 0), cA, voffA); PG8_STAGE(PG8_SA(0, 1), cA + hstep, voffA);
        if (wr == 1) PG8_BAR;
        PG8_WAIT_V(2); PG8_BAR;
        PG8_STAGE(PG8_SB(1, 0), cB + kstep, voffB); PG8_STAGE(PG8_SA(1, 0), cA + kstep, voffA); PG8_STAGE(PG8_SB(1, 1), cB + hstep + kstep, voffB);
        PG8_WAIT_V(6); PG8_BAR;
    } else {
        PG8_STAGE(PG8_SB(0, 0), cB, voffB); PG8_STAGE(PG8_SA(0, 0), cA, voffA); PG8_STAGE(PG8_SB(0, 1), cB + hstep, voffB); PG8_STAGE(PG8_SA(0, 1), cA + hstep, voffA);
        if (wr == 1) PG8_BAR;
        PG8_WAIT_V(4); PG8_BAR;
        PG8_STAGE(PG8_SB(1, 0), cB + kstep, voffB); PG8_STAGE(PG8_SA(1, 0), cA + kstep, voffA); PG8_STAGE(PG8_SB(1, 1), cB + hstep + kstep, voffB);
        PG8_WAIT_V(6); PG8_BAR;
    }
    for (;;) {
        const bool has_next = S.next(ui + 1, nxt);
        const char* nA = has_next ? (const char*)g.A + (size_t)nxt.pm * tstep + (size_t)nxt.ko * 2 : cA; const char* nB = has_next ? (const char*)g.Bt + (size_t)nxt.pn * tstep + (size_t)nxt.ko * 2 : cB;
        for (int t = 0; t < nt; t += 2) {
            const bool last = (t == nt - 2);
            const char* a1 = cA + (size_t)(t + 1) * kstep;
            const char* a2 = last ? nA : cA + (size_t)(t + 2) * kstep; const char* b2 = last ? nB : cB + (size_t)(t + 2) * kstep;
            const char* a3 = a2 + kstep; const char* b3 = b2 + kstep;
            if (last && has_next) S.a_ready(nxt);
            if constexpr (SP2) {
            PG8_LDB(B0, 0, 0); PG8_LDB(B1, 0, 1); PG8_SCHED; PG8_LDA(At, 0, 0); PG8_STAGE(PG8_SA(1, 1), a1 + hstep, voffA);
            PG8_WAIT_V(8); PG8_WAIT_L(0); PG8_BAR; PG8_MMA(0, 0, At, B0); PG8_MMA(0, 1, At, B1); PG8_BAR; PG8_SCHED;
            PG8_LDA(At, 0, 1); PG8_STAGE(PG8_SB(0, 0), b2, voffB); PG8_STAGE(PG8_SB(0, 1), b2 + hstep, voffB); PG8_STAGE(PG8_SA(0, 0), a2, voffA);
            PG8_WAIT_V(8); PG8_WAIT_L(0); PG8_BAR; PG8_MMA(1, 0, At, B0); PG8_MMA(1, 1, At, B1); PG8_BAR; PG8_SCHED;
            PG8_LDB(B0, 1, 0); PG8_LDB(B1, 1, 1); PG8_SCHED; PG8_LDA(At, 1, 0); PG8_STAGE(PG8_SA(0, 1), a2 + hstep, voffA);
            PG8_WAIT_V(8); PG8_WAIT_L(0); PG8_BAR; PG8_MMA(0, 0, At, B0); PG8_MMA(0, 1, At, B1); PG8_BAR; PG8_SCHED;
            PG8_LDA(At, 1, 1); PG8_STAGE(PG8_SB(1, 0), b3, voffB); PG8_STAGE(PG8_SB(1, 1), b3 + hstep, voffB); PG8_STAGE(PG8_SA(1, 0), a3, voffA);
            PG8_WAIT_V(8); PG8_WAIT_L(0); PG8_BAR; PG8_MMA(1, 0, At, B0); PG8_MMA(1, 1, At, B1); PG8_BAR; PG8_SCHED;
            } else {
            PG8_LDB(B0, 0, 0); PG8_SCHED; PG8_LDA(At, 0, 0); PG8_STAGE(PG8_SA(1, 1), a1 + hstep, voffA);
            PG8_WAIT_L(8); PG8_BAR; PG8_WAIT_L(0); PG8_MMA(0, 0, At, B0); PG8_BAR; PG8_SCHED;
            PG8_LDB(B1, 0, 1); PG8_STAGE(PG8_SB(0, 0), b2, voffB);
            PG8_BAR; PG8_WAIT_L(0); PG8_MMA(0, 1, At, B1); PG8_BAR;
            PG8_LDA(At, 0, 1); PG8_STAGE(PG8_SA(0, 0), a2, voffA);
            PG8_BAR; PG8_WAIT_L(0); PG8_MMA(1, 0, At, B0); PG8_BAR; PG8_SCHED;
            PG8_STAGE(PG8_SB(0, 1), b2 + hstep, voffB);
            PG8_WAIT_V(6); PG8_BAR; PG8_MMA(1, 1, At, B1); PG8_BAR;
            PG8_LDB(B0, 1, 0); PG8_SCHED; PG8_LDA(At, 1, 0); PG8_STAGE(PG8_SA(0, 1), a2 + hstep, voffA);
            PG8_WAIT_L(8); PG8_BAR; PG8_WAIT_L(0); PG8_MMA(0, 0, At, B0); PG8_BAR; PG8_SCHED;
            PG8_LDB(B1, 1, 1); PG8_STAGE(PG8_SB(1, 0), b3, voffB);
            PG8_BAR; PG8_WAIT_L(0); PG8_MMA(0, 1, At, B1); PG8_BAR;
            PG8_LDA(At, 1, 1); PG8_STAGE(PG8_SA(1, 0), a3, voffA);
            PG8_BAR; PG8_WAIT_L(0); PG8_MMA(1, 0, At, B0); PG8_BAR; PG8_SCHED;
            PG8_STAGE(PG8_SB(1, 1), b3 + hstep, voffB);
            PG8_WAIT_V(6); PG8_BAR; PG8_MMA(1, 1, At, B1); PG8_BAR;
            }
        }
        if constexpr (ALIGN_EPI) { if (wr == 0) PG8_BAR; }
        if constexpr (!Epi::AFTER_DRAIN) { E(acc, cur, wr, wc, fr, fq); S.done(cur); }
        if (!has_next) break;
#pragma unroll
        for (int a = 0; a < 2; ++a)
#pragma unroll
            for (int b = 0; b < 2; ++b)
#pragma unroll
                for (int m = 0; m < 4; ++m)
#pragma unroll
                    for (int n = 0; n < 2; ++n) acc[a][b][m][n] = (f32x4){0.f, 0.f, 0.f, 0.f};
        cur = nxt; cA = nA; cB = nB; ++ui;
        if constexpr (ALIGN_EPI) { if (wr == 1) PG8_BAR; }
    }
    PG8_WAIT_V(0);
    if constexpr (!ALIGN_EPI) { if (wr == 0) PG8_BAR; }
    PG8_BAR;
    if constexpr (Epi::AFTER_DRAIN) { E.fused(acc, cur, wr, wc, fr, fq, lds, wid, lane); S.done(cur); }
#undef PG8_SA
#undef PG8_SB
#undef PG8_STAGE
#undef PG8_LDA
#undef PG8_LDB
#undef PG8_MMA
#undef PG8_WAIT_V
#undef PG8_WAIT_L
#undef PG8_BAR
#undef PG8_SCHED
}
}

#define LAS __attribute__((address_space(3)))
typedef unsigned short bf16_t;
typedef short bf16x8 __attribute__((ext_vector_type(8)));
typedef float f32x4 __attribute__((ext_vector_type(4)));
typedef unsigned u32x4 __attribute__((ext_vector_type(4)));
typedef unsigned u32x2 __attribute__((ext_vector_type(2)));

constexpr int D = 1024, MP = 16384, MSAMP = 256, MT = MP + MSAMP, SEQ = 8192, FF = 2816;
constexpr int NH0 = 2048, NH1 = 2560, NINO = 2816;
constexpr float ALPHA = 1.41421356237f, LN_EPS = 1e-5f;
constexpr size_t MiB = 1u << 20;
constexpr size_t WS_CTL = 0, CTL_BYTES = 1 * MiB;
constexpr size_t WS_CS13 = 64 * 1024, WS_CB13 = 112 * 1024, WS_CSG = 160 * 1024, WS_CBG = 168 * 1024, WS_STATS = 256 * 1024;
static_assert(WS_STATS + 4 * 2 * 16640 * 4 <= CTL_BYTES, "ctl map");
constexpr size_t WS_WINE = 1 * MiB, WS_WOUTE = 5 * MiB, WS_WINO = 7 * MiB, WS_WOUTO = 12 * MiB + MiB / 2;
constexpr size_t WS_W13 = 14 * MiB + MiB / 2, W13_BYTES = 11 * MiB;
constexpr size_t WS_W2 = 36 * MiB + MiB / 2, W2_BYTES = 5 * MiB + MiB / 2;
constexpr size_t WS_WG = 47 * MiB + MiB / 2, WG_BYTES = 2 * MiB;
constexpr size_t WS_WPLE = 51 * MiB + MiB / 2, WPLE_BYTES = MiB / 2;
constexpr size_t WS_WPOOL = 52 * MiB + MiB / 2, WS_WSGU = WS_WPOOL + 131072;
constexpr size_t WS_PLEB = 53 * MiB;
constexpr size_t WS_XB = 61 * MiB + MiB / 4, ACT_BYTES = (size_t)MT * D * 2;
constexpr size_t WS_PB = WS_XB + ACT_BYTES, WS_MIX = WS_PB + ACT_BYTES, WS_REGA = WS_MIX + ACT_BYTES;
constexpr size_t WS_DT = WS_REGA + 82 * MiB, WS_SSAMP = WS_REGA + 83 * MiB, WS_DEC = WS_REGA + 86 * MiB;
constexpr size_t WS_END = WS_REGA + (size_t)MT * FF * 2, WS_SLAB4 = WS_END, WS_END2 = WS_END + 4 * MiB;
static_assert(WS_END2 <= 256 * MiB, "ws map");
static_assert(WS_DEC + 264 * 8 * 4 <= WS_END, "ws map tail");
constexpr size_t O_Y = 0, O_POOLP = 17039360, O_POOLS = 17054720, O_CONVP = 17116160, O_CONVS = 17118208, O_SGUV = 17126400,
                 O_SCP = 17257472, O_SCS = 17263616, O_SSMP = 17288192, O_SSMS = 17419264;
constexpr int LDS_BYTES = 147456;

struct Params { const float* in[34]; float* out; unsigned char* ws; };
#define CAS __attribute__((address_space(4)))
#if defined(__HIP_DEVICE_COMPILE__)
__device__ __forceinline__ const CAS Params& kargs() { const CAS Params* k = (const CAS Params*)__builtin_amdgcn_kernarg_segment_ptr(); asm volatile("" : "+s"(k)); return *k; }
#else
__device__ const CAS Params& kargs();
#endif
enum { I_XP = 0, I_XS, I_PP, I_PS, I_STPOOL, I_STCONV, I_STSSMCONV, I_STSSM, I_WINE, I_POOLW, I_POOLSC, I_CONVW, I_WOUTE, I_WINO, I_SGUW, I_SGUB, I_SGULNG, I_SGULNB,
       I_SSMCW, I_SSMCB, I_DTB, I_ALOG, I_SSMD, I_SSMNW, I_WOUTO, I_LN1G, I_LN1B, I_LN2G, I_LN2B, I_FF1, I_FF3, I_FF2, I_WPLE, I_WGATE };

__device__ __forceinline__ float bf2f(unsigned b) { return __uint_as_float(b << 16); }
__device__ __forceinline__ unsigned f2bf(float f) { unsigned u = __float_as_uint(f); return (u + 0x7fffu + ((u >> 16) & 1u)) >> 16; }
__device__ __forceinline__ unsigned pk2(float lo, float hi) { return f2bf(lo) | (f2bf(hi) << 16); }
__device__ __forceinline__ void unpack8(const u32x4 w, float (&v)[8]) {
    v[0] = bf2f(w.x & 0xffffu); v[1] = __uint_as_float(w.x & 0xffff0000u); v[2] = bf2f(w.y & 0xffffu); v[3] = __uint_as_float(w.y & 0xffff0000u);
    v[4] = bf2f(w.z & 0xffffu); v[5] = __uint_as_float(w.z & 0xffff0000u); v[6] = bf2f(w.w & 0xffffu); v[7] = __uint_as_float(w.w & 0xffff0000u); }
__device__ __forceinline__ u32x4 pack8(const float (&v)[8]) { u32x4 w; w.x = pk2(v[0], v[1]); w.y = pk2(v[2], v[3]); w.z = pk2(v[4], v[5]); w.w = pk2(v[6], v[7]); return w; }
__device__ __forceinline__ void load8bf(const bf16_t* p, float (&v)[8]) { unpack8(*(const u32x4*)p, v); }
__device__ __forceinline__ void load8f(const float* p, float (&v)[8]) { const f32x4 a = *(const f32x4*)p, b = *(const f32x4*)(p + 4); v[0] = a.x; v[1] = a.y; v[2] = a.z; v[3] = a.w; v[4] = b.x; v[5] = b.y; v[6] = b.z; v[7] = b.w; }
__device__ __forceinline__ float sigmoidf_(float x) { return __builtin_amdgcn_rcpf(1.0f + __expf(-x)); }
__device__ __forceinline__ float siluf_(float x) { return x * sigmoidf_(x); }
__device__ __forceinline__ float geluf_(float x) { const float y = 0.7978845608f * (x + 0.044715f * x * x * x); return x * sigmoidf_(2.0f * y); }
__device__ __forceinline__ float softplusf_(float x) { return x > 20.f ? x : log1pf(__expf(x)); }
__device__ __forceinline__ float wave_sum(float v) {
#pragma unroll
    for (int o = 1; o < 64; o <<= 1) v += __shfl_xor(v, o);
    return v; }
__device__ __forceinline__ f32x4 mfma16(bf16x8 a, bf16x8 b, f32x4 c) { return __builtin_amdgcn_mfma_f32_16x16x32_bf16(a, b, c, 0, 0, 0); }
#define LDS_WAIT() asm volatile("s_waitcnt lgkmcnt(0)" ::: "memory")
__device__ __forceinline__ int swz(int row, int col) { return col ^ (((row >> 3) & 7) << 3); }
__device__ __forceinline__ int lane_id_() { int l = (int)__builtin_amdgcn_mbcnt_hi(~0u, __builtin_amdgcn_mbcnt_lo(~0u, 0u)); asm volatile("" : "+v"(l)); return l; }
#define TIDX (wid_s * 64 + lane_id_())

namespace pg8 {
struct EpiStore { static constexpr bool PERM = true, AFTER_DRAIN = false;
    bf16_t* O; int ldc; int dt_pn; float* DT;
    __device__ __forceinline__ void operator()(const f32x4 (&acc)[2][2][4][2], const Unit& u, int wr, int wc, int fr_, int fq_) const {
        int fr = fr_, fq = fq_; asm volatile("" : "+v"(fr), "+v"(fq));
        const int row0 = u.pm * BM + wr * 64 + fr;
        if (u.pn == dt_pn) {
            if (wc == 0 && fq == 0) {
#pragma unroll
                for (int ai = 0; ai < 2; ++ai)
#pragma unroll
                    for (int m = 0; m < 4; ++m) { float* d = DT + (size_t)(row0 + ai * HALF + m * 16) * 8; *(f32x4*)d = acc[ai][0][m][0]; *(f32x4*)(d + 4) = acc[ai][0][m][1]; }
            }
            return;
        }
        const int col0 = u.pn * BM + wc * 32 + 8 * fq;
#pragma unroll
        for (int ai = 0; ai < 2; ++ai)
#pragma unroll
            for (int m = 0; m < 4; ++m) { bf16_t* rowp = O + (size_t)(row0 + ai * HALF + m * 16) * ldc + col0;
#pragma unroll
                for (int bj = 0; bj < 2; ++bj) { const f32x4 v0 = acc[ai][bj][m][0], v1 = acc[ai][bj][m][1];
                    u32x4 w; w.x = cvt_pk_bf16(v0[0], v0[1]); w.y = cvt_pk_bf16(v0[2], v0[3]); w.z = cvt_pk_bf16(v1[0], v1[1]); w.w = cvt_pk_bf16(v1[2], v1[3]);
                    *(u32x4*)(rowp + bj * HALF) = w; } }
    }
};
struct EpiRes { static constexpr bool PERM = false, AFTER_DRAIN = false;
    const float* base; const float* base_s; float* out;
    __device__ __forceinline__ void operator()(const f32x4 (&acc)[2][2][4][2], const Unit& u, int wr, int wc, int fr_, int fq_) const {
        int fr = fr_, fq = fq_; asm volatile("" : "+v"(fr), "+v"(fq));
        const int row0 = u.pm * BM + wr * 64 + fr, col0 = u.pn * BM + wc * 32 + 4 * fq;
#pragma unroll
        for (int ai = 0; ai < 2; ++ai)
#pragma unroll
            for (int m = 0; m < 4; ++m) { const int r = row0 + ai * HALF + m * 16;
                const float* bp = (base_s != nullptr && r >= MP) ? base_s + (size_t)(r - MP) * D : base + (size_t)r * D; float* op = out + (size_t)r * D;
#pragma unroll
                for (int bj = 0; bj < 2; ++bj)
#pragma unroll
                    for (int n = 0; n < 2; ++n) { const int c = col0 + bj * HALF + n * 16; const f32x4 x = *(const f32x4*)(bp + c); *(f32x4*)(op + c) = x * ALPHA + acc[ai][bj][m][n]; }
                asm volatile("" ::: "memory"); }
    }
};
struct EpiSwiGLU { static constexpr bool PERM = true, AFTER_DRAIN = false;
    bf16_t* HF;
    __device__ __forceinline__ void operator()(const f32x4 (&acc)[2][2][4][2], const Unit& u, int wr, int wc, int fr_, int fq_) const {
        int fr = fr_, fq = fq_; asm volatile("" : "+v"(fr), "+v"(fq));
        const int row0 = u.pm * BM + wr * 64 + fr, col0 = u.pn * HALF + wc * 32 + 8 * fq;
#pragma unroll
        for (int ai = 0; ai < 2; ++ai)
#pragma unroll
            for (int m = 0; m < 4; ++m) { bf16_t* rowp = HF + (size_t)(row0 + ai * HALF + m * 16) * FF + col0;
                f32x4 h0, h1;
#pragma unroll
                for (int j = 0; j < 4; ++j) { h0[j] = siluf_(acc[ai][0][m][0][j]) * acc[ai][1][m][0][j]; h1[j] = siluf_(acc[ai][0][m][1][j]) * acc[ai][1][m][1][j]; }
                u32x4 w; w.x = cvt_pk_bf16(h0[0], h0[1]); w.y = cvt_pk_bf16(h0[2], h0[3]); w.z = cvt_pk_bf16(h1[0], h1[1]); w.w = cvt_pk_bf16(h1[2], h1[3]);
                *(u32x4*)rowp = w; asm volatile("" ::: "memory"); }
    }
};
struct EpiGate { static constexpr bool PERM = false, AFTER_DRAIN = false;
    const float* xf; const bf16_t* P; float* out; bf16_t* xb2;
    __device__ __forceinline__ void operator()(const f32x4 (&acc)[2][2][4][2], const Unit& u, int wr, int wc, int fr_, int fq_) const {
        int fr = fr_, fq = fq_; asm volatile("" : "+v"(fr), "+v"(fq));
        const int row0 = u.pm * BM + wr * 64 + fr, col0 = u.pn * BM + wc * 32 + 4 * fq;
#pragma unroll
        for (int ai = 0; ai < 2; ++ai)
#pragma unroll
            for (int m = 0; m < 4; ++m) { const size_t ro = (size_t)(row0 + ai * HALF + m * 16) * D;
#pragma unroll
                for (int bj = 0; bj < 2; ++bj)
#pragma unroll
                    for (int n = 0; n < 2; ++n) { const size_t o = ro + col0 + bj * HALF + n * 16; const f32x4 x = *(const f32x4*)(xf + o); const u32x2 pw = *(const u32x2*)(P + o);
                        const f32x4 a = acc[ai][bj][m][n]; f32x4 r;
                        r[0] = x[0] + bf2f(pw.x & 0xffffu) * sigmoidf_(a[0]); r[1] = x[1] + __uint_as_float(pw.x & 0xffff0000u) * sigmoidf_(a[1]);
                        r[2] = x[2] + bf2f(pw.y & 0xffffu) * sigmoidf_(a[2]); r[3] = x[3] + __uint_as_float(pw.y & 0xffff0000u) * sigmoidf_(a[3]);
                        *(f32x4*)(out + o) = r;
                        if (xb2) { u32x2 w; w.x = cvt_pk_bf16(r[0], r[1]); w.y = cvt_pk_bf16(r[2], r[3]); *(u32x2*)(xb2 + o) = w; } }
                asm volatile("" ::: "memory"); }
    }
};

__device__ __forceinline__ void row_stats(const float* ssum, const float* ssq, int r, float& mean, float& rstd) {
    const float s = ssum[r], q = ssq[r]; mean = s * (1.f / D); const float var = fmaxf(q * (1.f / D) - mean * mean, 0.f); rstd = 1.f / sqrtf(var + LN_EPS); }
template <int BASE> struct EpiRes3 { static constexpr bool PERM = false, AFTER_DRAIN = false;
    const float* basef; const bf16_t* baseb; bf16_t* xb; float* ssum; float* ssq; const float* pss; const float* psq; const float* g; const float* b;
    __device__ __forceinline__ void operator()(const f32x4 (&acc)[2][2][4][2], const Unit& u, int wr, int wc, int fr_, int fq_) const {
        int fr = fr_, fq = fq_; asm volatile("" : "+v"(fr), "+v"(fq));
        const int row0 = u.pm * BM + wr * 64 + fr, col0 = u.pn * BM + wc * 32 + 4 * fq;
        float mean[8], rstd[8], s1[8], s2[8];
#pragma unroll
        for (int i = 0; i < 8; ++i) { mean[i] = 0.f; rstd[i] = 1.f; s1[i] = 0.f; s2[i] = 0.f; if (BASE == 2) row_stats(pss, psq, row0 + (i >> 2) * HALF + (i & 3) * 16, mean[i], rstd[i]); }
#pragma unroll
        for (int bj = 0; bj < 2; ++bj)
#pragma unroll
            for (int n = 0; n < 2; ++n) { const int c = col0 + bj * HALF + n * 16; f32x4 gg, bb;
                if (BASE == 2) { gg = *(const f32x4*)(g + c); bb = *(const f32x4*)(b + c); }
#pragma unroll
                for (int i = 0; i < 8; ++i) { const int ai = i >> 2, m = i & 3; const size_t ro = (size_t)(row0 + ai * HALF + m * 16) * D; f32x4 x;
                    if (BASE == 0) x = *(const f32x4*)(basef + ro + c);
                    else { const u32x2 bw = *(const u32x2*)(baseb + ro + c); x = (f32x4){bf2f(bw.x & 0xffffu), __uint_as_float(bw.x & 0xffff0000u), bf2f(bw.y & 0xffffu), __uint_as_float(bw.y & 0xffff0000u)}; }
                    if (BASE == 2) x = (x - mean[i]) * rstd[i] * gg + bb;
                    const f32x4 v = x * ALPHA + acc[ai][bj][m][n];
                    u32x2 w; w.x = cvt_pk_bf16(v[0], v[1]); w.y = cvt_pk_bf16(v[2], v[3]); *(u32x2*)(xb + ro + c) = w;
                    s1[i] += (v[0] + v[1]) + (v[2] + v[3]); s2[i] += (v[0] * v[0] + v[1] * v[1]) + (v[2] * v[2] + v[3] * v[3]); }
                asm volatile("" ::: "memory"); }
#pragma unroll
        for (int i = 0; i < 8; ++i) { float a = s1[i], q = s2[i]; a += __shfl_xor(a, 16); a += __shfl_xor(a, 32); q += __shfl_xor(q, 16); q += __shfl_xor(q, 32);
            if (fq == 0) { const int r = row0 + (i >> 2) * HALF + (i & 3) * 16; atomicAdd(ssum + r, a); atomicAdd(ssq + r, q); } }
    }
};
struct EpiSwiGLU2 { static constexpr bool PERM = true, AFTER_DRAIN = false;
    bf16_t* HF; const float* ssum; const float* ssq; const float* cs; const float* cb;
    __device__ __forceinline__ void operator()(const f32x4 (&acc)[2][2][4][2], const Unit& u, int wr, int wc, int fr_, int fq_) const {
        int fr = fr_, fq = fq_; asm volatile("" : "+v"(fr), "+v"(fq));
        const int row0 = u.pm * BM + wr * 64 + fr, col0 = u.pn * HALF + wc * 32 + 8 * fq, cc0 = u.pn * BM + wc * 32 + 8 * fq;
        f32x4 csv[2][2], cbv[2][2];
#pragma unroll
        for (int bj = 0; bj < 2; ++bj)
#pragma unroll
            for (int n = 0; n < 2; ++n) { csv[bj][n] = *(const f32x4*)(cs + cc0 + bj * HALF + 4 * n); cbv[bj][n] = *(const f32x4*)(cb + cc0 + bj * HALF + 4 * n); }
#pragma unroll
        for (int ai = 0; ai < 2; ++ai)
#pragma unroll
            for (int m = 0; m < 4; ++m) { const int r = row0 + ai * HALF + m * 16; bf16_t* rowp = HF + (size_t)r * FF + col0;
                float mean, rstd; row_stats(ssum, ssq, r, mean, rstd);
                f32x4 h0, h1;
#pragma unroll
                for (int j = 0; j < 4; ++j) {
                    const float a0 = rstd * (acc[ai][0][m][0][j] - mean * csv[0][0][j]) + cbv[0][0][j], b0 = rstd * (acc[ai][1][m][0][j] - mean * csv[1][0][j]) + cbv[1][0][j];
                    const float a1 = rstd * (acc[ai][0][m][1][j] - mean * csv[0][1][j]) + cbv[0][1][j], b1 = rstd * (acc[ai][1][m][1][j] - mean * csv[1][1][j]) + cbv[1][1][j];
                    h0[j] = siluf_(a0) * b0; h1[j] = siluf_(a1) * b1; }
                u32x4 w; w.x = cvt_pk_bf16(h0[0], h0[1]); w.y = cvt_pk_bf16(h0[2], h0[3]); w.z = cvt_pk_bf16(h1[0], h1[1]); w.w = cvt_pk_bf16(h1[2], h1[3]);
                *(u32x4*)rowp = w; asm volatile("" ::: "memory"); }
    }
};
template <bool FINAL> struct EpiGate3 { static constexpr bool PERM = false, AFTER_DRAIN = false;
    const bf16_t* xr; const bf16_t* P; float* outf; bf16_t* ob1; bf16_t* ob2; const float* ssum; const float* ssq; const float* cs; const float* cb; const float* g; const float* b;
    __device__ __forceinline__ void operator()(const f32x4 (&acc)[2][2][4][2], const Unit& u, int wr, int wc, int fr_, int fq_) const {
        int fr = fr_, fq = fq_; asm volatile("" : "+v"(fr), "+v"(fq));
        const int row0 = u.pm * BM + wr * 64 + fr, col0 = u.pn * BM + wc * 32 + 4 * fq;
        float mean[8], rstd[8];
#pragma unroll
        for (int i = 0; i < 8; ++i) row_stats(ssum, ssq, row0 + (i >> 2) * HALF + (i & 3) * 16, mean[i], rstd[i]);
#pragma unroll
        for (int bj = 0; bj < 2; ++bj)
#pragma unroll
            for (int n = 0; n < 2; ++n) { const int c = col0 + bj * HALF + n * 16;
                const f32x4 gg = *(const f32x4*)(g + c), bb = *(const f32x4*)(b + c), c1 = *(const f32x4*)(cs + c), c2 = *(const f32x4*)(cb + c);
#pragma unroll
                for (int i = 0; i < 8; ++i) { const int ai = i >> 2, m = i & 3; const size_t o = (size_t)(row0 + ai * HALF + m * 16) * D + c;
                    const u32x2 rw = *(const u32x2*)(xr + o); const u32x2 pw = *(const u32x2*)(P + o);
                    const f32x4 rv = (f32x4){bf2f(rw.x & 0xffffu), __uint_as_float(rw.x & 0xffff0000u), bf2f(rw.y & 0xffffu), __uint_as_float(rw.y & 0xffff0000u)};
                    const f32x4 x = (rv - mean[i]) * rstd[i] * gg + bb; const f32x4 a = (acc[ai][bj][m][n] - c1 * mean[i]) * rstd[i] + c2; f32x4 o4;
                    o4[0] = x[0] + bf2f(pw.x & 0xffffu) * sigmoidf_(a[0]); o4[1] = x[1] + __uint_as_float(pw.x & 0xffff0000u) * sigmoidf_(a[1]);
                    o4[2] = x[2] + bf2f(pw.y & 0xffffu) * sigmoidf_(a[2]); o4[3] = x[3] + __uint_as_float(pw.y & 0xffff0000u) * sigmoidf_(a[3]);
                    if (FINAL) *(f32x4*)(outf + o) = o4;
                    else { u32x2 w; w.x = cvt_pk_bf16(o4[0], o4[1]); w.y = cvt_pk_bf16(o4[2], o4[3]); *(u32x2*)(ob1 + o) = w; *(u32x2*)(ob2 + o) = w; } }
                asm volatile("" ::: "memory"); }
    }
};
}

template <class Epi>
__device__ __forceinline__ void run_gemm(int wid_s, LAS unsigned char* lds, const bf16_t* A, const bf16_t* Bt, int Mrows, int N, int K, const Epi& E) {
    pg8::Gemm g{A, Bt, Mrows, N, K, K}; pg8::StaticOrder S; S.init(Mrows, N, (int)gridDim.x, (int)blockIdx.x);
    pg8::gemm_phase<Epi, pg8::StaticOrder, true, true>(wid_s, lds, g, S, E);
}
namespace pg8 {
struct SplitOrder { int nN, nS, G, c;
    __device__ bool next(int i, Unit& u) const { const int L = i * G + c; if (L >= nN * nS) return false; u.pm = 64; u.pn = L % nN; u.ko = (L / nN) * 256; return true; }
    __device__ __forceinline__ void a_ready(const Unit&) const {}
    __device__ __forceinline__ void done(const Unit&) const {}
};
struct EpiSlab { static constexpr bool PERM = false, AFTER_DRAIN = false;
    float* slab;
    __device__ __forceinline__ void operator()(const f32x4 (&acc)[2][2][4][2], const Unit& u, int wr, int wc, int fr_, int fq_) const {
        int fr = fr_, fq = fq_; asm volatile("" : "+v"(fr), "+v"(fq));
        const int row0 = wr * 64 + fr, col0 = u.pn * BM + wc * 32 + 4 * fq; float* sp = slab + (size_t)(u.ko >> 8) * (256 * D);
#pragma unroll
        for (int ai = 0; ai < 2; ++ai)
#pragma unroll
            for (int m = 0; m < 4; ++m) { float* op = sp + (size_t)(row0 + ai * HALF + m * 16) * D;
#pragma unroll
                for (int bj = 0; bj < 2; ++bj)
#pragma unroll
                    for (int n = 0; n < 2; ++n) *(f32x4*)(op + col0 + bj * HALF + n * 16) = acc[ai][bj][m][n]; }
    }
};
}
__device__ __forceinline__ void run_gemm_split(int wid_s, LAS unsigned char* lds, const bf16_t* A, const bf16_t* Bt, int K, float* slab) {
    pg8::Gemm g{A, Bt, MT, D, K, 256}; pg8::SplitOrder S{4, K / 256, (int)gridDim.x, (int)(gridDim.x - 1 - blockIdx.x)}; pg8::EpiSlab E{slab};
    pg8::gemm_phase<pg8::EpiSlab, pg8::SplitOrder, true, true>(wid_s, lds, g, S, E);
}

template <int NCT, class Fin>
__device__ __forceinline__ void mini_gemm_tail(int wid_s, LAS unsigned char* lds, const bf16_t* A, const bf16_t* Bt, int K, const Fin& fin) {
    const int lane = lane_id_(), wv = wid_s, tid = wv * 64 + lane; LAS float* red = (LAS float*)lds; constexpr int NB = 16 * NCT;
    for (int blk = blockIdx.x; blk < 256; blk += gridDim.x) {
        const int rows0 = MP + (blk >> 5) * 32, cols0 = (blk & 31) * NB, kw = K >> 3;
        f32x4 acc[2][NCT];
#pragma unroll
        for (int rt = 0; rt < 2; ++rt)
#pragma unroll
            for (int ct = 0; ct < NCT; ++ct) acc[rt][ct] = (f32x4){0.f, 0.f, 0.f, 0.f};
        const bf16_t* ap = A + (size_t)(rows0 + (lane & 15)) * K + wv * kw + 8 * (lane >> 4);
        const bf16_t* bp = Bt + (size_t)(cols0 + (lane & 15)) * K + wv * kw + 8 * (lane >> 4);
#pragma unroll 4
        for (int k0 = 0; k0 < kw; k0 += 32) {
            const bf16x8 a0 = *(const bf16x8*)(ap + k0), a1 = *(const bf16x8*)(ap + (size_t)16 * K + k0);
#pragma unroll
            for (int ct = 0; ct < NCT; ++ct) { const bf16x8 bf = *(const bf16x8*)(bp + (size_t)(16 * ct) * K + k0); acc[0][ct] = mfma16(bf, a0, acc[0][ct]); acc[1][ct] = mfma16(bf, a1, acc[1][ct]); } }
#pragma unroll
        for (int rt = 0; rt < 2; ++rt)
#pragma unroll
            for (int ct = 0; ct < NCT; ++ct) *(LAS f32x4*)(red + ((wv * 32 + rt * 16 + (lane & 15)) * NB + ct * 16 + (lane >> 4) * 4)) = acc[rt][ct];
        __syncthreads();
        if (tid < 8 * NB) { const int row = tid / (NB / 4), cg = (tid % (NB / 4)) * 4; f32x4 s = (f32x4){0.f, 0.f, 0.f, 0.f};
#pragma unroll
            for (int w = 0; w < 8; ++w) s += *(const LAS f32x4*)(red + ((w * 32 + row) * NB + cg));
            fin(rows0 + row, cols0 + cg, s); }
        __syncthreads();
    }
}
struct FinStore { bf16_t* O; int ldc;
    __device__ __forceinline__ void operator()(int r, int c, const f32x4 acc) const { u32x2 w; w.x = pk2(acc[0], acc[1]); w.y = pk2(acc[2], acc[3]); *(u32x2*)(O + (size_t)r * ldc + c) = w; } };
struct FinRes { int kind; const float* basef; const bf16_t* baseb; bf16_t* xb; float* ssum; float* ssq; const float* pss; const float* psq; const float* g; const float* b;
    __device__ __forceinline__ void operator()(int r, int c, const f32x4 acc) const { const size_t o = (size_t)r * D + c; f32x4 x;
        if (kind == 0) x = *(const f32x4*)(basef + (size_t)(r - MP) * D + c);
        else { const u32x2 bw = *(const u32x2*)(baseb + o); x = (f32x4){bf2f(bw.x & 0xffffu), __uint_as_float(bw.x & 0xffff0000u), bf2f(bw.y & 0xffffu), __uint_as_float(bw.y & 0xffff0000u)}; }
        if (kind == 2) { float mean, rstd; pg8::row_stats(pss, psq, r, mean, rstd); x = (x - mean) * rstd * *(const f32x4*)(g + c) + *(const f32x4*)(b + c); }
        const f32x4 v = x * ALPHA + acc; u32x2 w; w.x = pk2(v[0], v[1]); w.y = pk2(v[2], v[3]); *(u32x2*)(xb + o) = w;
        float s1 = (v[0] + v[1]) + (v[2] + v[3]), s2 = (v[0] * v[0] + v[1] * v[1]) + (v[2] * v[2] + v[3] * v[3]);
        s1 += __shfl_xor(s1, 1); s1 += __shfl_xor(s1, 2); s1 += __shfl_xor(s1, 4); s2 += __shfl_xor(s2, 1); s2 += __shfl_xor(s2, 2); s2 += __shfl_xor(s2, 4);
        if ((c & 31) == 0) { atomicAdd(ssum + r, s1); atomicAdd(ssq + r, s2); } }
};
struct FinGate { bool final_; const bf16_t* xr; const bf16_t* P; float* outf; bf16_t* ob1; bf16_t* ob2; const float* ssum; const float* ssq; const float* cs; const float* cb; const float* g; const float* b;
    __device__ __forceinline__ void operator()(int r, int c, const f32x4 acc) const {
        float mean, rstd; pg8::row_stats(ssum, ssq, r, mean, rstd); const size_t o = (size_t)r * D + c;
        const u32x2 rw = *(const u32x2*)(xr + o); const u32x2 pw = *(const u32x2*)(P + o);
        const f32x4 gg = *(const f32x4*)(g + c), bb = *(const f32x4*)(b + c), c1 = *(const f32x4*)(cs + c), c2 = *(const f32x4*)(cb + c);
        const f32x4 rv = (f32x4){bf2f(rw.x & 0xffffu), __uint_as_float(rw.x & 0xffff0000u), bf2f(rw.y & 0xffffu), __uint_as_float(rw.y & 0xffff0000u)};
        const f32x4 x = (rv - mean) * rstd * gg + bb; const f32x4 a = (acc - c1 * mean) * rstd + c2; f32x4 o4;
        o4[0] = x[0] + bf2f(pw.x & 0xffffu) * sigmoidf_(a[0]); o4[1] = x[1] + __uint_as_float(pw.x & 0xffff0000u) * sigmoidf_(a[1]);
        o4[2] = x[2] + bf2f(pw.y & 0xffffu) * sigmoidf_(a[2]); o4[3] = x[3] + __uint_as_float(pw.y & 0xffff0000u) * sigmoidf_(a[3]);
        if (final_) *(f32x4*)(outf + o) = o4;
        else { u32x2 w; w.x = pk2(o4[0], o4[1]); w.y = pk2(o4[2], o4[3]); *(u32x2*)(ob1 + o) = w; *(u32x2*)(ob2 + o) = w; } }
};

__device__ __forceinline__ void tr_item(const float* W, int ldw, int nvalid, int k0, int n0, bf16_t* WT, int ldt, int drow0, LAS float* scr, int lane,
                                        const float* gs = nullptr, const float* bs = nullptr, float* cs = nullptr, float* cb = nullptr) {
    float wv_[32];
#pragma unroll
    for (int i = 0; i < 32; ++i) { const int kk = 2 * i + (lane >> 5), n = n0 + (lane & 31); wv_[i] = (n < nvalid) ? W[(size_t)(k0 + kk) * ldw + n] : 0.f; }
#pragma unroll
    for (int i = 0; i < 32; ++i) scr[(2 * i + (lane >> 5)) * 33 + (lane & 31)] = wv_[i];
    LDS_WAIT();
    const int c = lane & 7;
    float gk[8], bk[8];
    if (gs != nullptr) { load8f(gs + k0 + 8 * c, gk); load8f(bs + k0 + 8 * c, bk); }
#pragma unroll
    for (int j = 0; j < 4; ++j) { const int n = (lane >> 3) + 8 * j; const LAS float* s = scr + (8 * c) * 33 + n; float w[8];
#pragma unroll
        for (int q = 0; q < 8; ++q) w[q] = s[q * 33];
        if (gs != nullptr) { float csp = 0.f, cbp = 0.f;
#pragma unroll
            for (int q = 0; q < 8; ++q) { cbp += w[q] * bk[q]; w[q] *= gk[q]; csp += bf2f(f2bf(w[q])); }
            csp += __shfl_xor(csp, 1); csp += __shfl_xor(csp, 2); csp += __shfl_xor(csp, 4); cbp += __shfl_xor(cbp, 1); cbp += __shfl_xor(cbp, 2); cbp += __shfl_xor(cbp, 4);
            if (c == 0 && n0 + n < nvalid) { atomicAdd(cs + drow0 + n, csp); atomicAdd(cb + drow0 + n, cbp); } }
        u32x4 o; o.x = pk2(w[0], w[1]); o.y = pk2(w[2], w[3]); o.z = pk2(w[4], w[5]); o.w = pk2(w[6], w[7]);
        if (n0 + n < nvalid) *(u32x4*)(WT + (size_t)(drow0 + n) * ldt + k0 + 8 * c) = o; }
    LDS_WAIT();
}
__device__ __forceinline__ void tr_plain(const float* W, int K, int N, bf16_t* WT, int item, LAS float* scr, int lane) {
    const int nblk = (N + 31) / 32, kb = item / nblk, nb = item % nblk; tr_item(W, N, N, 64 * kb, 32 * nb, WT, K, 32 * nb, scr, lane);
}
__device__ __forceinline__ void cvt_f32_bf16(const float* src, bf16_t* dst, size_t n4, size_t gtid, size_t gstride) {
    size_t i = gtid;
    for (; i + 7 * gstride < n4; i += 8 * gstride) { f32x4 v[8];
#pragma unroll
        for (int j = 0; j < 8; ++j) v[j] = *(const f32x4*)(src + 4 * (i + j * gstride));
#pragma unroll
        for (int j = 0; j < 8; ++j) { u32x2 w; w.x = pk2(v[j].x, v[j].y); w.y = pk2(v[j].z, v[j].w); *(u32x2*)(dst + 4 * (i + j * gstride)) = w; } }
    for (; i < n4; i += gstride) { const f32x4 v = *(const f32x4*)(src + 4 * i); u32x2 w; w.x = pk2(v.x, v.y); w.y = pk2(v.z, v.w); *(u32x2*)(dst + 4 * i) = w; }
}
template <int PART>
__device__ __forceinline__ void p0_prep(int wid_s, const CAS Params& p, LAS unsigned char* lds) {
    const int lane = lane_id_(), wv = wid_s, tid = wv * 64 + lane;
    LAS float* scr = (LAS float*)(lds + wv * 16384);
    const int gw = blockIdx.x * 8 + wv, NGW = gridDim.x * 8;
    unsigned char* ws = p.ws;
    constexpr int I_INE = 16 * 64, I_SQ = 16 * 32, I_INO = 16 * 81, I_F1 = 16 * 88, I_F2 = 44 * 32, I_PL = 4 * 32, I_POOL = 32;
    constexpr int PER_L = 2 * I_F1 + I_F2 + I_SQ + I_PL;
    constexpr int NITEMS = PART == 0 ? (I_INE + I_SQ + PER_L + I_POOL) : (I_INO + I_SQ + PER_L);
    constexpr int l = PART;
    for (int it = gw; it < NITEMS; it += NGW) {
        int r = it;
        if (PART == 0) {
            if (r < I_INE) { tr_plain(p.in[I_WINE], D, 2048, (bf16_t*)(ws + WS_WINE), r, scr, lane); continue; } r -= I_INE;
            if (r < I_SQ) { tr_plain(p.in[I_WOUTE], D, D, (bf16_t*)(ws + WS_WOUTE), r, scr, lane); continue; } r -= I_SQ;
        } else {
            if (r < I_INO) { tr_plain(p.in[I_WINO], D, 2568, (bf16_t*)(ws + WS_WINO), r, scr, lane); continue; } r -= I_INO;
            if (r < I_SQ) { tr_plain(p.in[I_WOUTO], D, D, (bf16_t*)(ws + WS_WOUTO), r, scr, lane); continue; } r -= I_SQ;
        }
        if (r < PER_L) {
            if (r < 2 * I_F1) { const int which = r / I_F1, rr = r % I_F1, kb = rr / 88, nb = rr % 88, n0 = 32 * nb;
                const float* W = p.in[which ? I_FF3 : I_FF1] + (size_t)l * D * FF;
                tr_item(W, FF, FF, 64 * kb, n0, (bf16_t*)(ws + WS_W13 + l * W13_BYTES), D, (n0 >> 7) * 256 + which * 128 + (n0 & 127), scr, lane,
                        p.in[I_LN1G] + l * D, p.in[I_LN1B] + l * D, (float*)(ws + WS_CS13) + l * 5632, (float*)(ws + WS_CB13) + l * 5632); continue; } r -= 2 * I_F1;
            if (r < I_F2) { tr_plain(p.in[I_FF2] + (size_t)l * FF * D, FF, D, (bf16_t*)(ws + WS_W2 + l * W2_BYTES), r, scr, lane); continue; } r -= I_F2;
            if (r < I_SQ) { const int kb = r / 32, nb = r % 32; tr_item(p.in[I_WGATE] + (size_t)l * D * D, D, D, 64 * kb, 32 * nb, (bf16_t*)(ws + WS_WG + l * WG_BYTES), D, 32 * nb, scr, lane,
                        p.in[I_LN2G] + l * D, p.in[I_LN2B] + l * D, (float*)(ws + WS_CSG) + l * D, (float*)(ws + WS_CBG) + l * D); continue; } r -= I_SQ;
            tr_plain(p.in[I_WPLE] + (size_t)l * 256 * D, 256, D, (bf16_t*)(ws + WS_WPLE + l * WPLE_BYTES), r, scr, lane); continue; }
        r -= PER_L;
        if (PART == 0) { const int g = r >> 3, rr = r & 7; tr_plain(p.in[I_POOLW] + g * 16384, 128, 128, (bf16_t*)(ws + WS_WPOOL) + g * 16384, rr, scr, lane); }
    }
    const size_t gtid = (size_t)blockIdx.x * 512 + tid, gstride = (size_t)gridDim.x * 512;
    if (PART == 0) {
        { u32x4* z = (u32x4*)(ws + WS_STATS); const size_t n = (size_t)4 * 2 * MT * 4 / 16; for (size_t i = gtid; i < n; i += gstride) z[i] = (u32x4){0u, 0u, 0u, 0u}; }
        cvt_f32_bf16(p.in[I_XP], (bf16_t*)(ws + WS_XB), (size_t)MP * D / 4, gtid, gstride);
        cvt_f32_bf16(p.in[I_XS], (bf16_t*)(ws + WS_XB) + (size_t)MP * D, (size_t)MSAMP * D / 4, gtid, gstride);
        cvt_f32_bf16(p.in[I_PP], (bf16_t*)(ws + WS_PLEB), (size_t)MP * 256 / 4, gtid, gstride);
        cvt_f32_bf16(p.in[I_PS], (bf16_t*)(ws + WS_PLEB) + (size_t)MP * 256, (size_t)MSAMP * 256 / 4, gtid, gstride);
    } else {
        { u32x4* z = (u32x4*)(ws + WS_WINO + (size_t)2568 * D * 2); const size_t n = (size_t)(NINO - 2568) * D * 2 / 16; for (size_t i = gtid; i < n; i += gstride) z[i] = (u32x4){0u, 0u, 0u, 0u}; }
        { bf16_t* o = (bf16_t*)(ws + WS_WSGU); const float* w = p.in[I_SGUW]; for (size_t i = gtid; i < 65536; i += gstride) { const int t = (int)(i >> 7) & 127, s = (int)i & 127; o[i] = (bf16_t)((s <= t) ? f2bf(w[i]) : 0u); } }
    }
}

__device__ __forceinline__ void ln_sample(int wid_s, bf16_t* xb, const float* slab, int nsl, const float* sbf, const bf16_t* sbb, float* ssum, float* ssq,
                                          const float* pss, const float* psq, const float* g, const float* b) {
    const int lane = lane_id_(), wv = wid_s;
    const int gw = blockIdx.x * 8 + wv, NGW = gridDim.x * 8;
    for (int m = MP + gw; m < MT; m += NGW) {
        f32x4 v[4];
        if (sbf != nullptr) { const f32x4* br = (const f32x4*)(sbf + (size_t)(m - MP) * D) + lane;
#pragma unroll
            for (int j = 0; j < 4; ++j) v[j] = br[64 * j]; }
        else { const u32x2* br = (const u32x2*)(sbb + (size_t)(m - MP) * D) + lane;
#pragma unroll
            for (int j = 0; j < 4; ++j) { const u32x2 bw = br[64 * j]; v[j] = (f32x4){bf2f(bw.x & 0xffffu), __uint_as_float(bw.x & 0xffff0000u), bf2f(bw.y & 0xffffu), __uint_as_float(bw.y & 0xffff0000u)}; } }
        if (pss != nullptr) { float mean, rstd; pg8::row_stats(pss, psq, m, mean, rstd);
#pragma unroll
            for (int j = 0; j < 4; ++j) v[j] = (v[j] - mean) * rstd * *(const f32x4*)(g + 4 * lane + 256 * j) + *(const f32x4*)(b + 4 * lane + 256 * j); }
#pragma unroll
        for (int j = 0; j < 4; ++j) v[j] = v[j] * ALPHA;
        for (int sl = 0; sl < nsl; ++sl) { const f32x4* sr = (const f32x4*)(slab + (size_t)sl * (256 * D) + (size_t)(m - MP) * D) + lane;
#pragma unroll
            for (int j = 0; j < 4; ++j) v[j] += sr[64 * j]; }
        float s = 0.f, q = 0.f;
#pragma unroll
        for (int j = 0; j < 4; ++j) { s += (v[j].x + v[j].y) + (v[j].z + v[j].w); q += (v[j].x * v[j].x + v[j].y * v[j].y) + (v[j].z * v[j].z + v[j].w * v[j].w); }
        s = wave_sum(s); q = wave_sum(q);
        if (lane == 0) { ssum[m] = s; ssq[m] = q; }
        u32x2* o8 = (u32x2*)(xb + (size_t)m * D) + lane;
#pragma unroll
        for (int j = 0; j < 4; ++j) { u32x2 w; w.x = pk2(v[j].x, v[j].y); w.y = pk2(v[j].z, v[j].w); o8[64 * j] = w; }
    }
}

__device__ __forceinline__ void even_mixer_tile(int wid_s, const CAS Params& p, LAS unsigned char* lds, int ti) {
    const int lane = lane_id_(), wv = wid_s, tid = wv * 64 + lane;
    int row0, nvalid, tpos0, sb = -1, b = 0;
    if (ti < 256) { row0 = ti * 64; nvalid = 64; tpos0 = row0 & (SEQ - 1); b = ti >> 7; } else { sb = ti - 256; row0 = MP + sb * 32; nvalid = 32; tpos0 = 4096; }
    const bf16_t* H0 = (const bf16_t*)(p.ws + WS_REGA); bf16_t* MIX = (bf16_t*)(p.ws + WS_MIX);
    const bf16_t* poolT = (const bf16_t*)(p.ws + WS_WPOOL);
    constexpr int LDA = 520;
    LAS bf16_t* A2 = (LAS bf16_t*)lds;
    const bool first = (sb < 0 && tpos0 == 0);
    const bool lasttile = (sb >= 0) || (tpos0 == SEQ - 64);
#pragma unroll 5
    for (int it = tid; it < 79 * 64; it += 512) { const int j = it >> 6, c8 = (it & 63) * 8, tok = j - 15; u32x4 w = (u32x4){0u, 0u, 0u, 0u};
        if (tok < nvalid) {
            if (tok >= 0 || (sb < 0 && !first)) w = *(const u32x4*)(H0 + (size_t)(row0 + tok) * NH0 + c8);
            else if (sb >= 0) { float v[8]; load8f(p.in[I_STPOOL] + (size_t)(sb * 15 + j) * 512 + c8, v); w = pack8(v); } }
        *(LAS u32x4*)(A2 + j * LDA + c8) = w; }
    __syncthreads();
    { const int c = tid, gi = c >> 7, w = 2 << gi; float W = 0.f;
        for (int k = 0; k < w; ++k) W += bf2f((unsigned)A2[(15 + 63 - k) * LDA + c]);
        const float inv = 1.f / (float)w;
        for (int t = 63; t >= 0; --t) { const float a = bf2f((unsigned)A2[(15 + t) * LDA + c]);
            if (lasttile && t < nvalid && t >= nvalid - 15) { const int j = t - (nvalid - 15); p.out[((sb >= 0) ? O_POOLS + (size_t)(sb * 15 + j) * 512 : O_POOLP + (size_t)(b * 15 + j) * 512) + c] = a; }
            const float sc = (first && t + 1 < w) ? 1.f / (float)(t + 1) : inv;
            const float d = W * sc - a;
            if (t > 0) W += bf2f((unsigned)A2[(15 + t - w) * LDA + c]) - a;
            A2[(15 + t) * LDA + c] = (bf16_t)f2bf(d); } }
    __syncthreads();
    { const int gi = wv >> 1, eb = (wv & 1) * 4; f32x4 acc[4][4];
#pragma unroll
        for (int tt = 0; tt < 4; ++tt)
#pragma unroll
            for (int q = 0; q < 4; ++q) acc[tt][q] = (f32x4){0.f, 0.f, 0.f, 0.f};
#pragma unroll
        for (int ks = 0; ks < 4; ++ks) { bf16x8 bfr[4];
#pragma unroll
            for (int q = 0; q < 4; ++q) bfr[q] = *(const bf16x8*)(poolT + gi * 16384 + ((eb + q) * 16 + (lane & 15)) * 128 + ks * 32 + 8 * (lane >> 4));
#pragma unroll
            for (int tt = 0; tt < 4; ++tt) { const bf16x8 af = *(const LAS bf16x8*)(A2 + (15 + tt * 16 + (lane & 15)) * LDA + gi * 128 + ks * 32 + 8 * (lane >> 4));
#pragma unroll
                for (int q = 0; q < 4; ++q) acc[tt][q] = mfma16(bfr[q], af, acc[tt][q]); } }
#pragma unroll
        for (int q = 0; q < 4; ++q) { const int e0 = (eb + q) * 16 + (lane >> 4) * 4; const f32x4 sc = *(const f32x4*)(p.in[I_POOLSC] + gi * 128 + e0);
#pragma unroll
            for (int tt = 0; tt < 4; ++tt) { const int t = tt * 16 + (lane & 15);
                if (t < nvalid) { u32x2 o; o.x = pk2(acc[tt][q][0] * sc[0], acc[tt][q][1] * sc[1]); o.y = pk2(acc[tt][q][2] * sc[2], acc[tt][q][3] * sc[3]);
                    *(u32x2*)(MIX + (size_t)(row0 + t) * D + gi * 128 + e0) = o; } } } }
    const float* cw = p.in[I_CONVW];
#pragma unroll 2
    for (int it = tid; it < nvalid * 64; it += 512) { const int t = it >> 6, c8 = (it & 63) * 8; float cg[3][8];
        { float cgt[3][8], hv[3][8];
#pragma unroll
            for (int dk = 0; dk < 3; ++dk) { const int tok = t - 2 + dk; const int tokc = (tok < 0 && (first || sb >= 0)) ? 0 : tok;
                load8bf(H0 + (size_t)(row0 + tokc) * NH0 + 1024 + c8, cgt[dk]); load8bf(H0 + (size_t)(row0 + tokc) * NH0 + 1536 + c8, hv[dk]); }
#pragma unroll
            for (int dk = 0; dk < 3; ++dk)
#pragma unroll
                for (int q = 0; q < 8; ++q) cg[dk][q] = cgt[dk][q] * hv[dk][q];
            if (sb >= 0) {
#pragma unroll
                for (int dk = 0; dk < 2; ++dk) { const int tok = t - 2 + dk; if (tok < 0) load8f(p.in[I_STCONV] + (size_t)(sb * 2 + 2 + tok) * 512 + c8, cg[dk]); }
            } else if (first) {
#pragma unroll
                for (int dk = 0; dk < 2; ++dk) { const bool hist = (t - 2 + dk) < 0;
#pragma unroll
                    for (int q = 0; q < 8; ++q) cg[dk][q] = hist ? 0.f : cg[dk][q]; } } }
        float bg[8], w0[8], w1[8], w2[8], y[8];
        load8bf(H0 + (size_t)(row0 + t) * NH0 + 512 + c8, bg); load8f(cw + c8, w0); load8f(cw + 512 + c8, w1); load8f(cw + 1024 + c8, w2);
#pragma unroll
        for (int q = 0; q < 8; ++q) y[q] = bg[q] * (w0[q] * cg[0][q] + w1[q] * cg[1][q] + w2[q] * cg[2][q]);
        *(u32x4*)(MIX + (size_t)(row0 + t) * D + 512 + c8) = pack8(y);
        if (lasttile && t >= nvalid - 2) { const int j = t - (nvalid - 2); float* o = p.out + ((sb >= 0) ? O_CONVS + (size_t)(sb * 2 + j) * 512 + c8 : O_CONVP + (size_t)(b * 2 + j) * 512 + c8);
            *(f32x4*)o = (f32x4){cg[2][0], cg[2][1], cg[2][2], cg[2][3]}; *(f32x4*)(o + 4) = (f32x4){cg[2][4], cg[2][5], cg[2][6], cg[2][7]}; }
    }
    __syncthreads();
}

__device__ __forceinline__ void even_mixer_part(int wid_s, const CAS Params& p, LAS unsigned char* lds, int ti, int part) {
    const int lane = lane_id_(), wv = wid_s, tid = wv * 64 + lane;
    int row0, nvalid, tpos0, sb = -1, b = 0;
    if (ti < 256) { row0 = ti * 64; nvalid = 64; tpos0 = row0 & (SEQ - 1); b = ti >> 7; } else { sb = ti - 256; row0 = MP + sb * 32; nvalid = 32; tpos0 = 4096; }
    const bf16_t* H0 = (const bf16_t*)(p.ws + WS_REGA); bf16_t* MIX = (bf16_t*)(p.ws + WS_MIX);
    const bf16_t* poolT = (const bf16_t*)(p.ws + WS_WPOOL);
    LAS float* araw = (LAS float*)lds; LAS bf16_t* dA = (LAS bf16_t*)(lds + 40448);
    const bool first = (sb < 0 && tpos0 == 0);
    const bool lasttile = (sb >= 0) || (tpos0 == SEQ - 64);
    if (part < 4) { const int gi = part;
        for (int it = tid; it < 79 * 16; it += 512) { const int j = it >> 4, c8 = (it & 15) * 8, tok = j - 15; float v[8];
#pragma unroll
            for (int q = 0; q < 8; ++q) v[q] = 0.f;
            if (tok < nvalid) {
                if (tok >= 0 || (sb < 0 && !first)) load8bf(H0 + (size_t)(row0 + tok) * NH0 + gi * 128 + c8, v);
                else if (sb >= 0) load8f(p.in[I_STPOOL] + (size_t)(sb * 15 + j) * 512 + gi * 128 + c8, v);
            }
            *(LAS f32x4*)(araw + j * 128 + c8) = (f32x4){v[0], v[1], v[2], v[3]}; *(LAS f32x4*)(araw + j * 128 + c8 + 4) = (f32x4){v[4], v[5], v[6], v[7]}; }
        __syncthreads();
        if (lasttile) { for (int it = tid; it < 15 * 128; it += 512) { const int j = it >> 7, c = it & 127, t = nvalid - 15 + j;
                const size_t o = (sb >= 0) ? O_POOLS + (size_t)(sb * 15 + j) * 512 + gi * 128 + c : O_POOLP + (size_t)(b * 15 + j) * 512 + gi * 128 + c;
                p.out[o] = araw[(15 + t) * 128 + c]; } }
        const int w = 2 << gi;
        for (int it = tid; it < 64 * 128; it += 512) { const int t = it >> 7, c = it & 127; float s = 0.f;
            for (int k = 0; k < w; ++k) s += araw[(15 + t - k) * 128 + c];
            const int cnt = first ? (w < t + 1 ? w : t + 1) : w;
            dA[t * 136 + c] = (bf16_t)f2bf(s / (float)cnt - araw[(15 + t) * 128 + c]); }
        __syncthreads();
        { const int tt = wv & 3, eb = (wv >> 2) * 4; f32x4 acc[4];
#pragma unroll
            for (int q = 0; q < 4; ++q) acc[q] = (f32x4){0.f, 0.f, 0.f, 0.f};
#pragma unroll
            for (int ks = 0; ks < 4; ++ks) { const bf16x8 af = *(const LAS bf16x8*)(dA + (tt * 16 + (lane & 15)) * 136 + ks * 32 + 8 * (lane >> 4));
#pragma unroll
                for (int q = 0; q < 4; ++q) { const bf16x8 bf = *(const bf16x8*)(poolT + gi * 16384 + ((eb + q) * 16 + (lane & 15)) * 128 + ks * 32 + 8 * (lane >> 4)); acc[q] = mfma16(bf, af, acc[q]); } }
            const int t = tt * 16 + (lane & 15);
            if (t < nvalid) {
#pragma unroll
                for (int q = 0; q < 4; ++q) { const int e0 = (eb + q) * 16 + (lane >> 4) * 4; const f32x4 sc = *(const f32x4*)(p.in[I_POOLSC] + gi * 128 + e0);
                    u32x2 o; o.x = pk2(acc[q][0] * sc[0], acc[q][1] * sc[1]); o.y = pk2(acc[q][2] * sc[2], acc[q][3] * sc[3]);
                    *(u32x2*)(MIX + (size_t)(row0 + t) * D + gi * 128 + e0) = o; } } }
        __syncthreads();
    }
    if (part < 4) return;
    const float* cw = p.in[I_CONVW];
    for (int it = tid; it < nvalid * 32; it += 512) { const int t = it >> 5, c8 = (part - 4) * 256 + (it & 31) * 8; float cg[3][8];
#pragma unroll
        for (int dk = 0; dk < 3; ++dk) { const int tok = t - 2 + dk;
            if (tok >= 0 || (sb < 0 && !first)) { float cgt[8], hv[8]; load8bf(H0 + (size_t)(row0 + tok) * NH0 + 1024 + c8, cgt); load8bf(H0 + (size_t)(row0 + tok) * NH0 + 1536 + c8, hv);
#pragma unroll
                for (int q = 0; q < 8; ++q) cg[dk][q] = cgt[q] * hv[q]; }
            else if (sb >= 0) { float hv[8]; load8f(p.in[I_STCONV] + (size_t)(sb * 2 + 2 + tok) * 512 + c8, hv);
#pragma unroll
                for (int q = 0; q < 8; ++q) cg[dk][q] = hv[q]; }
            else {
#pragma unroll
                for (int q = 0; q < 8; ++q) cg[dk][q] = 0.f; } }
        float bg[8], w0[8], w1[8], w2[8], y[8];
        load8bf(H0 + (size_t)(row0 + t) * NH0 + 512 + c8, bg); load8f(cw + c8, w0); load8f(cw + 512 + c8, w1); load8f(cw + 1024 + c8, w2);
#pragma unroll
        for (int q = 0; q < 8; ++q) y[q] = bg[q] * (w0[q] * cg[0][q] + w1[q] * cg[1][q] + w2[q] * cg[2][q]);
        *(u32x4*)(MIX + (size_t)(row0 + t) * D + 512 + c8) = pack8(y);
        if (lasttile && t >= nvalid - 2) { const int j = t - (nvalid - 2); float* o = p.out + ((sb >= 0) ? O_CONVS + (size_t)(sb * 2 + j) * 512 + c8 : O_CONVP + (size_t)(b * 2 + j) * 512 + c8);
            *(f32x4*)o = (f32x4){cg[2][0], cg[2][1], cg[2][2], cg[2][3]}; *(f32x4*)(o + 4) = (f32x4){cg[2][4], cg[2][5], cg[2][6], cg[2][7]}; }
    }
    __syncthreads();
}

__device__ __forceinline__ void sgu_block(int wid_s, const CAS Params& p, LAS unsigned char* lds, int bi) {
    const int lane = lane_id_(), wv = wid_s, tid = wv * 64 + lane;
    int row0, nvalid, sb = -1;
    if (bi < 128) { row0 = bi * 128; nvalid = 128; } else { sb = bi - 128; row0 = MP + sb * 32; nvalid = 32; }
    const bf16_t* H1 = (const bf16_t*)(p.ws + WS_REGA); bf16_t* MIX = (bf16_t*)(p.ws + WS_MIX); const bf16_t* sguW = (const bf16_t*)(p.ws + WS_WSGU);
    LAS float* stats = (LAS float*)lds; LAS bf16_t* vT = (LAS bf16_t*)(lds + 1024);
    { const int t = wv * 16 + (lane >> 2), sub = lane & 3;
        float s = 0.f;
        if (t < nvalid) {
#pragma unroll 4
            for (int i = 0; i < 16; ++i) { float v[8]; load8bf(H1 + (size_t)(row0 + t) * NH1 + 512 + sub * 128 + i * 8, v);
#pragma unroll
                for (int q = 0; q < 8; ++q) s += geluf_(v[q]); } }
        s += __shfl_xor(s, 1); s += __shfl_xor(s, 2); const float mean = s * (1.f / 512.f); float s2 = 0.f;
        if (t < nvalid) {
#pragma unroll 4
            for (int i = 0; i < 16; ++i) { float v[8]; load8bf(H1 + (size_t)(row0 + t) * NH1 + 512 + sub * 128 + i * 8, v);
#pragma unroll
                for (int q = 0; q < 8; ++q) { const float d = geluf_(v[q]) - mean; s2 += d * d; } } }
        s2 += __shfl_xor(s2, 1); s2 += __shfl_xor(s2, 2);
        if (t < nvalid && sub == 0) { stats[2 * t] = mean; stats[2 * t + 1] = 1.f / sqrtf(s2 * (1.f / 512.f) + LN_EPS); } }
    __syncthreads();
    for (int g = 0; g < 4; ++g) {
#pragma unroll 4
    for (int it = tid; it < 128 * 16; it += 512) { const int blk = it >> 6, s = (blk & 15) * 8 + (lane >> 3), d8 = ((blk >> 4) * 8 + (lane & 7)) * 8;
            if (s < nvalid) { float v[8], lg[8], lb[8]; load8bf(H1 + (size_t)(row0 + s) * NH1 + 512 + g * 128 + d8, v); load8f(p.in[I_SGULNG] + g * 128 + d8, lg); load8f(p.in[I_SGULNB] + g * 128 + d8, lb);
                const float mean = stats[2 * s], rstd = stats[2 * s + 1];
#pragma unroll
                for (int q = 0; q < 8; ++q) { v[q] = (geluf_(v[q]) - mean) * rstd * lg[q] + lb[q]; vT[(d8 + q) * 136 + swz(d8 + q, s)] = (bf16_t)f2bf(v[q]); }
                if (sb >= 0) { float* o = p.out + O_SGUV + (size_t)(sb * 32 + s) * 512 + g * 128 + d8; *(f32x4*)o = (f32x4){v[0], v[1], v[2], v[3]}; *(f32x4*)(o + 4) = (f32x4){v[4], v[5], v[6], v[7]}; }
            } else {
#pragma unroll
                for (int q = 0; q < 8; ++q) vT[(d8 + q) * 136 + swz(d8 + q, s)] = (bf16_t)0; } }
        __syncthreads();
        if (wv * 16 < nvalid) {
            f32x4 acc[8];
#pragma unroll
            for (int q = 0; q < 8; ++q) acc[q] = (f32x4){0.f, 0.f, 0.f, 0.f};
            const int nks = (wv + 2) >> 1;
            for (int ks = 0; ks < nks; ++ks) { const bf16x8 wf = *(const bf16x8*)(sguW + g * 16384 + (wv * 16 + (lane & 15)) * 128 + ks * 32 + 8 * (lane >> 4));
#pragma unroll
                for (int q = 0; q < 8; ++q) { const int dr = q * 16 + (lane & 15); const bf16x8 vf = *(const LAS bf16x8*)(vT + dr * 136 + swz(dr, ks * 32 + 8 * (lane >> 4))); acc[q] = mfma16(vf, wf, acc[q]); } }
            const int t = wv * 16 + (lane & 15);
            if (t < nvalid) { const float bias = p.in[I_SGUB][g * 128 + t];
#pragma unroll
                for (int q = 0; q < 8; ++q) { const int d0 = q * 16 + (lane >> 4) * 4; const u32x2 uw = *(const u32x2*)(H1 + (size_t)(row0 + t) * NH1 + g * 128 + d0);
                    const float u0 = geluf_(bf2f(uw.x & 0xffffu)), u1 = geluf_(__uint_as_float(uw.x & 0xffff0000u)), u2 = geluf_(bf2f(uw.y & 0xffffu)), u3 = geluf_(__uint_as_float(uw.y & 0xffff0000u));
                    u32x2 o; o.x = pk2(u0 * (acc[q][0] + bias), u1 * (acc[q][1] + bias)); o.y = pk2(u2 * (acc[q][2] + bias), u3 * (acc[q][3] + bias));
                    *(u32x2*)(MIX + (size_t)(row0 + t) * D + g * 128 + d0) = o; } } }
        __syncthreads();
    }
}

__device__ __forceinline__ void ssm_conv8(const CAS Params& p, const bf16_t* H1, int row0, int t, int col8, int sb, bool first, float (&o)[8]) {
    float a[8]; load8f(p.in[I_SSMCB] + col8, a);
    float xv[4][8], wk[4][8];
#pragma unroll
    for (int k = 0; k < 4; ++k) { const int tok = t - 3 + k; const int tokc = (tok < 0 && (first || sb >= 0)) ? 0 : tok;
        load8bf(H1 + (size_t)(row0 + tokc) * NH1 + 1536 + col8, xv[k]); load8f(p.in[I_SSMCW] + k * 1024 + col8, wk[k]); }
    if (sb >= 0) {
#pragma unroll
        for (int k = 0; k < 3; ++k) { const int tok = t - 3 + k; if (tok < 0) load8f(p.in[I_STSSMCONV] + (size_t)(sb * 3 + 3 + tok) * 1024 + col8, xv[k]); }
    } else if (first) {
#pragma unroll
        for (int k = 0; k < 3; ++k) { const bool hist = (t - 3 + k) < 0;
#pragma unroll
            for (int q = 0; q < 8; ++q) xv[k][q] = hist ? 0.f : xv[k][q]; }
    }
#pragma unroll
    for (int k = 0; k < 4; ++k)
#pragma unroll
        for (int q = 0; q < 8; ++q) a[q] += wk[k][q] * xv[k][q];
#pragma unroll
    for (int q = 0; q < 8; ++q) o[q] = siluf_(a[q]);
}
__device__ __forceinline__ void ssd_dt(int wid_s, const CAS Params& p, int row0, int nvalid, int g, LAS float* acum, LAS float* dtv, float* dec_out  ) {
    const int lane = lane_id_(), wv = wid_s, tid = wv * 64 + lane;
    if (wv < 4) { const int h = 4 * g + wv; const float* DT = (const float*)(p.ws + WS_DT);
        float dt = 0.f; if (lane < nvalid) dt = softplusf_(DT[(size_t)(row0 + lane) * 8 + h] + p.in[I_DTB][h]);
        const float a = -__expf(p.in[I_ALOG][h]); float v = dt * a;
#pragma unroll
        for (int o = 1; o < 64; o <<= 1) { const float t = __shfl_up(v, o); if (lane >= o) v += t; }
        acum[wv * 64 + lane] = v; dtv[wv * 64 + lane] = dt;
        if (dec_out != nullptr && lane == 63) dec_out[h] = __expf(v); }
}
__device__ __forceinline__ void ssd_chunk_geom(int ci, int& row0, int& nvalid, int& sb, bool& first) {
    if (ci < 256) { row0 = ci * 64; nvalid = 64; sb = -1; first = (ci & 127) == 0; } else { sb = ci - 256; row0 = MP + sb * 32; nvalid = 32; first = false; }
}
__device__ __forceinline__ void ssd_stepA(int wid_s, const CAS Params& p, LAS unsigned char* lds, int task) {
    const int lane = lane_id_(), wv = wid_s, tid = wv * 64 + lane;
    const int ci = task >> 1, g = task & 1; int row0, nvalid, sb; bool first; ssd_chunk_geom(ci, row0, nvalid, sb, first);
    const bf16_t* H1 = (const bf16_t*)(p.ws + WS_REGA);
    LAS bf16_t* xT = (LAS bf16_t*)lds; LAS bf16_t* BT = (LAS bf16_t*)(lds + 36864); LAS float* acum = (LAS float*)(lds + 55296); LAS float* dtv = (LAS float*)(lds + 56320);
    ssd_dt(wid_s, p, row0, nvalid, g, acum, dtv, (float*)(p.ws + WS_DEC) + ci * 8);
    float vv[6][8];
#pragma unroll
    for (int j = 0; j < 6; ++j) { const int blk = (tid >> 6) + 8 * j, t = (blk & 7) * 8 + (lane >> 3), cc = (blk >> 3) * 8 + (lane & 7);
        const int col = (cc < 32) ? 256 * g + cc * 8 : 512 + 128 * g + (cc - 32) * 8;
        if (t < nvalid) ssm_conv8(p, H1, row0, t, col, sb, first, vv[j]);
        else {
#pragma unroll
            for (int q = 0; q < 8; ++q) vv[j][q] = 0.f; } }
    __syncthreads();
#pragma unroll
    for (int j = 0; j < 6; ++j) { const int blk = (tid >> 6) + 8 * j, t = (blk & 7) * 8 + (lane >> 3), cc = (blk >> 3) * 8 + (lane & 7);
        if (cc < 32) { const int c8 = cc * 8, hh = c8 >> 6; const float te = __expf(acum[hh * 64 + 63] - acum[hh * 64 + t]) * dtv[hh * 64 + t];
#pragma unroll
            for (int q = 0; q < 8; ++q) xT[(c8 + q) * 72 + swz(c8 + q, t)] = (bf16_t)f2bf(vv[j][q] * te);
        } else { const int c8 = (cc - 32) * 8;
#pragma unroll
            for (int q = 0; q < 8; ++q) BT[(c8 + q) * 72 + swz(c8 + q, t)] = (bf16_t)f2bf(vv[j][q]); } }
    __syncthreads();
    f32x4 acc[2][8];
#pragma unroll
    for (int q = 0; q < 2; ++q)
#pragma unroll
        for (int nt = 0; nt < 8; ++nt) acc[q][nt] = (f32x4){0.f, 0.f, 0.f, 0.f};
#pragma unroll
    for (int ks = 0; ks < 2; ++ks) { bf16x8 xf[2];
#pragma unroll
        for (int q = 0; q < 2; ++q) { const int pr = (2 * wv + q) * 16 + (lane & 15); xf[q] = *(const LAS bf16x8*)(xT + pr * 72 + swz(pr, ks * 32 + 8 * (lane >> 4))); }
#pragma unroll
        for (int nt = 0; nt < 8; ++nt) { const int nr = nt * 16 + (lane & 15); const bf16x8 bf = *(const LAS bf16x8*)(BT + nr * 72 + swz(nr, ks * 32 + 8 * (lane >> 4)));
#pragma unroll
            for (int q = 0; q < 2; ++q) acc[q][nt] = mfma16(bf, xf[q], acc[q][nt]); } }
    float* Sb = (float*)(p.ws + WS_SSAMP) + (size_t)(sb >= 0 ? sb : 0) * 65536; bf16_t* Sb16 = (bf16_t*)(p.ws + WS_XB) + (size_t)ci * 65536;
#pragma unroll
    for (int q = 0; q < 2; ++q) { const int pall = (2 * wv + q) * 16 + (lane & 15), h = 4 * g + (pall >> 6), pp = pall & 63;
#pragma unroll
        for (int nt = 0; nt < 8; ++nt) { const size_t o = (size_t)(h * 64 + pp) * 128 + nt * 16 + (lane >> 4) * 4;
            if (sb >= 0) *(f32x4*)(Sb + o) = acc[q][nt];
            else { u32x2 w; w.x = pk2(acc[q][nt][0], acc[q][nt][1]); w.y = pk2(acc[q][nt][2], acc[q][nt][3]); *(u32x2*)(Sb16 + o) = w; } } }
    __syncthreads();
}
__device__ __forceinline__ void ssd_stepB(int wid_s, const CAS Params& p) {
    const size_t gtid = (size_t)blockIdx.x * 512 + TIDX, gstride = (size_t)gridDim.x * 512;
    const float* DEC = (const float*)(p.ws + WS_DEC);
    for (size_t e = gtid; e < 131072; e += gstride) { const int b = (int)(e >> 16), rem = (int)(e & 65535), h = rem >> 13;
        bf16_t* sp = (bf16_t*)(p.ws + WS_XB) + (size_t)b * 128 * 65536 + rem; float st = 0.f;
        for (int c0 = 0; c0 < 128; c0 += 8) { float s[8], dc[8];
#pragma unroll
            for (int i = 0; i < 8; ++i) { s[i] = bf2f((unsigned)sp[(size_t)(c0 + i) * 65536]); dc[i] = DEC[(b * 128 + c0 + i) * 8 + h]; }
#pragma unroll
            for (int i = 0; i < 8; ++i) { sp[(size_t)(c0 + i) * 65536] = (bf16_t)f2bf(st); st = st * dc[i] + s[i]; } }
        p.out[O_SSMP + e] = st; }
    const float* SS = (const float*)(p.ws + WS_SSAMP);
    for (size_t e = gtid; e < 524288; e += gstride) { const int sb = (int)(e >> 16), h = (int)(e & 65535) >> 13;
        p.out[O_SSMS + e] = p.in[I_STSSM][e] * DEC[(256 + sb) * 8 + h] + SS[e]; }
    const bf16_t* H1 = (const bf16_t*)(p.ws + WS_REGA);
    for (size_t e = gtid; e < 6144 + 24576; e += gstride) {
        if (e < 6144) { const int b = (int)e / 3072, j = ((int)e % 3072) >> 10, c = (int)e & 1023; p.out[O_SCP + e] = bf2f(H1[(size_t)(b * SEQ + SEQ - 3 + j) * NH1 + 1536 + c]); }
        else { const int e2 = (int)e - 6144, sb = e2 / 3072, j = (e2 % 3072) >> 10, c = e2 & 1023; p.out[O_SCS + e2] = bf2f(H1[(size_t)(MP + sb * 32 + 29 + j) * NH1 + 1536 + c]); } }
}
__device__ __forceinline__ void ssd_stepC(int wid_s, const CAS Params& p, LAS unsigned char* lds, int task) {
    const int lane = lane_id_(), wv = wid_s, tid = wv * 64 + lane;
    const int ci = task >> 1, g = task & 1; int row0, nvalid, sb; bool first; ssd_chunk_geom(ci, row0, nvalid, sb, first);
    const bf16_t* H1 = (const bf16_t*)(p.ws + WS_REGA); bf16_t* MIX = (bf16_t*)(p.ws + WS_MIX);
    LAS bf16_t* xT = (LAS bf16_t*)lds; LAS bf16_t* Bm = (LAS bf16_t*)(lds + 36864); LAS bf16_t* Cm = (LAS bf16_t*)(lds + 54272); LAS bf16_t* Mm = (LAS bf16_t*)(lds + 71680);
    LAS float* acum = (LAS float*)(lds + 108544); LAS float* dtv = (LAS float*)(lds + 109568); LAS float* ssq = (LAS float*)(lds + 110592);
    bf16x8 hfp[4][2];
#pragma unroll
    for (int ks = 0; ks < 4; ++ks)
#pragma unroll
        for (int q = 0; q < 2; ++q) { const int pall = (2 * wv + q) * 16 + (lane & 15), pp = pall & 63; const size_t o = (size_t)((4 * g + (wv >> 1)) * 64 + pp) * 128 + ks * 32 + 8 * (lane >> 4);
            if (sb >= 0) { float hv[8]; load8f(p.in[I_STSSM] + (size_t)sb * 65536 + o, hv); const u32x4 w = pack8(hv); hfp[ks][q] = __builtin_bit_cast(bf16x8, w); }
            else hfp[ks][q] = *(const bf16x8*)((const bf16_t*)(p.ws + WS_XB) + (size_t)ci * 65536 + o); }
    ssd_dt(wid_s, p, row0, nvalid, g, acum, dtv, nullptr);
    { float vv[8][8];
#pragma unroll
        for (int j = 0; j < 8; ++j) { const int blk = (tid >> 6) + 8 * j, t = (blk & 7) * 8 + (lane >> 3), cc = (blk >> 3) * 8 + (lane & 7);
            const int col = (cc < 32) ? 256 * g + cc * 8 : (cc < 48) ? 512 + 128 * g + (cc - 32) * 8 : 768 + 128 * g + (cc - 48) * 8;
            if (t < nvalid) ssm_conv8(p, H1, row0, t, col, sb, first, vv[j]);
            else {
#pragma unroll
                for (int q = 0; q < 8; ++q) vv[j][q] = 0.f; } }
#pragma unroll
        for (int j = 0; j < 8; ++j) { const int blk = (tid >> 6) + 8 * j, t = (blk & 7) * 8 + (lane >> 3), cc = (blk >> 3) * 8 + (lane & 7);
            if (cc < 32) {
#pragma unroll
                for (int q = 0; q < 8; ++q) xT[(cc * 8 + q) * 72 + swz(cc * 8 + q, t)] = (bf16_t)f2bf(vv[j][q]); }
            else if (cc < 48) *(LAS u32x4*)(Bm + t * 136 + (cc - 32) * 8) = pack8(vv[j]);
            else *(LAS u32x4*)(Cm + t * 136 + (cc - 48) * 8) = pack8(vv[j]); } }
    __syncthreads();
    { const int tt = wv >> 1;
#pragma unroll
        for (int q = 0; q < 2; ++q) { const int st = (wv & 1) * 2 + q; f32x4 acc = (f32x4){0.f, 0.f, 0.f, 0.f};
            if (st <= tt) {
#pragma unroll
                for (int ks = 0; ks < 4; ++ks) { const bf16x8 cf = *(const LAS bf16x8*)(Cm + (tt * 16 + (lane & 15)) * 136 + ks * 32 + 8 * (lane >> 4));
                    const bf16x8 bf = *(const LAS bf16x8*)(Bm + (st * 16 + (lane & 15)) * 136 + ks * 32 + 8 * (lane >> 4)); acc = mfma16(cf, bf, acc); } }
            const int s = st * 16 + (lane & 15);
#pragma unroll
            for (int hh = 0; hh < 4; ++hh) { const float as = acum[hh * 64 + s], ds = dtv[hh * 64 + s];
#pragma unroll
                for (int r = 0; r < 4; ++r) { const int t = tt * 16 + (lane >> 4) * 4 + r; const float val = (s <= t) ? acc[r] * __expf(acum[hh * 64 + t] - as) * ds : 0.f;
                    Mm[(hh * 64 + t) * 72 + s] = (bf16_t)f2bf(val); } } } }
    __syncthreads();
    const int hh = wv >> 1, h = 4 * g + hh;
    f32x4 yi[4][2], yo[4][2];
#pragma unroll
    for (int tt = 0; tt < 4; ++tt)
#pragma unroll
        for (int q = 0; q < 2; ++q) { yi[tt][q] = (f32x4){0.f, 0.f, 0.f, 0.f}; yo[tt][q] = (f32x4){0.f, 0.f, 0.f, 0.f}; }
#pragma unroll
    for (int ks = 0; ks < 2; ++ks) { bf16x8 xf[2];
#pragma unroll
        for (int q = 0; q < 2; ++q) { const int pr = (2 * wv + q) * 16 + (lane & 15); xf[q] = *(const LAS bf16x8*)(xT + pr * 72 + swz(pr, ks * 32 + 8 * (lane >> 4))); }
#pragma unroll
        for (int tt = 0; tt < 4; ++tt) { const bf16x8 mf = *(const LAS bf16x8*)(Mm + (hh * 64 + tt * 16 + (lane & 15)) * 72 + ks * 32 + 8 * (lane >> 4));
#pragma unroll
            for (int q = 0; q < 2; ++q) yi[tt][q] = mfma16(xf[q], mf, yi[tt][q]); } }
#pragma unroll
    for (int ks = 0; ks < 4; ++ks) {
#pragma unroll
        for (int tt = 0; tt < 4; ++tt) { const bf16x8 cf = *(const LAS bf16x8*)(Cm + (tt * 16 + (lane & 15)) * 136 + ks * 32 + 8 * (lane >> 4));
#pragma unroll
            for (int q = 0; q < 2; ++q) yo[tt][q] = mfma16(hfp[ks][q], cf, yo[tt][q]); } }
    const float dsk = p.in[I_SSMD][h];
#pragma unroll
    for (int tt = 0; tt < 4; ++tt) { const int t = tt * 16 + (lane & 15); const float ea = __expf(acum[hh * 64 + t]); float sq = 0.f;
#pragma unroll
        for (int q = 0; q < 2; ++q) { const int pall = (2 * wv + q) * 16 + (lane >> 4) * 4;
            const u32x2 zw = *(const u32x2*)(H1 + (size_t)(row0 + (t < nvalid ? t : nvalid - 1)) * NH1 + 1024 + 256 * g + pall);
            const float z0 = bf2f(zw.x & 0xffffu), z1 = __uint_as_float(zw.x & 0xffff0000u), z2 = bf2f(zw.y & 0xffffu), z3 = __uint_as_float(zw.y & 0xffff0000u);
            const float zz[4] = {z0, z1, z2, z3};
#pragma unroll
            for (int r = 0; r < 4; ++r) { const float xv = bf2f((unsigned)xT[(pall + r) * 72 + swz(pall + r, t)]); const float y = yi[tt][q][r] + ea * yo[tt][q][r] + dsk * xv; const float gv = y * siluf_(zz[r]); yi[tt][q][r] = gv; sq += gv * gv; } }
        sq += __shfl_xor(sq, 16); sq += __shfl_xor(sq, 32);
        if ((lane >> 4) == 0) ssq[t * 8 + wv] = sq; }
    __syncthreads();
#pragma unroll
    for (int tt = 0; tt < 4; ++tt) { const int t = tt * 16 + (lane & 15);
        const f32x4 s0 = *(const LAS f32x4*)(ssq + t * 8), s1 = *(const LAS f32x4*)(ssq + t * 8 + 4);
        const float tot = (s0[0] + s0[1]) + (s0[2] + s0[3]) + (s1[0] + s1[1]) + (s1[2] + s1[3]); const float rs = 1.f / sqrtf(tot * (1.f / 256.f) + 1e-5f);
        if (t < nvalid) {
#pragma unroll
            for (int q = 0; q < 2; ++q) { const int pall = (2 * wv + q) * 16 + (lane >> 4) * 4; const f32x4 nw = *(const f32x4*)(p.in[I_SSMNW] + 256 * g + pall);
                u32x2 o; o.x = pk2(yi[tt][q][0] * rs * nw[0], yi[tt][q][1] * rs * nw[1]); o.y = pk2(yi[tt][q][2] * rs * nw[2], yi[tt][q][3] * rs * nw[3]);
                *(u32x2*)(MIX + (size_t)(row0 + t) * D + 512 + 256 * g + pall) = o; } } }
    __syncthreads();
}

#define XB_TMO      128
#define XB_XCNT(j)  (256  + 64 * (j))
#define XB_XSUB(j)  (1280 + 64 * (j))
#define XB_XGEN(j)  (2304 + 64 * (j))
#define XB_TOP      3328
#define XB_TOPGEN   3392
#define XCD_BAR_WORDS 3456
#define XB_SPIN_CAP (1u << 18)

__device__ __forceinline__ unsigned xb_ld(unsigned* p)              { return __hip_atomic_load(p, __ATOMIC_RELAXED, __HIP_MEMORY_SCOPE_AGENT); }
__device__ __forceinline__ unsigned xb_add(unsigned* p, unsigned v) { return __hip_atomic_fetch_add(p, v, __ATOMIC_RELAXED, __HIP_MEMORY_SCOPE_AGENT); }
__device__ __forceinline__ unsigned xb_xcc_id() { return (unsigned)__builtin_amdgcn_s_getreg((3 << 11) | 20) & 0xFu; }
#define XB_SPIN(cond, bar) do { unsigned _sp = 0; while (cond) { __builtin_amdgcn_s_sleep(1); \
    if ((++_sp & 255u) == 0u) { if (xb_ld(&(bar)[XB_TMO])) break; if (_sp > XB_SPIN_CAP) { atomicAdd(&(bar)[XB_TMO], 1u); break; } } } } while (0)

struct XcdBarrier {
    unsigned* bar; unsigned x;
    volatile LAS unsigned* st;
};

__device__ __forceinline__ XcdBarrier xcd_barrier_post(int wid_s, unsigned* bar, volatile LAS unsigned* st) {
    XcdBarrier b; b.bar = bar; b.x = xb_xcc_id(); b.st = st;
    if (TIDX == 0) (void)xb_add(&bar[XB_XCNT(b.x)], 1u);
    return b;
}
__device__ __forceinline__ void xcd_barrier_complete(unsigned* bar, unsigned x, unsigned& nloc, unsigned& nx) {
    const unsigned G = gridDim.x * gridDim.y * gridDim.z;
    unsigned sum, cnt, mine, sp = 0u;
    for (;;) {
        sum = 0u; cnt = 0u; mine = 0u;
#pragma unroll
        for (unsigned j = 0; j < 16; ++j) { const unsigned c = xb_ld(&bar[XB_XCNT(j)]); sum += c; cnt += (c > 0u) ? 1u : 0u; mine = (j == x) ? c : mine; }
        if (sum == G) break;
        __builtin_amdgcn_s_sleep(1);
        if ((++sp & 255u) == 0u) { if (xb_ld(&bar[XB_TMO])) break; if (sp > XB_SPIN_CAP) { atomicAdd(&bar[XB_TMO], 1u); break; } }
    }
    nloc = mine > 0u ? mine : 1u; nx = cnt > 0u ? cnt : 1u;
}

__device__ __forceinline__ void xcd_barrier(int wid_s, const XcdBarrier& b) {
    asm volatile("s_waitcnt vmcnt(0)" ::: "memory");
    __syncthreads();
    if (TIDX == 0) {
        unsigned* bar = b.bar;
        __builtin_amdgcn_s_waitcnt(0);
        unsigned nloc = b.st[0], nx = b.st[1];
        if (nloc == 0u) { xcd_barrier_complete(bar, b.x, nloc, nx); b.st[0] = nloc; b.st[1] = nx; }
        const unsigned old = xb_add(&bar[XB_XSUB(b.x)], 1u);
        const unsigned gen = old / nloc;
        if (old + 1u == (gen + 1u) * nloc) {
            __builtin_amdgcn_fence(__ATOMIC_RELEASE, "agent");
            asm volatile("s_waitcnt vmcnt(0)" ::: "memory");
            const unsigned og = xb_add(&bar[XB_TOP], 1u);
            const unsigned tg = og / nx;
            if (og + 1u == (tg + 1u) * nx) xb_add(&bar[XB_TOPGEN], 1u);
            else XB_SPIN(xb_ld(&bar[XB_TOPGEN]) == tg, bar);
            __builtin_amdgcn_fence(__ATOMIC_ACQUIRE, "agent");
            xb_add(&bar[XB_XGEN(b.x)], 1u);
            asm volatile("s_waitcnt vmcnt(0)" ::: "memory");
        } else {
            XB_SPIN(xb_ld(&bar[XB_XGEN(b.x)]) == gen, bar);
            __builtin_amdgcn_fence(__ATOMIC_ACQUIRE, "agent");
            asm volatile("s_waitcnt vmcnt(0)" ::: "memory");
        }
    }
    __syncthreads();
}

__global__ void __launch_bounds__(512, 2) mega_fwd(Params p_unused) {
    extern __shared__ __attribute__((aligned(16))) unsigned char lds_raw[];
    LAS unsigned char* lds = (LAS unsigned char*)lds_raw;
    cg::grid_group grid = cg::this_grid();
    const int wid_s = __builtin_amdgcn_readfirstlane((int)(__builtin_amdgcn_workitem_id_x() >> 6));
    { LAS unsigned* z = (LAS unsigned*)(lds + 131072); if (TIDX < 128) z[TIDX] = 0u; }
    __syncthreads();
    XcdBarrier bar = xcd_barrier_post(wid_s, (unsigned*)(kargs().ws + WS_CTL) + 4096, (volatile LAS unsigned*)(lds + 131072 + 32));
#define SEAM() xcd_barrier(wid_s, bar)
#define WSP(off) (kargs().ws + (off))
#define XFP (kargs().out + O_Y)
    p0_prep<0>(wid_s, kargs(), lds);
    if (gridDim.x == 0x7fffffffu) grid.sync();
    SEAM();
    { pg8::EpiStore E{(bf16_t*)WSP(WS_REGA), NH0, -1, nullptr}; run_gemm(wid_s, lds, (const bf16_t*)WSP(WS_XB), (const bf16_t*)WSP(WS_WINE), MP, NH0, D, E);
      FinStore F{(bf16_t*)WSP(WS_REGA), NH0}; mini_gemm_tail<4>(wid_s, lds, (const bf16_t*)WSP(WS_XB), (const bf16_t*)WSP(WS_WINE), D, F); }
    { pg8::EpiStore E{(bf16_t*)WSP(WS_PB), D, -1, nullptr}; run_gemm(wid_s, lds, (const bf16_t*)WSP(WS_PLEB), (const bf16_t*)WSP(WS_WPLE), MP, D, 256, E);
      FinStore F{(bf16_t*)WSP(WS_PB), D}; mini_gemm_tail<2>(wid_s, lds, (const bf16_t*)WSP(WS_PLEB), (const bf16_t*)WSP(WS_WPLE), 256, F); }
    SEAM();
    for (int ti = blockIdx.x; ti < 256; ti += gridDim.x) even_mixer_tile(wid_s, kargs(), lds, ti);
    for (int tt = blockIdx.x; tt < 48; tt += gridDim.x) even_mixer_part(wid_s, kargs(), lds, 256 + (tt & 7), tt >> 3);
    p0_prep<1>(wid_s, kargs(), lds);
    { const CAS Params& p = kargs(); const size_t gtid = (size_t)blockIdx.x * 512 + TIDX, gstride = (size_t)gridDim.x * 512; bf16_t* PLEB = (bf16_t*)(p.ws + WS_PLEB);
      cvt_f32_bf16(p.in[I_PP] + (size_t)MP * 256, PLEB, (size_t)MP * 256 / 4, gtid, gstride);
      cvt_f32_bf16(p.in[I_PS] + (size_t)MSAMP * 256, PLEB + (size_t)MP * 256, (size_t)MSAMP * 256 / 4, gtid, gstride); }
    SEAM();
    { pg8::EpiRes3<0> E{kargs().in[I_XP], nullptr, (bf16_t*)WSP(WS_XB), ((float*)WSP(WS_STATS) + 0 * MT), ((float*)WSP(WS_STATS) + 1 * MT), nullptr, nullptr, nullptr, nullptr}; run_gemm(wid_s, lds, (const bf16_t*)WSP(WS_MIX), (const bf16_t*)WSP(WS_WOUTE), MP, D, D, E);
      FinRes F{0, kargs().in[I_XS], nullptr, (bf16_t*)WSP(WS_XB), ((float*)WSP(WS_STATS) + 0 * MT), ((float*)WSP(WS_STATS) + 1 * MT), nullptr, nullptr, nullptr, nullptr}; mini_gemm_tail<2>(wid_s, lds, (const bf16_t*)WSP(WS_MIX), (const bf16_t*)WSP(WS_WOUTE), D, F); }
    SEAM();
    { pg8::EpiSwiGLU2 E{(bf16_t*)WSP(WS_REGA), ((float*)WSP(WS_STATS) + 0 * MT), ((float*)WSP(WS_STATS) + 1 * MT), (const float*)WSP(WS_CS13), (const float*)WSP(WS_CB13)}; run_gemm(wid_s, lds, (const bf16_t*)WSP(WS_XB), (const bf16_t*)WSP(WS_W13), MT, 2 * FF, D, E); }
    SEAM();
    { pg8::EpiRes3<2> E{nullptr, (const bf16_t*)WSP(WS_XB), (bf16_t*)WSP(WS_XB), ((float*)WSP(WS_STATS) + 2 * MT), ((float*)WSP(WS_STATS) + 3 * MT), ((float*)WSP(WS_STATS) + 0 * MT), ((float*)WSP(WS_STATS) + 1 * MT), kargs().in[I_LN1G], kargs().in[I_LN1B]}; run_gemm(wid_s, lds, (const bf16_t*)WSP(WS_REGA), (const bf16_t*)WSP(WS_W2), MP, D, FF, E);
      FinRes F{2, nullptr, (const bf16_t*)WSP(WS_XB), (bf16_t*)WSP(WS_XB), ((float*)WSP(WS_STATS) + 2 * MT), ((float*)WSP(WS_STATS) + 3 * MT), ((float*)WSP(WS_STATS) + 0 * MT), ((float*)WSP(WS_STATS) + 1 * MT), kargs().in[I_LN1G], kargs().in[I_LN1B]}; mini_gemm_tail<2>(wid_s, lds, (const bf16_t*)WSP(WS_REGA), (const bf16_t*)WSP(WS_W2), FF, F); }
    SEAM();
    { pg8::EpiGate3<false> E{(const bf16_t*)WSP(WS_XB), (const bf16_t*)WSP(WS_PB), nullptr, (bf16_t*)WSP(WS_MIX), (bf16_t*)(kargs().out + O_Y), ((float*)WSP(WS_STATS) + 2 * MT), ((float*)WSP(WS_STATS) + 3 * MT), (const float*)WSP(WS_CSG), (const float*)WSP(WS_CBG), kargs().in[I_LN2G], kargs().in[I_LN2B]}; run_gemm(wid_s, lds, (const bf16_t*)WSP(WS_XB), (const bf16_t*)WSP(WS_WG), MP, D, D, E);
      FinGate F{false, E.xr, E.P, nullptr, E.ob1, E.ob2, E.ssum, E.ssq, E.cs, E.cb, E.g, E.b}; mini_gemm_tail<2>(wid_s, lds, (const bf16_t*)WSP(WS_XB), (const bf16_t*)WSP(WS_WG), D, F); }
    SEAM();
    { pg8::EpiStore E{(bf16_t*)WSP(WS_REGA), NH1, 10, (float*)WSP(WS_DT)}; run_gemm(wid_s, lds, (const bf16_t*)WSP(WS_MIX), (const bf16_t*)WSP(WS_WINO), MT, NINO, D, E); }
    SEAM();
    if (gridDim.x == 256) {
        const int b = blockIdx.x;
        if (b < 136) { sgu_block(wid_s, kargs(), lds, b); ssd_stepA(wid_s, kargs(), lds, b); }
        else { for (int t = b; t < 528; t += 120) ssd_stepA(wid_s, kargs(), lds, t); if (b >= 240) ssd_stepC(wid_s, kargs(), lds, 512 + (b - 240)); }
    } else {
        for (int t = blockIdx.x; t < 136 + 528 + 16; t += gridDim.x) { if (t < 136) sgu_block(wid_s, kargs(), lds, t); else if (t < 664) ssd_stepA(wid_s, kargs(), lds, t - 136); else ssd_stepC(wid_s, kargs(), lds, 512 + (t - 664)); }
    }
    SEAM();
    ssd_stepB(wid_s, kargs());
    SEAM();
    for (int t = blockIdx.x; t < 512; t += gridDim.x) ssd_stepC(wid_s, kargs(), lds, t);
    SEAM();
    { pg8::EpiRes3<1> E{nullptr, (const bf16_t*)(kargs().out + O_Y), (bf16_t*)WSP(WS_XB), ((float*)WSP(WS_STATS) + 4 * MT), ((float*)WSP(WS_STATS) + 5 * MT), nullptr, nullptr, nullptr, nullptr}; run_gemm(wid_s, lds, (const bf16_t*)WSP(WS_MIX), (const bf16_t*)WSP(WS_WOUTO), MP, D, D, E);
      FinRes F{1, nullptr, (const bf16_t*)(kargs().out + O_Y), (bf16_t*)WSP(WS_XB), ((float*)WSP(WS_STATS) + 4 * MT), ((float*)WSP(WS_STATS) + 5 * MT), nullptr, nullptr, nullptr, nullptr}; mini_gemm_tail<2>(wid_s, lds, (const bf16_t*)WSP(WS_MIX), (const bf16_t*)WSP(WS_WOUTO), D, F); }
    { pg8::EpiStore E{(bf16_t*)WSP(WS_PB), D, -1, nullptr}; run_gemm(wid_s, lds, (const bf16_t*)WSP(WS_PLEB), (const bf16_t*)WSP(WS_WPLE + WPLE_BYTES), MP, D, 256, E);
      FinStore F{(bf16_t*)WSP(WS_PB), D}; mini_gemm_tail<2>(wid_s, lds, (const bf16_t*)WSP(WS_PLEB), (const bf16_t*)WSP(WS_WPLE + WPLE_BYTES), 256, F); }
    SEAM();
    { pg8::EpiSwiGLU2 E{(bf16_t*)WSP(WS_REGA), ((float*)WSP(WS_STATS) + 4 * MT), ((float*)WSP(WS_STATS) + 5 * MT), (const float*)WSP(WS_CS13) + 5632, (const float*)WSP(WS_CB13) + 5632}; run_gemm(wid_s, lds, (const bf16_t*)WSP(WS_XB), (const bf16_t*)WSP(WS_W13 + W13_BYTES), MT, 2 * FF, D, E); }
    SEAM();
    { pg8::EpiRes3<2> E{nullptr, (const bf16_t*)WSP(WS_XB), (bf16_t*)WSP(WS_XB), ((float*)WSP(WS_STATS) + 6 * MT), ((float*)WSP(WS_STATS) + 7 * MT), ((float*)WSP(WS_STATS) + 4 * MT), ((float*)WSP(WS_STATS) + 5 * MT), kargs().in[I_LN1G] + D, kargs().in[I_LN1B] + D}; run_gemm(wid_s, lds, (const bf16_t*)WSP(WS_REGA), (const bf16_t*)WSP(WS_W2 + W2_BYTES), MP, D, FF, E);
      FinRes F{2, nullptr, (const bf16_t*)WSP(WS_XB), (bf16_t*)WSP(WS_XB), ((float*)WSP(WS_STATS) + 6 * MT), ((float*)WSP(WS_STATS) + 7 * MT), ((float*)WSP(WS_STATS) + 4 * MT), ((float*)WSP(WS_STATS) + 5 * MT), kargs().in[I_LN1G] + D, kargs().in[I_LN1B] + D}; mini_gemm_tail<2>(wid_s, lds, (const bf16_t*)WSP(WS_REGA), (const bf16_t*)WSP(WS_W2 + W2_BYTES), FF, F); }
    SEAM();
    { pg8::EpiGate3<true> E{(const bf16_t*)WSP(WS_XB), (const bf16_t*)WSP(WS_PB), XFP, nullptr, nullptr, ((float*)WSP(WS_STATS) + 6 * MT), ((float*)WSP(WS_STATS) + 7 * MT), (const float*)WSP(WS_CSG) + D, (const float*)WSP(WS_CBG) + D, kargs().in[I_LN2G] + D, kargs().in[I_LN2B] + D}; run_gemm(wid_s, lds, (const bf16_t*)WSP(WS_XB), (const bf16_t*)WSP(WS_WG + WG_BYTES), MP, D, D, E);
      FinGate F{true, E.xr, E.P, E.outf, nullptr, nullptr, E.ssum, E.ssq, E.cs, E.cb, E.g, E.b}; mini_gemm_tail<2>(wid_s, lds, (const bf16_t*)WSP(WS_XB), (const bf16_t*)WSP(WS_WG + WG_BYTES), D, F); }
}

extern "C" void kernel_launch(void* const* d_in, const int* in_sizes, int n_in, void* d_out, int out_size, void* d_ws, size_t ws_size, hipStream_t stream) {
    static int grid = 0;
    if (grid == 0) {
        if (n_in != 34 || ws_size < WS_END2) { fprintf(stderr, "kernel_launch: unexpected n_in %d or ws_size %zu (need %zu)\n", n_in, ws_size, (size_t)WS_END2); grid = -1; return; }
        int dev = 0, cus = 0, per_cu = 0;
        hipGetDevice(&dev); hipDeviceGetAttribute(&cus, hipDeviceAttributeMultiprocessorCount, dev);
        hipFuncSetAttribute((const void*)mega_fwd, hipFuncAttributeMaxDynamicSharedMemorySize, LDS_BYTES);
        hipOccupancyMaxActiveBlocksPerMultiprocessor(&per_cu, (const void*)mega_fwd, 512, LDS_BYTES);
        (void)hipGetLastError();
        if (per_cu < 1) per_cu = 1;
        grid = cus;
        fprintf(stderr, "kernel_launch: cus %d per_cu %d grid %d\n", cus, per_cu, grid);
    }
    if (grid < 0) return;
    if (hipMemsetAsync((char*)d_ws + WS_CTL, 0, WS_STATS, stream) != hipSuccess) { fprintf(stderr, "memset failed\n"); return; }
    Params prm{};
    for (int i = 0; i < 34; ++i) prm.in[i] = (const float*)d_in[i];
    prm.out = (float*)d_out; prm.ws = (unsigned char*)d_ws;
    void* args[] = {&prm};
    hipError_t e = hipLaunchCooperativeKernel((const void*)mega_fwd, dim3(grid), dim3(512), args, LDS_BYTES, stream);
    if (e != hipSuccess) fprintf(stderr, "cooperative launch failed: %s (grid %d)\n", hipGetErrorString(e), grid);
}
```

```cpp
#include <hip/hip_runtime.h>
#include <hip/hip_cooperative_groups.h>
#include <cstdio>
#include <cstdint>
namespace cg = cooperative_groups;
namespace pg8 {
#define PG8_LAS __attribute__((address_space(3)))
typedef unsigned short bf16_t;
typedef short bf16x8 __attribute__((ext_vector_type(8)));
typedef float f32x4 __attribute__((ext_vector_type(4)));
typedef unsigned u32x4 __attribute__((ext_vector_type(4)));
constexpr int BM = 256, BK = 64, HALF = 128, HTB = HALF * BK * 2  , STAGE_BYTES = 8 * HTB, NXCD = 8, WGM = 8;

__host__ __device__ __forceinline__ int lds_byte(int r, int c) { const int st = (r >> 4) * 2 + (c >> 5), rr = r & 15, cc = c & 31, ob = rr * 64 + cc * 2; return st * 1024 + (ob ^ (((ob >> 9) & 1) << 5)); }
__host__ __device__ __forceinline__ void stage_rc(int b, int& R, int& C) { const int st = b / 1024, sb = b % 1024, swz = sb ^ (((sb >> 9) & 1) << 5); R = (st >> 1) * 16 + swz / 64; C = (st & 1) * 32 + (swz % 64) / 2; }
__host__ __device__ __forceinline__ int perm32(int rho) { const int n = rho >> 4, i = rho & 15; return 8 * (i >> 2) + 4 * n + (i & 3); }

struct Unit { int pm, pn, ko; };
struct Gemm { const bf16_t* A; const bf16_t* Bt; int M, N, K, KL; };

struct StaticOrder {
    int nM, nN, nwg, G, c;
    __host__ __device__ void init(int M, int N, int G_, int c_) { nM = M / BM; nN = N / BM; nwg = nM * nN; G = G_; c = c_; }
    __host__ __device__ bool next(int i, Unit& u) const {
        const long L = (long)i * G + c; if (L >= nwg) return false;
        int wgid = (int)L; { const int q = nwg / NXCD, r = nwg % NXCD, xcd = wgid % NXCD, off = wgid / NXCD; wgid = (xcd < r ? xcd * (q + 1) : r * (q + 1) + (xcd - r) * q) + off; }
        const int nig = WGM * nN, gid = wgid / nig, fm = gid * WGM, gsz = (nM - fm) < WGM ? (nM - fm) : WGM;
        u.pm = fm + ((wgid % nig) % gsz); u.pn = (wgid % nig) / gsz; u.ko = 0; return true;
    }
    __device__ __forceinline__ void a_ready(const Unit&) const {}
    __device__ __forceinline__ void done(const Unit&) const {}
};
__device__ __forceinline__ unsigned cvt_pk_bf16(float lo, float hi) { unsigned r; asm volatile("v_cvt_pk_bf16_f32 %0, %1, %2" : "=v"(r) : "v"(lo), "v"(hi)); return r; }
template <class Epi, class Sched, bool ALIGN_EPI = false, bool SP2 = false>
__device__ __forceinline__ void gemm_phase(int wid_s, PG8_LAS unsigned char* lds, const Gemm g, const Sched& S, const Epi& E) {
    int lane_ = (int)__builtin_amdgcn_mbcnt_hi(~0u, __builtin_amdgcn_mbcnt_lo(~0u, 0u)); asm volatile("" : "+v"(lane_)); const int wid = wid_s, lane = lane_, tid = wid * 64 + lane, wr = wid >> 2, wc = wid & 3, fr = lane & 15, fq = lane >> 4;
    const int K = g.K, nt = g.KL / BK;
    unsigned voffA[2], voffB[2];
#pragma unroll
    for (int i = 0; i < 2; ++i) { int R, C; stage_rc(tid * 16 + i * 8192, R, C); const int Rb = Epi::PERM ? ((R & ~31) + perm32(R & 31)) : R;
        voffA[i] = (unsigned)(R * K + C) * 2u; voffB[i] = (unsigned)(Rb * K + C) * 2u; }
    const size_t kstep = (size_t)(BK * 2);
    const size_t hstep = (size_t)HALF * K * 2;
    const size_t tstep = 2 * hstep;
    const unsigned ldsw = (unsigned)wid * 1024u;
    const int aoff = lds_byte(wr * 64 + fr, fq * 8), boff = lds_byte(wc * 32 + fr, fq * 8);
#define PG8_SA(b, h) (((b) * 2 + (h)) * HTB)
#define PG8_SB(b, h) ((4 + (b) * 2 + (h)) * HTB)
#define PG8_STAGE(bufoff, gbase, voff) do { _Pragma("unroll") for (int _i = 0; _i < 2; ++_i) \
        __builtin_amdgcn_global_load_lds((const unsigned*)((const char*)(gbase) + (voff)[_i]), (PG8_LAS unsigned*)(lds + (bufoff) + ldsw + _i * 8192), 16, 0, 0); } while (0)
#define PG8_LDA(dst, b, h) do { _Pragma("unroll") for (int m = 0; m < 4; ++m) _Pragma("unroll") for (int k = 0; k < 2; ++k) dst[m][k] = *(const PG8_LAS bf16x8*)(lds + PG8_SA(b, h) + aoff + m * 2048 + k * 1024); } while (0)
#define PG8_LDB(dst, b, h) do { _Pragma("unroll") for (int n = 0; n < 2; ++n) _Pragma("unroll") for (int k = 0; k < 2; ++k) dst[n][k] = *(const PG8_LAS bf16x8*)(lds + PG8_SB(b, h) + boff + n * 2048 + k * 1024); } while (0)
#define PG8_MMA(ai, bj, At, Bt) do { __builtin_amdgcn_s_setprio(1); _Pragma("unroll") for (int m = 0; m < 4; ++m) _Pragma("unroll") for (int n = 0; n < 2; ++n) _Pragma("unroll") for (int k = 0; k < 2; ++k) \
        acc[ai][bj][m][n] = __builtin_amdgcn_mfma_f32_16x16x32_bf16(Bt[n][k], At[m][k], acc[ai][bj][m][n], 0, 0, 0); __builtin_amdgcn_s_setprio(0); } while (0)
#define PG8_WAIT_V(n) asm volatile("s_waitcnt vmcnt(" #n ")" ::: "memory")
#define PG8_WAIT_L(n) asm volatile("s_waitcnt lgkmcnt(" #n ")" ::: "memory")
#define PG8_BAR __builtin_amdgcn_s_barrier()
#define PG8_SCHED __builtin_amdgcn_sched_barrier(0)
    Unit cur, nxt; int ui = 0;
    if (!S.next(0, cur)) return;
    f32x4 acc[2][2][4][2];
#pragma unroll
    for (int a = 0; a < 2; ++a)
#pragma unroll
        for (int b = 0; b < 2; ++b)
#pragma unroll
            for (int m = 0; m < 4; ++m)
#pragma unroll
                for (int n = 0; n < 2; ++n) acc[a][b][m][n] = (f32x4){0.f, 0.f, 0.f, 0.f};
    bf16x8 At[4][2], B0[2][2], B1[2][2];
    const char* cA = (const char*)g.A + (size_t)cur.pm * tstep + (size_t)cur.ko * 2; const char* cB = (const char*)g.Bt + (size_t)cur.pn * tstep + (size_t)cur.ko * 2;
    S.a_ready(cur);
    if constexpr (SP2) {
        PG8_STAGE(PG8_SB(0, 0), cB, voffB); PG8_STAGE(PG8_SB(0, 1), cB + hstep, voffB); PG8_STAGE(PG8_SA(0, 0), cA, voffA); PG8_STAGE(PG8_SA(0, 1), cA + hstep, voffA);
        if (wr == 1) PG8_BAR;
        PG8_WAIT_V(2); PG8_BAR;
        PG8_STAGE(PG8_SB(1, 0), cB + kstep, voffB); PG8_STAGE(PG8_SA(1, 0), cA + kstep, voffA); PG8_STAGE(PG8_SB(1, 1), cB + hstep + kstep, voffB);
        PG8_WAIT_V(6); PG8_BAR;
    } else {
        PG8_STAGE(PG8_SB(0, 0), cB, voffB); PG8_STAGE(PG8_SA(0, 0), cA, voffA); PG8_STAGE(PG8_SB(0, 1), cB + hstep, voffB); PG8_STAGE(PG8_SA(0, 1), cA + hstep, voffA);
        if (wr == 1) PG8_BAR;
        PG8_WAIT_V(4); PG8_BAR;
        PG8_STAGE(PG8_SB(1, 0), cB + kstep, voffB); PG8_STAGE(PG8_SA(1, 0), cA + kstep, voffA); PG8_STAGE(PG8_SB(1, 1), cB + hstep + kstep, voffB);
        PG8_WAIT_V(6); PG8_BAR;
    }
    for (;;) {
        const bool has_next = S.next(ui + 1, nxt);
        const char* nA = has_next ? (const char*)g.A + (size_t)nxt.pm * tstep + (size_t)nxt.ko * 2 : cA; const char* nB = has_next ? (const char*)g.Bt + (size_t)nxt.pn * tstep + (size_t)nxt.ko * 2 : cB;
        for (int t = 0; t < nt; t += 2) {
            const bool last = (t == nt - 2);
            const char* a1 = cA + (size_t)(t + 1) * kstep;
            const char* a2 = last ? nA : cA + (size_t)(t + 2) * kstep; const char* b2 = last ? nB : cB + (size_t)(t + 2) * kstep;
            const char* a3 = a2 + kstep; const char* b3 = b2 + kstep;
            if (last && has_next) S.a_ready(nxt);
            if constexpr (SP2) {
            PG8_LDB(B0, 0, 0); PG8_LDB(B1, 0, 1); PG8_SCHED; PG8_LDA(At, 0, 0); PG8_STAGE(PG8_SA(1, 1), a1 + hstep, voffA);
            PG8_WAIT_V(8); PG8_WAIT_L(0); PG8_BAR; PG8_MMA(0, 0, At, B0); PG8_MMA(0, 1, At, B1); PG8_BAR; PG8_SCHED;
            PG8_LDA(At, 0, 1); PG8_STAGE(PG8_SB(0, 0), b2, voffB); PG8_STAGE(PG8_SB(0, 1), b2 + hstep, voffB); PG8_STAGE(PG8_SA(0, 0), a2, voffA);
            PG8_WAIT_V(8); PG8_WAIT_L(0); PG8_BAR; PG8_MMA(1, 0, At, B0); PG8_MMA(1, 1, At, B1); PG8_BAR; PG8_SCHED;
            PG8_LDB(B0, 1, 0); PG8_LDB(B1, 1, 1); PG8_SCHED; PG8_LDA(At, 1, 0); PG8_STAGE(PG8_SA(0, 1), a2 + hstep, voffA);
            PG8_WAIT_V(8); PG8_WAIT_L(0); PG8_BAR; PG8_MMA(0, 0, At, B0); PG8_MMA(0, 1, At, B1); PG8_BAR; PG8_SCHED;
            PG8_LDA(At, 1, 1); PG8_STAGE(PG8_SB(1, 0), b3, voffB); PG8_STAGE(PG8_SB(1, 1), b3 + hstep, voffB); PG8_STAGE(PG8_SA(1, 0), a3, voffA);
            PG8_WAIT_V(8); PG8_WAIT_L(0); PG8_BAR; PG8_MMA(1, 0, At, B0); PG8_MMA(1, 1, At, B1); PG8_BAR; PG8_SCHED;
            } else {
            PG8_LDB(B0, 0, 0); PG8_SCHED; PG8_LDA(At, 0, 0); PG8_STAGE(PG8_SA(1, 1), a1 + hstep, voffA);
            PG8_WAIT_L(8); PG8_BAR; PG8_WAIT_L(0); PG8_MMA(0, 0, At, B0); PG8_BAR; PG8_SCHED;
            PG8_LDB(B1, 0, 1); PG8_STAGE(PG8_SB(0, 0), b2, voffB);
            PG8_BAR; PG8_WAIT_L(0); PG8_MMA(0, 1, At, B1); PG8_BAR;
            PG8_LDA(At, 0, 1); PG8_STAGE(PG8_SA(0, 0), a2, voffA);
            PG8_BAR; PG8_WAIT_L(0); PG8_MMA(1, 0, At, B0); PG8_BAR; PG8_SCHED;
            PG8_STAGE(PG8_SB(0, 1), b2 + hstep, voffB);
            PG8_WAIT_V(6); PG8_BAR; PG8_MMA(1, 1, At, B1); PG8_BAR;
            PG8_LDB(B0, 1, 0); PG8_SCHED; PG8_LDA(At, 1, 0); PG8_STAGE(PG8_SA(0, 1), a2 + hstep, voffA);
            PG8_WAIT_L(8); PG8_BAR; PG8_WAIT_L(0); PG8_MMA(0, 0, At, B0); PG8_BAR; PG8_SCHED;
            PG8_LDB(B1, 1, 1); PG8_STAGE(PG8_SB(1, 0), b3, voffB);
            PG8_BAR; PG8_WAIT_L(0); PG8_MMA(0, 1, At, B1); PG8_BAR;
            PG8_LDA(At, 1, 1); PG8_STAGE(PG8_SA(1, 0), a3, voffA);
            PG8_BAR; PG8_WAIT_L(0); PG8_MMA(1, 0, At, B0); PG8_BAR; PG8_SCHED;
            PG8_STAGE(PG8_SB(1, 1), b3 + hstep, voffB);
            PG8_WAIT_V(6); PG8_BAR; PG8_MMA(1, 1, At, B1); PG8_BAR;
            }
        }
        if constexpr (ALIGN_EPI) { if (wr == 0) PG8_BAR; }
        if constexpr (!Epi::AFTER_DRAIN) { E(acc, cur, wr, wc, fr, fq); S.done(cur); }
        if (!has_next) break;
#pragma unroll
        for (int a = 0; a < 2; ++a)
#pragma unroll
            for (int b = 0; b < 2; ++b)
#pragma unroll
                for (int m = 0; m < 4; ++m)
#pragma unroll
                    for (int n = 0; n < 2; ++n) acc[a][b][m][n] = (f32x4){0.f, 0.f, 0.f, 0.f};
        cur = nxt; cA = nA; cB = nB; ++ui;
        if constexpr (ALIGN_EPI) { if (wr == 1) PG8_BAR; }
    }
    PG8_WAIT_V(0);
    if constexpr (!ALIGN_EPI) { if (wr == 0) PG8_BAR; }
    PG8_BAR;
    if constexpr (Epi::AFTER_DRAIN) { E.fused(acc, cur, wr, wc, fr, fq, lds, wid, lane); S.done(cur); }
#undef PG8_SA
#undef PG8_SB
#undef PG8_STAGE
#undef PG8_LDA
#undef PG8_LDB
#undef PG8_MMA
#undef PG8_WAIT_V
#undef PG8_WAIT_L
#undef PG8_BAR
#undef PG8_SCHED
}
}

#define LAS __attribute__((address_space(3)))
typedef unsigned short bf16_t;
typedef short bf16x8 __attribute__((ext_vector_type(8)));
typedef float f32x4 __attribute__((ext_vector_type(4)));
typedef unsigned u32x4 __attribute__((ext_vector_type(4)));
typedef unsigned u32x2 __attribute__((ext_vector_type(2)));

constexpr int D = 1024, MP = 16384, MSAMP = 256, MT = MP + MSAMP, SEQ = 8192, FF = 2816;
constexpr int NH0 = 2048, NH1 = 2560, NINO = 2816;
constexpr float ALPHA = 1.41421356237f, LN_EPS = 1e-5f;
constexpr size_t MiB = 1u << 20;
constexpr size_t WS_CTL = 0, CTL_BYTES = 1 * MiB;
constexpr size_t WS_CS13 = 64 * 1024, WS_CB13 = 112 * 1024, WS_CSG = 160 * 1024, WS_CBG = 168 * 1024, WS_STATS = 256 * 1024;
static_assert(WS_STATS + 4 * 2 * 16640 * 4 <= CTL_BYTES, "ctl map");
constexpr size_t WS_WINE = 1 * MiB, WS_WOUTE = 5 * MiB, WS_WINO = 7 * MiB, WS_WOUTO = 12 * MiB + MiB / 2;
constexpr size_t WS_W13 = 14 * MiB + MiB / 2, W13_BYTES = 11 * MiB;
constexpr size_t WS_W2 = 36 * MiB + MiB / 2, W2_BYTES = 5 * MiB + MiB / 2;
constexpr size_t WS_WG = 47 * MiB + MiB / 2, WG_BYTES = 2 * MiB;
constexpr size_t WS_WPLE = 51 * MiB + MiB / 2, WPLE_BYTES = MiB / 2;
constexpr size_t WS_WPOOL = 52 * MiB + MiB / 2, WS_WSGU = WS_WPOOL + 131072;
constexpr size_t WS_PLEB = 53 * MiB;
constexpr size_t WS_XB = 61 * MiB + MiB / 4, ACT_BYTES = (size_t)MT * D * 2;
constexpr size_t WS_PB = WS_XB + ACT_BYTES, WS_MIX = WS_PB + ACT_BYTES, WS_REGA = WS_MIX + ACT_BYTES;
constexpr size_t WS_DT = WS_REGA + 82 * MiB, WS_SSAMP = WS_REGA + 83 * MiB, WS_DEC = WS_REGA + 86 * MiB;
constexpr size_t WS_END = WS_REGA + (size_t)MT * FF * 2, WS_SLAB4 = WS_END, WS_END2 = WS_END + 4 * MiB;
static_assert(WS_END2 <= 256 * MiB, "ws map");
static_assert(WS_DEC + 264 * 8 * 4 <= WS_END, "ws map tail");
constexpr size_t O_Y = 0, O_POOLP = 17039360, O_POOLS = 17054720, O_CONVP = 17116160, O_CONVS = 17118208, O_SGUV = 17126400,
                 O_SCP = 17257472, O_SCS = 17263616, O_SSMP = 17288192, O_SSMS = 17419264;
constexpr int LDS_BYTES = 147456;

struct Params { const float* in[34]; float* out; unsigned char* ws; };
#define CAS __attribute__((address_space(4)))
#if defined(__HIP_DEVICE_COMPILE__)
__device__ __forceinline__ const CAS Params& kargs() { const CAS Params* k = (const CAS Params*)__builtin_amdgcn_kernarg_segment_ptr(); asm volatile("" : "+s"(k)); return *k; }
#else
__device__ const CAS Params& kargs();
#endif
enum { I_XP = 0, I_XS, I_PP, I_PS, I_STPOOL, I_STCONV, I_STSSMCONV, I_STSSM, I_WINE, I_POOLW, I_POOLSC, I_CONVW, I_WOUTE, I_WINO, I_SGUW, I_SGUB, I_SGULNG, I_SGULNB,
       I_SSMCW, I_SSMCB, I_DTB, I_ALOG, I_SSMD, I_SSMNW, I_WOUTO, I_LN1G, I_LN1B, I_LN2G, I_LN2B, I_FF1, I_FF3, I_FF2, I_WPLE, I_WGATE };

__device__ __forceinline__ float bf2f(unsigned b) { return __uint_as_float(b << 16); }
__device__ __forceinline__ unsigned f2bf(float f) { unsigned u = __float_as_uint(f); return (u + 0x7fffu + ((u >> 16) & 1u)) >> 16; }
__device__ __forceinline__ unsigned pk2(float lo, float hi) { return f2bf(lo) | (f2bf(hi) << 16); }
__device__ __forceinline__ void unpack8(const u32x4 w, float (&v)[8]) {
    v[0] = bf2f(w.x & 0xffffu); v[1] = __uint_as_float(w.x & 0xffff0000u); v[2] = bf2f(w.y & 0xffffu); v[3] = __uint_as_float(w.y & 0xffff0000u);
    v[4] = bf2f(w.z & 0xffffu); v[5] = __uint_as_float(w.z & 0xffff0000u); v[6] = bf2f(w.w & 0xffffu); v[7] = __uint_as_float(w.w & 0xffff0000u); }
__device__ __forceinline__ u32x4 pack8(const float (&v)[8]) { u32x4 w; w.x = pk2(v[0], v[1]); w.y = pk2(v[2], v[3]); w.z = pk2(v[4], v[5]); w.w = pk2(v[6], v[7]); return w; }
__device__ __forceinline__ void load8bf(const bf16_t* p, float (&v)[8]) { unpack8(*(const u32x4*)p, v); }
__device__ __forceinline__ void load8f(const float* p, float (&v)[8]) { const f32x4 a = *(const f32x4*)p, b = *(const f32x4*)(p + 4); v[0] = a.x; v[1] = a.y; v[2] = a.z; v[3] = a.w; v[4] = b.x; v[5] = b.y; v[6] = b.z; v[7] = b.w; }
__device__ __forceinline__ float sigmoidf_(float x) { return __builtin_amdgcn_rcpf(1.0f + __expf(-x)); }
__device__ __forceinline__ float siluf_(float x) { return x * sigmoidf_(x); }
__device__ __forceinline__ float geluf_(float x) { const float y = 0.7978845608f * (x + 0.044715f * x * x * x); return x * sigmoidf_(2.0f * y); }
__device__ __forceinline__ float softplusf_(float x) { return x > 20.f ? x : log1pf(__expf(x)); }
__device__ __forceinline__ float wave_sum(float v) {
#pragma unroll
    for (int o = 1; o < 64; o <<= 1) v += __shfl_xor(v, o);
    return v; }
__device__ __forceinline__ f32x4 mfma16(bf16x8 a, bf16x8 b, f32x4 c) { return __builtin_amdgcn_mfma_f32_16x16x32_bf16(a, b, c, 0, 0, 0); }
#define LDS_WAIT() asm volatile("s_waitcnt lgkmcnt(0)" ::: "memory")
__device__ __forceinline__ int swz(int row, int col) { return col ^ (((row >> 3) & 7) << 3); }
__device__ __forceinline__ int lane_id_() { int l = (int)__builtin_amdgcn_mbcnt_hi(~0u, __builtin_amdgcn_mbcnt_lo(~0u, 0u)); asm volatile("" : "+v"(l)); return l; }
#define TIDX (wid_s * 64 + lane_id_())

namespace pg8 {
struct EpiStore { static constexpr bool PERM = true, AFTER_DRAIN = false;
    bf16_t* O; int ldc; int dt_pn; float* DT;
    __device__ __forceinline__ void operator()(const f32x4 (&acc)[2][2][4][2], const Unit& u, int wr, int wc, int fr_, int fq_) const {
        int fr = fr_, fq = fq_; asm volatile("" : "+v"(fr), "+v"(fq));
        const int row0 = u.pm * BM + wr * 64 + fr;
        if (u.pn == dt_pn) {
            if (wc == 0 && fq == 0) {
#pragma unroll
                for (int ai = 0; ai < 2; ++ai)
#pragma unroll
                    for (int m = 0; m < 4; ++m) { float* d = DT + (size_t)(row0 + ai * HALF + m * 16) * 8; *(f32x4*)d = acc[ai][0][m][0]; *(f32x4*)(d + 4) = acc[ai][0][m][1]; }
            }
            return;
        }
        const int col0 = u.pn * BM + wc * 32 + 8 * fq;
#pragma unroll
        for (int ai = 0; ai < 2; ++ai)
#pragma unroll
            for (int m = 0; m < 4; ++m) { bf16_t* rowp = O + (size_t)(row0 + ai * HALF + m * 16) * ldc + col0;
#pragma unroll
                for (int bj = 0; bj < 2; ++bj) { const f32x4 v0 = acc[ai][bj][m][0], v1 = acc[ai][bj][m][1];
                    u32x4 w; w.x = cvt_pk_bf16(v0[0], v0[1]); w.y = cvt_pk_bf16(v0[2], v0[3]); w.z = cvt_pk_bf16(v1[0], v1[1]); w.w = cvt_pk_bf16(v1[2], v1[3]);
                    *(u32x4*)(rowp + bj * HALF) = w; } }
    }
};
struct EpiRes { static constexpr bool PERM = false, AFTER_DRAIN = false;
    const float* base; const float* base_s; float* out;
    __device__ __forceinline__ void operator()(const f32x4 (&acc)[2][2][4][2], const Unit& u, int wr, int wc, int fr_, int fq_) const {
        int fr = fr_, fq = fq_; asm volatile("" : "+v"(fr), "+v"(fq));
        const int row0 = u.pm * BM + wr * 64 + fr, col0 = u.pn * BM + wc * 32 + 4 * fq;
#pragma unroll
        for (int ai = 0; ai < 2; ++ai)
#pragma unroll
            for (int m = 0; m < 4; ++m) { const int r = row0 + ai * HALF + m * 16;
                const float* bp = (base_s != nullptr && r >= MP) ? base_s + (size_t)(r - MP) * D : base + (size_t)r * D; float* op = out + (size_t)r * D;
#pragma unroll
                for (int bj = 0; bj < 2; ++bj)
#pragma unroll
                    for (int n = 0; n < 2; ++n) { const int c = col0 + bj * HALF + n * 16; const f32x4 x = *(const f32x4*)(bp + c); *(f32x4*)(op + c) = x * ALPHA + acc[ai][bj][m][n]; }
                asm volatile("" ::: "memory"); }
    }
};
struct EpiSwiGLU { static constexpr bool PERM = true, AFTER_DRAIN = false;
    bf16_t* HF;
    __device__ __forceinline__ void operator()(const f32x4 (&acc)[2][2][4][2], const Unit& u, int wr, int wc, int fr_, int fq_) const {
        int fr = fr_, fq = fq_; asm volatile("" : "+v"(fr), "+v"(fq));
        const int row0 = u.pm * BM + wr * 64 + fr, col0 = u.pn * HALF + wc * 32 + 8 * fq;
#pragma unroll
        for (int ai = 0; ai < 2; ++ai)
#pragma unroll
            for (int m = 0; m < 4; ++m) { bf16_t* rowp = HF + (size_t)(row0 + ai * HALF + m * 16) * FF + col0;
                f32x4 h0, h1;
#pragma unroll
                for (int j = 0; j < 4; ++j) { h0[j] = siluf_(acc[ai][0][m][0][j]) * acc[ai][1][m][0][j]; h1[j] = siluf_(acc[ai][0][m][1][j]) * acc[ai][1][m][1][j]; }
                u32x4 w; w.x = cvt_pk_bf16(h0[0], h0[1]); w.y = cvt_pk_bf16(h0[2], h0[3]); w.z = cvt_pk_bf16(h1[0], h1[1]); w.w = cvt_pk_bf16(h1[2], h1[3]);
                *(u32x4*)rowp = w; asm volatile("" ::: "memory"); }
    }
};
struct EpiGate { static constexpr bool PERM = false, AFTER_DRAIN = false;
    const float* xf; const bf16_t* P; float* out; bf16_t* xb2;
    __device__ __forceinline__ void operator()(const f32x4 (&acc)[2][2][4][2], const Unit& u, int wr, int wc, int fr_, int fq_) const {
        int fr = fr_, fq = fq_; asm volatile("" : "+v"(fr), "+v"(fq));
        const int row0 = u.pm * BM + wr * 64 + fr, col0 = u.pn * BM + wc * 32 + 4 * fq;
#pragma unroll
        for (int ai = 0; ai < 2; ++ai)
#pragma unroll
            for (int m = 0; m < 4; ++m) { const size_t ro = (size_t)(row0 + ai * HALF + m * 16) * D;
#pragma unroll
                for (int bj = 0; bj < 2; ++bj)
#pragma unroll
                    for (int n = 0; n < 2; ++n) { const size_t o = ro + col0 + bj * HALF + n * 16; const f32x4 x = *(const f32x4*)(xf + o); const u32x2 pw = *(const u32x2*)(P + o);
                        const f32x4 a = acc[ai][bj][m][n]; f32x4 r;
                        r[0] = x[0] + bf2f(pw.x & 0xffffu) * sigmoidf_(a[0]); r[1] = x[1] + __uint_as_float(pw.x & 0xffff0000u) * sigmoidf_(a[1]);
                        r[2] = x[2] + bf2f(pw.y & 0xffffu) * sigmoidf_(a[2]); r[3] = x[3] + __uint_as_float(pw.y & 0xffff0000u) * sigmoidf_(a[3]);
                        *(f32x4*)(out + o) = r;
                        if (xb2) { u32x2 w; w.x = cvt_pk_bf16(r[0], r[1]); w.y = cvt_pk_bf16(r[2], r[3]); *(u32x2*)(xb2 + o) = w; } }
                asm volatile("" ::: "memory"); }
    }
};

__device__ __forceinline__ void row_stats(const float* ssum, const float* ssq, int r, float& mean, float& rstd) {
    const float s = ssum[r], q = ssq[r]; mean = s * (1.f / D); const float var = fmaxf(q * (1.f / D) - mean * mean, 0.f); rstd = 1.f / sqrtf(var + LN_EPS); }
template <int BASE> struct EpiRes3 { static constexpr bool PERM = false, AFTER_DRAIN = false;
    const float* basef; const bf16_t* baseb; bf16_t* xb; float* ssum; float* ssq; const float* pss; const float* psq; const float* g; const float* b;
    __device__ __forceinline__ void operator()(const f32x4 (&acc)[2][2][4][2], const Unit& u, int wr, int wc, int fr_, int fq_) const {
        int fr = fr_, fq = fq_; asm volatile("" : "+v"(fr), "+v"(fq));
        const int row0 = u.pm * BM + wr * 64 + fr, col0 = u.pn * BM + wc * 32 + 4 * fq;
        float mean[8], rstd[8], s1[8], s2[8];
#pragma unroll
        for (int i = 0; i < 8; ++i) { mean[i] = 0.f; rstd[i] = 1.f; s1[i] = 0.f; s2[i] = 0.f; if (BASE == 2) row_stats(pss, psq, row0 + (i >> 2) * HALF + (i & 3) * 16, mean[i], rstd[i]); }
#pragma unroll
        for (int bj = 0; bj < 2; ++bj)
#pragma unroll
            for (int n = 0; n < 2; ++n) { const int c = col0 + bj * HALF + n * 16; f32x4 gg, bb;
                if (BASE == 2) { gg = *(const f32x4*)(g + c); bb = *(const f32x4*)(b + c); }
#pragma unroll
                for (int i = 0; i < 8; ++i) { const int ai = i >> 2, m = i & 3; const size_t ro = (size_t)(row0 + ai * HALF + m * 16) * D; f32x4 x;
                    if (BASE == 0) x = *(const f32x4*)(basef + ro + c);
                    else { const u32x2 bw = *(const u32x2*)(baseb + ro + c); x = (f32x4){bf2f(bw.x & 0xffffu), __uint_as_float(bw.x & 0xffff0000u), bf2f(bw.y & 0xffffu), __uint_as_float(bw.y & 0xffff0000u)}; }
                    if (BASE == 2) x = (x - mean[i]) * rstd[i] * gg + bb;
                    const f32x4 v = x * ALPHA + acc[ai][bj][m][n];
                    u32x2 w; w.x = cvt_pk_bf16(v[0], v[1]); w.y = cvt_pk_bf16(v[2], v[3]); *(u32x2*)(xb + ro + c) = w;
                    s1[i] += (v[0] + v[1]) + (v[2] + v[3]); s2[i] += (v[0] * v[0] + v[1] * v[1]) + (v[2] * v[2] + v[3] * v[3]); }
                asm volatile("" ::: "memory"); }
#pragma unroll
        for (int i = 0; i < 8; ++i) { float a = s1[i], q = s2[i]; a += __shfl_xor(a, 16); a += __shfl_xor(a, 32); q += __shfl_xor(q, 16); q += __shfl_xor(q, 32);
            if (fq == 0) { const int r = row0 + (i >> 2) * HALF + (i & 3) * 16; atomicAdd(ssum + r, a); atomicAdd(ssq + r, q); } }
    }
};
struct EpiSwiGLU2 { static constexpr bool PERM = true, AFTER_DRAIN = false;
    bf16_t* HF; const float* ssum; const float* ssq; const float* cs; const float* cb;
    __device__ __forceinline__ void operator()(const f32x4 (&acc)[2][2][4][2], const Unit& u, int wr, int wc, int fr_, int fq_) const {
        int fr = fr_, fq = fq_; asm volatile("" : "+v"(fr), "+v"(fq));
        const int row0 = u.pm * BM + wr * 64 + fr, col0 = u.pn * HALF + wc * 32 + 8 * fq, cc0 = u.pn * BM + wc * 32 + 8 * fq;
        f32x4 csv[2][2], cbv[2][2];
#pragma unroll
        for (int bj = 0; bj < 2; ++bj)
#pragma unroll
            for (int n = 0; n < 2; ++n) { csv[bj][n] = *(const f32x4*)(cs + cc0 + bj * HALF + 4 * n); cbv[bj][n] = *(const f32x4*)(cb + cc0 + bj * HALF + 4 * n); }
#pragma unroll
        for (int ai = 0; ai < 2; ++ai)
#pragma unroll
            for (int m = 0; m < 4; ++m) { const int r = row0 + ai * HALF + m * 16; bf16_t* rowp = HF + (size_t)r * FF + col0;
                float mean, rstd; row_stats(ssum, ssq, r, mean, rstd);
                f32x4 h0, h1;
#pragma unroll
                for (int j = 0; j < 4; ++j) {
                    const float a0 = rstd * (acc[ai][0][m][0][j] - mean * csv[0][0][j]) + cbv[0][0][j], b0 = rstd * (acc[ai][1][m][0][j] - mean * csv[1][0][j]) + cbv[1][0][j];
                    const float a1 = rstd * (acc[ai][0][m][1][j] - mean * csv[0][1][j]) + cbv[0][1][j], b1 = rstd * (acc[ai][1][m][1][j] - mean * csv[1][1][j]) + cbv[1][1][j];
                    h0[j] = siluf_(a0) * b0; h1[j] = siluf_(a1) * b1; }
                u32x4 w; w.x = cvt_pk_bf16(h0[0], h0[1]); w.y = cvt_pk_bf16(h0[2], h0[3]); w.z = cvt_pk_bf16(h1[0], h1[1]); w.w = cvt_pk_bf16(h1[2], h1[3]);
                *(u32x4*)rowp = w; asm volatile("" ::: "memory"); }
    }
};
template <bool FINAL> struct EpiGate3 { static constexpr bool PERM = false, AFTER_DRAIN = false;
    const bf16_t* xr; const bf16_t* P; float* outf; bf16_t* ob1; bf16_t* ob2; const float* ssum; const float* ssq; const float* cs; const float* cb; const float* g; const float* b;
    __device__ __forceinline__ void operator()(const f32x4 (&acc)[2][2][4][2], const Unit& u, int wr, int wc, int fr_, int fq_) const {
        int fr = fr_, fq = fq_; asm volatile("" : "+v"(fr), "+v"(fq));
        const int row0 = u.pm * BM + wr * 64 + fr, col0 = u.pn * BM + wc * 32 + 4 * fq;
        float mean[8], rstd[8];
#pragma unroll
        for (int i = 0; i < 8; ++i) row_stats(ssum, ssq, row0 + (i >> 2) * HALF + (i & 3) * 16, mean[i], rstd[i]);
#pragma unroll
        for (int bj = 0; bj < 2; ++bj)
#pragma unroll
            for (int n = 0; n < 2; ++n) { const int c = col0 + bj * HALF + n * 16;
                const f32x4 gg = *(const f32x4*)(g + c), bb = *(const f32x4*)(b + c), c1 = *(const f32x4*)(cs + c), c2 = *(const f32x4*)(cb + c);
#pragma unroll
                for (int i = 0; i < 8; ++i) { const int ai = i >> 2, m = i & 3; const size_t o = (size_t)(row0 + ai * HALF + m * 16) * D + c;
                    const u32x2 rw = *(const u32x2*)(xr + o); const u32x2 pw = *(const u32x2*)(P + o);
                    const f32x4 rv = (f32x4){bf2f(rw.x & 0xffffu), __uint_as_float(rw.x & 0xffff0000u), bf2f(rw.y & 0xffffu), __uint_as_float(rw.y & 0xffff0000u)};
                    const f32x4 x = (rv - mean[i]) * rstd[i] * gg + bb; const f32x4 a = (acc[ai][bj][m][n] - c1 * mean[i]) * rstd[i] + c2; f32x4 o4;
                    o4[0] = x[0] + bf2f(pw.x & 0xffffu) * sigmoidf_(a[0]); o4[1] = x[1] + __uint_as_float(pw.x & 0xffff0000u) * sigmoidf_(a[1]);
                    o4[2] = x[2] + bf2f(pw.y & 0xffffu) * sigmoidf_(a[2]); o4[3] = x[3] + __uint_as_float(pw.y & 0xffff0000u) * sigmoidf_(a[3]);
                    if (FINAL) __builtin_nontemporal_store(o4, (f32x4*)(outf + o));
                    else { u32x2 w; w.x = cvt_pk_bf16(o4[0], o4[1]); w.y = cvt_pk_bf16(o4[2], o4[3]); *(u32x2*)(ob1 + o) = w; *(u32x2*)(ob2 + o) = w; } }
                asm volatile("" ::: "memory"); }
    }
};
}

template <class Epi>
__device__ __forceinline__ void run_gemm(int wid_s, LAS unsigned char* lds, const bf16_t* A, const bf16_t* Bt, int Mrows, int N, int K, const Epi& E) {
    pg8::Gemm g{A, Bt, Mrows, N, K, K}; pg8::StaticOrder S; S.init(Mrows, N, (int)gridDim.x, (int)blockIdx.x);
    pg8::gemm_phase<Epi, pg8::StaticOrder, true, true>(wid_s, lds, g, S, E);
}
namespace pg8 {
struct SplitOrder { int nN, nS, G, c;
    __device__ bool next(int i, Unit& u) const { const int L = i * G + c; if (L >= nN * nS) return false; u.pm = 64; u.pn = L % nN; u.ko = (L / nN) * 256; return true; }
    __device__ __forceinline__ void a_ready(const Unit&) const {}
    __device__ __forceinline__ void done(const Unit&) const {}
};
struct EpiSlab { static constexpr bool PERM = false, AFTER_DRAIN = false;
    float* slab;
    __device__ __forceinline__ void operator()(const f32x4 (&acc)[2][2][4][2], const Unit& u, int wr, int wc, int fr_, int fq_) const {
        int fr = fr_, fq = fq_; asm volatile("" : "+v"(fr), "+v"(fq));
        const int row0 = wr * 64 + fr, col0 = u.pn * BM + wc * 32 + 4 * fq; float* sp = slab + (size_t)(u.ko >> 8) * (256 * D);
#pragma unroll
        for (int ai = 0; ai < 2; ++ai)
#pragma unroll
            for (int m = 0; m < 4; ++m) { float* op = sp + (size_t)(row0 + ai * HALF + m * 16) * D;
#pragma unroll
                for (int bj = 0; bj < 2; ++bj)
#pragma unroll
                    for (int n = 0; n < 2; ++n) *(f32x4*)(op + col0 + bj * HALF + n * 16) = acc[ai][bj][m][n]; }
    }
};
}
__device__ __forceinline__ void run_gemm_split(int wid_s, LAS unsigned char* lds, const bf16_t* A, const bf16_t* Bt, int K, float* slab) {
    pg8::Gemm g{A, Bt, MT, D, K, 256}; pg8::SplitOrder S{4, K / 256, (int)gridDim.x, (int)(gridDim.x - 1 - blockIdx.x)}; pg8::EpiSlab E{slab};
    pg8::gemm_phase<pg8::EpiSlab, pg8::SplitOrder, true, true>(wid_s, lds, g, S, E);
}

template <int NCT, class Fin>
__device__ __forceinline__ void mini_gemm_tail(int wid_s, LAS unsigned char* lds, const bf16_t* A, const bf16_t* Bt, int K, const Fin& fin) {
    const int lane = lane_id_(), wv = wid_s, tid = wv * 64 + lane; LAS float* red = (LAS float*)lds; constexpr int NB = 16 * NCT;
    for (int blk = blockIdx.x; blk < 256; blk += gridDim.x) {
        const int rows0 = MP + (blk >> 5) * 32, cols0 = (blk & 31) * NB, kw = K >> 3;
        f32x4 acc[2][NCT];
#pragma unroll
        for (int rt = 0; rt < 2; ++rt)
#pragma unroll
            for (int ct = 0; ct < NCT; ++ct) acc[rt][ct] = (f32x4){0.f, 0.f, 0.f, 0.f};
        const bf16_t* ap = A + (size_t)(rows0 + (lane & 15)) * K + wv * kw + 8 * (lane >> 4);
        const bf16_t* bp = Bt + (size_t)(cols0 + (lane & 15)) * K + wv * kw + 8 * (lane >> 4);
#pragma unroll 4
        for (int k0 = 0; k0 < kw; k0 += 32) {
            const bf16x8 a0 = *(const bf16x8*)(ap + k0), a1 = *(const bf16x8*)(ap + (size_t)16 * K + k0);
#pragma unroll
            for (int ct = 0; ct < NCT; ++ct) { const bf16x8 bf = *(const bf16x8*)(bp + (size_t)(16 * ct) * K + k0); acc[0][ct] = mfma16(bf, a0, acc[0][ct]); acc[1][ct] = mfma16(bf, a1, acc[1][ct]); } }
#pragma unroll
        for (int rt = 0; rt < 2; ++rt)
#pragma unroll
            for (int ct = 0; ct < NCT; ++ct) *(LAS f32x4*)(red + ((wv * 32 + rt * 16 + (lane & 15)) * NB + ct * 16 + (lane >> 4) * 4)) = acc[rt][ct];
        __syncthreads();
        if (tid < 8 * NB) { const int row = tid / (NB / 4), cg = (tid % (NB / 4)) * 4; f32x4 s = (f32x4){0.f, 0.f, 0.f, 0.f};
#pragma unroll
            for (int w = 0; w < 8; ++w) s += *(const LAS f32x4*)(red + ((w * 32 + row) * NB + cg));
            fin(rows0 + row, cols0 + cg, s); }
        __syncthreads();
    }
}
struct FinStore { bf16_t* O; int ldc;
    __device__ __forceinline__ void operator()(int r, int c, const f32x4 acc) const { u32x2 w; w.x = pk2(acc[0], acc[1]); w.y = pk2(acc[2], acc[3]); *(u32x2*)(O + (size_t)r * ldc + c) = w; } };
struct FinRes { int kind; const float* basef; const bf16_t* baseb; bf16_t* xb; float* ssum; float* ssq; const float* pss; const float* psq; const float* g; const float* b;
    __device__ __forceinline__ void operator()(int r, int c, const f32x4 acc) const { const size_t o = (size_t)r * D + c; f32x4 x;
        if (kind == 0) x = *(const f32x4*)(basef + (size_t)(r - MP) * D + c);
        else { const u32x2 bw = *(const u32x2*)(baseb + o); x = (f32x4){bf2f(bw.x & 0xffffu), __uint_as_float(bw.x & 0xffff0000u), bf2f(bw.y & 0xffffu), __uint_as_float(bw.y & 0xffff0000u)}; }
        if (kind == 2) { float mean, rstd; pg8::row_stats(pss, psq, r, mean, rstd); x = (x - mean) * rstd * *(const f32x4*)(g + c) + *(const f32x4*)(b + c); }
        const f32x4 v = x * ALPHA + acc; u32x2 w; w.x = pk2(v[0], v[1]); w.y = pk2(v[2], v[3]); *(u32x2*)(xb + o) = w;
        float s1 = (v[0] + v[1]) + (v[2] + v[3]), s2 = (v[0] * v[0] + v[1] * v[1]) + (v[2] * v[2] + v[3] * v[3]);
        s1 += __shfl_xor(s1, 1); s1 += __shfl_xor(s1, 2); s1 += __shfl_xor(s1, 4); s2 += __shfl_xor(s2, 1); s2 += __shfl_xor(s2, 2); s2 += __shfl_xor(s2, 4);
        if ((c & 31) == 0) { atomicAdd(ssum + r, s1); atomicAdd(ssq + r, s2); } }
};
struct FinGate { bool final_; const bf16_t* xr; const bf16_t* P; float* outf; bf16_t* ob1; bf16_t* ob2; const float* ssum; const float* ssq; const float* cs; const float* cb; const float* g; const float* b;
    __device__ __forceinline__ void operator()(int r, int c, const f32x4 acc) const {
        float mean, rstd; pg8::row_stats(ssum, ssq, r, mean, rstd); const size_t o = (size_t)r * D + c;
        const u32x2 rw = *(const u32x2*)(xr + o); const u32x2 pw = *(const u32x2*)(P + o);
        const f32x4 gg = *(const f32x4*)(g + c), bb = *(const f32x4*)(b + c), c1 = *(const f32x4*)(cs + c), c2 = *(const f32x4*)(cb + c);
        const f32x4 rv = (f32x4){bf2f(rw.x & 0xffffu), __uint_as_float(rw.x & 0xffff0000u), bf2f(rw.y & 0xffffu), __uint_as_float(rw.y & 0xffff0000u)};
        const f32x4 x = (rv - mean) * rstd * gg + bb; const f32x4 a = (acc - c1 * mean) * rstd + c2; f32x4 o4;
        o4[0] = x[0] + bf2f(pw.x & 0xffffu) * sigmoidf_(a[0]); o4[1] = x[1] + __uint_as_float(pw.x & 0xffff0000u) * sigmoidf_(a[1]);
        o4[2] = x[2] + bf2f(pw.y & 0xffffu) * sigmoidf_(a[2]); o4[3] = x[3] + __uint_as_float(pw.y & 0xffff0000u) * sigmoidf_(a[3]);
        if (final_) __builtin_nontemporal_store(o4, (f32x4*)(outf + o));
        else { u32x2 w; w.x = pk2(o4[0], o4[1]); w.y = pk2(o4[2], o4[3]); *(u32x2*)(ob1 + o) = w; *(u32x2*)(ob2 + o) = w; } }
};

__device__ __forceinline__ void tr_item(const float* W, int ldw, int nvalid, int k0, int n0, bf16_t* WT, int ldt, int drow0, LAS float* scr, int lane,
                                        const float* gs = nullptr, const float* bs = nullptr, float* cs = nullptr, float* cb = nullptr) {
    float wv_[32];
#pragma unroll
    for (int i = 0; i < 32; ++i) { const int kk = 2 * i + (lane >> 5), n = n0 + (lane & 31); wv_[i] = (n < nvalid) ? W[(size_t)(k0 + kk) * ldw + n] : 0.f; }
#pragma unroll
    for (int i = 0; i < 32; ++i) scr[(2 * i + (lane >> 5)) * 33 + (lane & 31)] = wv_[i];
    LDS_WAIT();
    const int c = lane & 7;
    float gk[8], bk[8];
    if (gs != nullptr) { load8f(gs + k0 + 8 * c, gk); load8f(bs + k0 + 8 * c, bk); }
#pragma unroll
    for (int j = 0; j < 4; ++j) { const int n = (lane >> 3) + 8 * j; const LAS float* s = scr + (8 * c) * 33 + n; float w[8];
#pragma unroll
        for (int q = 0; q < 8; ++q) w[q] = s[q * 33];
        if (gs != nullptr) { float csp = 0.f, cbp = 0.f;
#pragma unroll
            for (int q = 0; q < 8; ++q) { cbp += w[q] * bk[q]; w[q] *= gk[q]; csp += bf2f(f2bf(w[q])); }
            csp += __shfl_xor(csp, 1); csp += __shfl_xor(csp, 2); csp += __shfl_xor(csp, 4); cbp += __shfl_xor(cbp, 1); cbp += __shfl_xor(cbp, 2); cbp += __shfl_xor(cbp, 4);
            if (c == 0 && n0 + n < nvalid) { atomicAdd(cs + drow0 + n, csp); atomicAdd(cb + drow0 + n, cbp); } }
        u32x4 o; o.x = pk2(w[0], w[1]); o.y = pk2(w[2], w[3]); o.z = pk2(w[4], w[5]); o.w = pk2(w[6], w[7]);
        if (n0 + n < nvalid) *(u32x4*)(WT + (size_t)(drow0 + n) * ldt + k0 + 8 * c) = o; }
    LDS_WAIT();
}
__device__ __forceinline__ void tr_plain(const float* W, int K, int N, bf16_t* WT, int item, LAS float* scr, int lane) {
    const int nblk = (N + 31) / 32, kb = item / nblk, nb = item % nblk; tr_item(W, N, N, 64 * kb, 32 * nb, WT, K, 32 * nb, scr, lane);
}
__device__ __forceinline__ void cvt_f32_bf16(const float* src, bf16_t* dst, size_t n4, size_t gtid, size_t gstride) {
    size_t i = gtid;
    for (; i + 7 * gstride < n4; i += 8 * gstride) { f32x4 v[8];
#pragma unroll
        for (int j = 0; j < 8; ++j) v[j] = *(const f32x4*)(src + 4 * (i + j * gstride));
#pragma unroll
        for (int j = 0; j < 8; ++j) { u32x2 w; w.x = pk2(v[j].x, v[j].y); w.y = pk2(v[j].z, v[j].w); *(u32x2*)(dst + 4 * (i + j * gstride)) = w; } }
    for (; i < n4; i += gstride) { const f32x4 v = *(const f32x4*)(src + 4 * i); u32x2 w; w.x = pk2(v.x, v.y); w.y = pk2(v.z, v.w); *(u32x2*)(dst + 4 * i) = w; }
}
template <int PART>
__device__ __forceinline__ void p0_prep(int wid_s, const CAS Params& p, LAS unsigned char* lds) {
    const int lane = lane_id_(), wv = wid_s, tid = wv * 64 + lane;
    LAS float* scr = (LAS float*)(lds + wv * 16384);
    const int gw = blockIdx.x * 8 + wv, NGW = gridDim.x * 8;
    unsigned char* ws = p.ws;
    constexpr int I_INE = 16 * 64, I_SQ = 16 * 32, I_INO = 16 * 81, I_F1 = 16 * 88, I_F2 = 44 * 32, I_PL = 4 * 32, I_POOL = 32;
    constexpr int PER_L = 2 * I_F1 + I_F2 + I_SQ + I_PL;
    constexpr int NITEMS = PART == 0 ? (I_INE + I_SQ + PER_L + I_POOL) : (I_INO + I_SQ + PER_L);
    constexpr int l = PART;
    for (int it = gw; it < NITEMS; it += NGW) {
        int r = it;
        if (PART == 0) {
            if (r < I_INE) { tr_plain(p.in[I_WINE], D, 2048, (bf16_t*)(ws + WS_WINE), r, scr, lane); continue; } r -= I_INE;
            if (r < I_SQ) { tr_plain(p.in[I_WOUTE], D, D, (bf16_t*)(ws + WS_WOUTE), r, scr, lane); continue; } r -= I_SQ;
        } else {
            if (r < I_INO) { tr_plain(p.in[I_WINO], D, 2568, (bf16_t*)(ws + WS_WINO), r, scr, lane); continue; } r -= I_INO;
            if (r < I_SQ) { tr_plain(p.in[I_WOUTO], D, D, (bf16_t*)(ws + WS_WOUTO), r, scr, lane); continue; } r -= I_SQ;
        }
        if (r < PER_L) {
            if (r < 2 * I_F1) { const int which = r / I_F1, rr = r % I_F1, kb = rr / 88, nb = rr % 88, n0 = 32 * nb;
                const float* W = p.in[which ? I_FF3 : I_FF1] + (size_t)l * D * FF;
                tr_item(W, FF, FF, 64 * kb, n0, (bf16_t*)(ws + WS_W13 + l * W13_BYTES), D, (n0 >> 7) * 256 + which * 128 + (n0 & 127), scr, lane,
                        p.in[I_LN1G] + l * D, p.in[I_LN1B] + l * D, (float*)(ws + WS_CS13) + l * 5632, (float*)(ws + WS_CB13) + l * 5632); continue; } r -= 2 * I_F1;
            if (r < I_F2) { tr_plain(p.in[I_FF2] + (size_t)l * FF * D, FF, D, (bf16_t*)(ws + WS_W2 + l * W2_BYTES), r, scr, lane); continue; } r -= I_F2;
            if (r < I_SQ) { const int kb = r / 32, nb = r % 32; tr_item(p.in[I_WGATE] + (size_t)l * D * D, D, D, 64 * kb, 32 * nb, (bf16_t*)(ws + WS_WG + l * WG_BYTES), D, 32 * nb, scr, lane,
                        p.in[I_LN2G] + l * D, p.in[I_LN2B] + l * D, (float*)(ws + WS_CSG) + l * D, (float*)(ws + WS_CBG) + l * D); continue; } r -= I_SQ;
            tr_plain(p.in[I_WPLE] + (size_t)l * 256 * D, 256, D, (bf16_t*)(ws + WS_WPLE + l * WPLE_BYTES), r, scr, lane); continue; }
        r -= PER_L;
        if (PART == 0) { const int g = r >> 3, rr = r & 7; tr_plain(p.in[I_POOLW] + g * 16384, 128, 128, (bf16_t*)(ws + WS_WPOOL) + g * 16384, rr, scr, lane); }
    }
    const size_t gtid = (size_t)blockIdx.x * 512 + tid, gstride = (size_t)gridDim.x * 512;
    if (PART == 0) {
        { u32x4* z = (u32x4*)(ws + WS_STATS); const size_t n = (size_t)4 * 2 * MT * 4 / 16; for (size_t i = gtid; i < n; i += gstride) z[i] = (u32x4){0u, 0u, 0u, 0u}; }
        cvt_f32_bf16(p.in[I_XP], (bf16_t*)(ws + WS_XB), (size_t)MP * D / 4, gtid, gstride);
        cvt_f32_bf16(p.in[I_XS], (bf16_t*)(ws + WS_XB) + (size_t)MP * D, (size_t)MSAMP * D / 4, gtid, gstride);
        cvt_f32_bf16(p.in[I_PP], (bf16_t*)(ws + WS_PLEB), (size_t)MP * 256 / 4, gtid, gstride);
        cvt_f32_bf16(p.in[I_PS], (bf16_t*)(ws + WS_PLEB) + (size_t)MP * 256, (size_t)MSAMP * 256 / 4, gtid, gstride);
    } else {
        { u32x4* z = (u32x4*)(ws + WS_WINO + (size_t)2568 * D * 2); const size_t n = (size_t)(NINO - 2568) * D * 2 / 16; for (size_t i = gtid; i < n; i += gstride) z[i] = (u32x4){0u, 0u, 0u, 0u}; }
        { bf16_t* o = (bf16_t*)(ws + WS_WSGU); const float* w = p.in[I_SGUW]; for (size_t i = gtid; i < 65536; i += gstride) { const int t = (int)(i >> 7) & 127, s = (int)i & 127; o[i] = (bf16_t)((s <= t) ? f2bf(w[i]) : 0u); } }
    }
}

__device__ __forceinline__ void ln_sample(int wid_s, bf16_t* xb, const float* slab, int nsl, const float* sbf, const bf16_t* sbb, float* ssum, float* ssq,
                                          const float* pss, const float* psq, const float* g, const float* b) {
    const int lane = lane_id_(), wv = wid_s;
    const int gw = blockIdx.x * 8 + wv, NGW = gridDim.x * 8;
    for (int m = MP + gw; m < MT; m += NGW) {
        f32x4 v[4];
        if (sbf != nullptr) { const f32x4* br = (const f32x4*)(sbf + (size_t)(m - MP) * D) + lane;
#pragma unroll
            for (int j = 0; j < 4; ++j) v[j] = br[64 * j]; }
        else { const u32x2* br = (const u32x2*)(sbb + (size_t)(m - MP) * D) + lane;
#pragma unroll
            for (int j = 0; j < 4; ++j) { const u32x2 bw = br[64 * j]; v[j] = (f32x4){bf2f(bw.x & 0xffffu), __uint_as_float(bw.x & 0xffff0000u), bf2f(bw.y & 0xffffu), __uint_as_float(bw.y & 0xffff0000u)}; } }
        if (pss != nullptr) { float mean, rstd; pg8::row_stats(pss, psq, m, mean, rstd);
#pragma unroll
            for (int j = 0; j < 4; ++j) v[j] = (v[j] - mean) * rstd * *(const f32x4*)(g + 4 * lane + 256 * j) + *(const f32x4*)(b + 4 * lane + 256 * j); }
#pragma unroll
        for (int j = 0; j < 4; ++j) v[j] = v[j] * ALPHA;
        for (int sl = 0; sl < nsl; ++sl) { const f32x4* sr = (const f32x4*)(slab + (size_t)sl * (256 * D) + (size_t)(m - MP) * D) + lane;
#pragma unroll
            for (int j = 0; j < 4; ++j) v[j] += sr[64 * j]; }
        float s = 0.f, q = 0.f;
#pragma unroll
        for (int j = 0; j < 4; ++j) { s += (v[j].x + v[j].y) + (v[j].z + v[j].w); q += (v[j].x * v[j].x + v[j].y * v[j].y) + (v[j].z * v[j].z + v[j].w * v[j].w); }
        s = wave_sum(s); q = wave_sum(q);
        if (lane == 0) { ssum[m] = s; ssq[m] = q; }
        u32x2* o8 = (u32x2*)(xb + (size_t)m * D) + lane;
#pragma unroll
        for (int j = 0; j < 4; ++j) { u32x2 w; w.x = pk2(v[j].x, v[j].y); w.y = pk2(v[j].z, v[j].w); o8[64 * j] = w; }
    }
}

__device__ __forceinline__ void even_mixer_tile(int wid_s, const CAS Params& p, LAS unsigned char* lds, int ti) {
    const int lane = lane_id_(), wv = wid_s, tid = wv * 64 + lane;
    int row0, nvalid, tpos0, sb = -1, b = 0;
    if (ti < 256) { row0 = ti * 64; nvalid = 64; tpos0 = row0 & (SEQ - 1); b = ti >> 7; } else { sb = ti - 256; row0 = MP + sb * 32; nvalid = 32; tpos0 = 4096; }
    const bf16_t* H0 = (const bf16_t*)(p.ws + WS_REGA); bf16_t* MIX = (bf16_t*)(p.ws + WS_MIX);
    const bf16_t* poolT = (const bf16_t*)(p.ws + WS_WPOOL);
    constexpr int LDA = 520;
    LAS bf16_t* A2 = (LAS bf16_t*)lds;
    const bool first = (sb < 0 && tpos0 == 0);
    const bool lasttile = (sb >= 0) || (tpos0 == SEQ - 64);
#pragma unroll 5
    for (int it = tid; it < 79 * 64; it += 512) { const int j = it >> 6, c8 = (it & 63) * 8, tok = j - 15; u32x4 w = (u32x4){0u, 0u, 0u, 0u};
        if (tok < nvalid) {
            if (tok >= 0 || (sb < 0 && !first)) w = *(const u32x4*)(H0 + (size_t)(row0 + tok) * NH0 + c8);
            else if (sb >= 0) { float v[8]; load8f(p.in[I_STPOOL] + (size_t)(sb * 15 + j) * 512 + c8, v); w = pack8(v); } }
        *(LAS u32x4*)(A2 + j * LDA + c8) = w; }
    __syncthreads();
    { const int c = tid, gi = c >> 7, w = 2 << gi; float W = 0.f;
        for (int k = 0; k < w; ++k) W += bf2f((unsigned)A2[(15 + 63 - k) * LDA + c]);
        const float inv = 1.f / (float)w;
        for (int t = 63; t >= 0; --t) { const float a = bf2f((unsigned)A2[(15 + t) * LDA + c]);
            if (lasttile && t < nvalid && t >= nvalid - 15) { const int j = t - (nvalid - 15); p.out[((sb >= 0) ? O_POOLS + (size_t)(sb * 15 + j) * 512 : O_POOLP + (size_t)(b * 15 + j) * 512) + c] = a; }
            const float sc = (first && t + 1 < w) ? 1.f / (float)(t + 1) : inv;
            const float d = W * sc - a;
            if (t > 0) W += bf2f((unsigned)A2[(15 + t - w) * LDA + c]) - a;
            A2[(15 + t) * LDA + c] = (bf16_t)f2bf(d); } }
    __syncthreads();
    { const int gi = wv >> 1, eb = (wv & 1) * 4; f32x4 acc[4][4];
#pragma unroll
        for (int tt = 0; tt < 4; ++tt)
#pragma unroll
            for (int q = 0; q < 4; ++q) acc[tt][q] = (f32x4){0.f, 0.f, 0.f, 0.f};
#pragma unroll
        for (int ks = 0; ks < 4; ++ks) { bf16x8 bfr[4];
#pragma unroll
            for (int q = 0; q < 4; ++q) bfr[q] = *(const bf16x8*)(poolT + gi * 16384 + ((eb + q) * 16 + (lane & 15)) * 128 + ks * 32 + 8 * (lane >> 4));
#pragma unroll
            for (int tt = 0; tt < 4; ++tt) { const bf16x8 af = *(const LAS bf16x8*)(A2 + (15 + tt * 16 + (lane & 15)) * LDA + gi * 128 + ks * 32 + 8 * (lane >> 4));
#pragma unroll
                for (int q = 0; q < 4; ++q) acc[tt][q] = mfma16(bfr[q], af, acc[tt][q]); } }
#pragma unroll
        for (int q = 0; q < 4; ++q) { const int e0 = (eb + q) * 16 + (lane >> 4) * 4; const f32x4 sc = *(const f32x4*)(p.in[I_POOLSC] + gi * 128 + e0);
#pragma unroll
            for (int tt = 0; tt < 4; ++tt) { const int t = tt * 16 + (lane & 15);
                if (t < nvalid) { u32x2 o; o.x = pk2(acc[tt][q][0] * sc[0], acc[tt][q][1] * sc[1]); o.y = pk2(acc[tt][q][2] * sc[2], acc[tt][q][3] * sc[3]);
                    *(u32x2*)(MIX + (size_t)(row0 + t) * D + gi * 128 + e0) = o; } } } }
    const float* cw = p.in[I_CONVW];
#pragma unroll 2
    for (int it = tid; it < nvalid * 64; it += 512) { const int t = it >> 6, c8 = (it & 63) * 8; float cg[3][8];
        { float cgt[3][8], hv[3][8];
#pragma unroll
            for (int dk = 0; dk < 3; ++dk) { const int tok = t - 2 + dk; const int tokc = (tok < 0 && (first || sb >= 0)) ? 0 : tok;
                load8bf(H0 + (size_t)(row0 + tokc) * NH0 + 1024 + c8, cgt[dk]); load8bf(H0 + (size_t)(row0 + tokc) * NH0 + 1536 + c8, hv[dk]); }
#pragma unroll
            for (int dk = 0; dk < 3; ++dk)
#pragma unroll
                for (int q = 0; q < 8; ++q) cg[dk][q] = cgt[dk][q] * hv[dk][q];
            if (sb >= 0) {
#pragma unroll
                for (int dk = 0; dk < 2; ++dk) { const int tok = t - 2 + dk; if (tok < 0) load8f(p.in[I_STCONV] + (size_t)(sb * 2 + 2 + tok) * 512 + c8, cg[dk]); }
            } else if (first) {
#pragma unroll
                for (int dk = 0; dk < 2; ++dk) { const bool hist = (t - 2 + dk) < 0;
#pragma unroll
                    for (int q = 0; q < 8; ++q) cg[dk][q] = hist ? 0.f : cg[dk][q]; } } }
        float bg[8], w0[8], w1[8], w2[8], y[8];
        load8bf(H0 + (size_t)(row0 + t) * NH0 + 512 + c8, bg); load8f(cw + c8, w0); load8f(cw + 512 + c8, w1); load8f(cw + 1024 + c8, w2);
#pragma unroll
        for (int q = 0; q < 8; ++q) y[q] = bg[q] * (w0[q] * cg[0][q] + w1[q] * cg[1][q] + w2[q] * cg[2][q]);
        *(u32x4*)(MIX + (size_t)(row0 + t) * D + 512 + c8) = pack8(y);
        if (lasttile && t >= nvalid - 2) { const int j = t - (nvalid - 2); float* o = p.out + ((sb >= 0) ? O_CONVS + (size_t)(sb * 2 + j) * 512 + c8 : O_CONVP + (size_t)(b * 2 + j) * 512 + c8);
            *(f32x4*)o = (f32x4){cg[2][0], cg[2][1], cg[2][2], cg[2][3]}; *(f32x4*)(o + 4) = (f32x4){cg[2][4], cg[2][5], cg[2][6], cg[2][7]}; }
    }
    __syncthreads();
}

__device__ __forceinline__ void even_mixer_part(int wid_s, const CAS Params& p, LAS unsigned char* lds, int ti, int part) {
    const int lane = lane_id_(), wv = wid_s, tid = wv * 64 + lane;
    int row0, nvalid, tpos0, sb = -1, b = 0;
    if (ti < 256) { row0 = ti * 64; nvalid = 64; tpos0 = row0 & (SEQ - 1); b = ti >> 7; } else { sb = ti - 256; row0 = MP + sb * 32; nvalid = 32; tpos0 = 4096; }
    const bf16_t* H0 = (const bf16_t*)(p.ws + WS_REGA); bf16_t* MIX = (bf16_t*)(p.ws + WS_MIX);
    const bf16_t* poolT = (const bf16_t*)(p.ws + WS_WPOOL);
    LAS float* araw = (LAS float*)lds; LAS bf16_t* dA = (LAS bf16_t*)(lds + 40448);
    const bool first = (sb < 0 && tpos0 == 0);
    const bool lasttile = (sb >= 0) || (tpos0 == SEQ - 64);
    if (part < 4) { const int gi = part;
        for (int it = tid; it < 79 * 16; it += 512) { const int j = it >> 4, c8 = (it & 15) * 8, tok = j - 15; float v[8];
#pragma unroll
            for (int q = 0; q < 8; ++q) v[q] = 0.f;
            if (tok < nvalid) {
                if (tok >= 0 || (sb < 0 && !first)) load8bf(H0 + (size_t)(row0 + tok) * NH0 + gi * 128 + c8, v);
                else if (sb >= 0) load8f(p.in[I_STPOOL] + (size_t)(sb * 15 + j) * 512 + gi * 128 + c8, v);
            }
            *(LAS f32x4*)(araw + j * 128 + c8) = (f32x4){v[0], v[1], v[2], v[3]}; *(LAS f32x4*)(araw + j * 128 + c8 + 4) = (f32x4){v[4], v[5], v[6], v[7]}; }
        __syncthreads();
        if (lasttile) { for (int it = tid; it < 15 * 128; it += 512) { const int j = it >> 7, c = it & 127, t = nvalid - 15 + j;
                const size_t o = (sb >= 0) ? O_POOLS + (size_t)(sb * 15 + j) * 512 + gi * 128 + c : O_POOLP + (size_t)(b * 15 + j) * 512 + gi * 128 + c;
                p.out[o] = araw[(15 + t) * 128 + c]; } }
        const int w = 2 << gi;
        for (int it = tid; it < 64 * 128; it += 512) { const int t = it >> 7, c = it & 127; float s = 0.f;
            for (int k = 0; k < w; ++k) s += araw[(15 + t - k) * 128 + c];
            const int cnt = first ? (w < t + 1 ? w : t + 1) : w;
            dA[t * 136 + c] = (bf16_t)f2bf(s / (float)cnt - araw[(15 + t) * 128 + c]); }
        __syncthreads();
        { const int tt = wv & 3, eb = (wv >> 2) * 4; f32x4 acc[4];
#pragma unroll
            for (int q = 0; q < 4; ++q) acc[q] = (f32x4){0.f, 0.f, 0.f, 0.f};
#pragma unroll
            for (int ks = 0; ks < 4; ++ks) { const bf16x8 af = *(const LAS bf16x8*)(dA + (tt * 16 + (lane & 15)) * 136 + ks * 32 + 8 * (lane >> 4));
#pragma unroll
                for (int q = 0; q < 4; ++q) { const bf16x8 bf = *(const bf16x8*)(poolT + gi * 16384 + ((eb + q) * 16 + (lane & 15)) * 128 + ks * 32 + 8 * (lane >> 4)); acc[q] = mfma16(bf, af, acc[q]); } }
            const int t = tt * 16 + (lane & 15);
            if (t < nvalid) {
#pragma unroll
                for (int q = 0; q < 4; ++q) { const int e0 = (eb + q) * 16 + (lane >> 4) * 4; const f32x4 sc = *(const f32x4*)(p.in[I_POOLSC] + gi * 128 + e0);
                    u32x2 o; o.x = pk2(acc[q][0] * sc[0], acc[q][1] * sc[1]); o.y = pk2(acc[q][2] * sc[2], acc[q][3] * sc[3]);
                    *(u32x2*)(MIX + (size_t)(row0 + t) * D + gi * 128 + e0) = o; } } }
        __syncthreads();
    }
    if (part < 4) return;
    const float* cw = p.in[I_CONVW];
    for (int it = tid; it < nvalid * 32; it += 512) { const int t = it >> 5, c8 = (part - 4) * 256 + (it & 31) * 8; float cg[3][8];
#pragma unroll
        for (int dk = 0; dk < 3; ++dk) { const int tok = t - 2 + dk;
            if (tok >= 0 || (sb < 0 && !first)) { float cgt[8], hv[8]; load8bf(H0 + (size_t)(row0 + tok) * NH0 + 1024 + c8, cgt); load8bf(H0 + (size_t)(row0 + tok) * NH0 + 1536 + c8, hv);
#pragma unroll
                for (int q = 0; q < 8; ++q) cg[dk][q] = cgt[q] * hv[q]; }
            else if (sb >= 0) { float hv[8]; load8f(p.in[I_STCONV] + (size_t)(sb * 2 + 2 + tok) * 512 + c8, hv);
#pragma unroll
                for (int q = 0; q < 8; ++q) cg[dk][q] = hv[q]; }
            else {
#pragma unroll
                for (int q = 0; q < 8; ++q) cg[dk][q] = 0.f; } }
        float bg[8], w0[8], w1[8], w2[8], y[8];
        load8bf(H0 + (size_t)(row0 + t) * NH0 + 512 + c8, bg); load8f(cw + c8, w0); load8f(cw + 512 + c8, w1); load8f(cw + 1024 + c8, w2);
#pragma unroll
        for (int q = 0; q < 8; ++q) y[q] = bg[q] * (w0[q] * cg[0][q] + w1[q] * cg[1][q] + w2[q] * cg[2][q]);
        *(u32x4*)(MIX + (size_t)(row0 + t) * D + 512 + c8) = pack8(y);
        if (lasttile && t >= nvalid - 2) { const int j = t - (nvalid - 2); float* o = p.out + ((sb >= 0) ? O_CONVS + (size_t)(sb * 2 + j) * 512 + c8 : O_CONVP + (size_t)(b * 2 + j) * 512 + c8);
            *(f32x4*)o = (f32x4){cg[2][0], cg[2][1], cg[2][2], cg[2][3]}; *(f32x4*)(o + 4) = (f32x4){cg[2][4], cg[2][5], cg[2][6], cg[2][7]}; }
    }
    __syncthreads();
}

__device__ __forceinline__ void sgu_block(int wid_s, const CAS Params& p, LAS unsigned char* lds, int bi) {
    const int lane = lane_id_(), wv = wid_s, tid = wv * 64 + lane;
    int row0, nvalid, sb = -1;
    if (bi < 128) { row0 = bi * 128; nvalid = 128; } else { sb = bi - 128; row0 = MP + sb * 32; nvalid = 32; }
    const bf16_t* H1 = (const bf16_t*)(p.ws + WS_REGA); bf16_t* MIX = (bf16_t*)(p.ws + WS_MIX); const bf16_t* sguW = (const bf16_t*)(p.ws + WS_WSGU);
    LAS float* stats = (LAS float*)lds; LAS bf16_t* vT = (LAS bf16_t*)(lds + 1024);
    { const int t = wv * 16 + (lane >> 2), sub = lane & 3;
        float s = 0.f, s2 = 0.f;
        if (t < nvalid) {
#pragma unroll 4
            for (int i = 0; i < 16; ++i) { float v[8]; load8bf(H1 + (size_t)(row0 + t) * NH1 + 512 + sub * 128 + i * 8, v);
#pragma unroll
                for (int q = 0; q < 8; ++q) { const float gv = geluf_(v[q]); s += gv; s2 += gv * gv; } } }
        s += __shfl_xor(s, 1); s += __shfl_xor(s, 2); s2 += __shfl_xor(s2, 1); s2 += __shfl_xor(s2, 2);
        const float mean = s * (1.f / 512.f), var = fmaxf(s2 * (1.f / 512.f) - mean * mean, 0.f);
        if (t < nvalid && sub == 0) { stats[2 * t] = mean; stats[2 * t + 1] = 1.f / sqrtf(var + LN_EPS); } }
    __syncthreads();
    for (int g = 0; g < 4; ++g) {
#pragma unroll 4
    for (int it = tid; it < 128 * 16; it += 512) { const int blk = it >> 6, s = (blk & 15) * 8 + (lane >> 3), d8 = ((blk >> 4) * 8 + (lane & 7)) * 8;
            if (s < nvalid) { float v[8], lg[8], lb[8]; load8bf(H1 + (size_t)(row0 + s) * NH1 + 512 + g * 128 + d8, v); load8f(p.in[I_SGULNG] + g * 128 + d8, lg); load8f(p.in[I_SGULNB] + g * 128 + d8, lb);
                const float mean = stats[2 * s], rstd = stats[2 * s + 1];
#pragma unroll
                for (int q = 0; q < 8; ++q) { v[q] = (geluf_(v[q]) - mean) * rstd * lg[q] + lb[q]; vT[(d8 + q) * 136 + swz(d8 + q, s)] = (bf16_t)f2bf(v[q]); }
                if (sb >= 0) { float* o = p.out + O_SGUV + (size_t)(sb * 32 + s) * 512 + g * 128 + d8; *(f32x4*)o = (f32x4){v[0], v[1], v[2], v[3]}; *(f32x4*)(o + 4) = (f32x4){v[4], v[5], v[6], v[7]}; }
            } else {
#pragma unroll
                for (int q = 0; q < 8; ++q) vT[(d8 + q) * 136 + swz(d8 + q, s)] = (bf16_t)0; } }
        __syncthreads();
        if (wv * 16 < nvalid) {
            f32x4 acc[8];
#pragma unroll
            for (int q = 0; q < 8; ++q) acc[q] = (f32x4){0.f, 0.f, 0.f, 0.f};
            const int nks = (wv + 2) >> 1;
            for (int ks = 0; ks < nks; ++ks) { const bf16x8 wf = *(const bf16x8*)(sguW + g * 16384 + (wv * 16 + (lane & 15)) * 128 + ks * 32 + 8 * (lane >> 4));
#pragma unroll
                for (int q = 0; q < 8; ++q) { const int dr = q * 16 + (lane & 15); const bf16x8 vf = *(const LAS bf16x8*)(vT + dr * 136 + swz(dr, ks * 32 + 8 * (lane >> 4))); acc[q] = mfma16(vf, wf, acc[q]); } }
            const int t = wv * 16 + (lane & 15);
            if (t < nvalid) { const float bias = p.in[I_SGUB][g * 128 + t];
#pragma unroll
                for (int q = 0; q < 8; ++q) { const int d0 = q * 16 + (lane >> 4) * 4; const u32x2 uw = *(const u32x2*)(H1 + (size_t)(row0 + t) * NH1 + g * 128 + d0);
                    const float u0 = geluf_(bf2f(uw.x & 0xffffu)), u1 = geluf_(__uint_as_float(uw.x & 0xffff0000u)), u2 = geluf_(bf2f(uw.y & 0xffffu)), u3 = geluf_(__uint_as_float(uw.y & 0xffff0000u));
                    u32x2 o; o.x = pk2(u0 * (acc[q][0] + bias), u1 * (acc[q][1] + bias)); o.y = pk2(u2 * (acc[q][2] + bias), u3 * (acc[q][3] + bias));
                    *(u32x2*)(MIX + (size_t)(row0 + t) * D + g * 128 + d0) = o; } } }
        __syncthreads();
    }
}

__device__ __forceinline__ void ssm_conv8(const CAS Params& p, const bf16_t* H1, int row0, int t, int col8, int sb, bool first, float (&o)[8]) {
    float a[8]; load8f(p.in[I_SSMCB] + col8, a);
    float xv[4][8], wk[4][8];
#pragma unroll
    for (int k = 0; k < 4; ++k) { const int tok = t - 3 + k; const int tokc = (tok < 0 && (first || sb >= 0)) ? 0 : tok;
        load8bf(H1 + (size_t)(row0 + tokc) * NH1 + 1536 + col8, xv[k]); load8f(p.in[I_SSMCW] + k * 1024 + col8, wk[k]); }
    if (sb >= 0) {
#pragma unroll
        for (int k = 0; k < 3; ++k) { const int tok = t - 3 + k; if (tok < 0) load8f(p.in[I_STSSMCONV] + (size_t)(sb * 3 + 3 + tok) * 1024 + col8, xv[k]); }
    } else if (first) {
#pragma unroll
        for (int k = 0; k < 3; ++k) { const bool hist = (t - 3 + k) < 0;
#pragma unroll
            for (int q = 0; q < 8; ++q) xv[k][q] = hist ? 0.f : xv[k][q]; }
    }
#pragma unroll
    for (int k = 0; k < 4; ++k)
#pragma unroll
        for (int q = 0; q < 8; ++q) a[q] += wk[k][q] * xv[k][q];
#pragma unroll
    for (int q = 0; q < 8; ++q) o[q] = siluf_(a[q]);
}
__device__ __forceinline__ void ssd_dt(int wid_s, const CAS Params& p, int row0, int nvalid, int g, LAS float* acum, LAS float* dtv, float* dec_out  ) {
    const int lane = lane_id_(), wv = wid_s, tid = wv * 64 + lane;
    if (wv < 4) { const int h = 4 * g + wv; const float* DT = (const float*)(p.ws + WS_DT);
        float dt = 0.f; if (lane < nvalid) dt = softplusf_(DT[(size_t)(row0 + lane) * 8 + h] + p.in[I_DTB][h]);
        const float a = -__expf(p.in[I_ALOG][h]); float v = dt * a;
#pragma unroll
        for (int o = 1; o < 64; o <<= 1) { const float t = __shfl_up(v, o); if (lane >= o) v += t; }
        acum[wv * 64 + lane] = v; dtv[wv * 64 + lane] = dt;
        if (dec_out != nullptr && lane == 63) dec_out[h] = __expf(v); }
}
__device__ __forceinline__ void ssd_chunk_geom(int ci, int& row0, int& nvalid, int& sb, bool& first) {
    if (ci < 256) { row0 = ci * 64; nvalid = 64; sb = -1; first = (ci & 127) == 0; } else { sb = ci - 256; row0 = MP + sb * 32; nvalid = 32; first = false; }
}
__device__ __forceinline__ void ssd_stepA(int wid_s, const CAS Params& p, LAS unsigned char* lds, int task) {
    const int lane = lane_id_(), wv = wid_s, tid = wv * 64 + lane;
    const int ci = task >> 1, g = task & 1; int row0, nvalid, sb; bool first; ssd_chunk_geom(ci, row0, nvalid, sb, first);
    const bf16_t* H1 = (const bf16_t*)(p.ws + WS_REGA);
    LAS bf16_t* xT = (LAS bf16_t*)lds; LAS bf16_t* BT = (LAS bf16_t*)(lds + 36864); LAS float* acum = (LAS float*)(lds + 55296); LAS float* dtv = (LAS float*)(lds + 56320);
    ssd_dt(wid_s, p, row0, nvalid, g, acum, dtv, (float*)(p.ws + WS_DEC) + ci * 8);
    float vv[6][8];
#pragma unroll
    for (int j = 0; j < 6; ++j) { const int blk = (tid >> 6) + 8 * j, t = (blk & 7) * 8 + (lane >> 3), cc = (blk >> 3) * 8 + (lane & 7);
        const int col = (cc < 32) ? 256 * g + cc * 8 : 512 + 128 * g + (cc - 32) * 8;
        if (t < nvalid) ssm_conv8(p, H1, row0, t, col, sb, first, vv[j]);
        else {
#pragma unroll
            for (int q = 0; q < 8; ++q) vv[j][q] = 0.f; } }
    __syncthreads();
#pragma unroll
    for (int j = 0; j < 6; ++j) { const int blk = (tid >> 6) + 8 * j, t = (blk & 7) * 8 + (lane >> 3), cc = (blk >> 3) * 8 + (lane & 7);
        if (cc < 32) { const int c8 = cc * 8, hh = c8 >> 6; const float te = __expf(acum[hh * 64 + 63] - acum[hh * 64 + t]) * dtv[hh * 64 + t];
#pragma unroll
            for (int q = 0; q < 8; ++q) xT[(c8 + q) * 72 + swz(c8 + q, t)] = (bf16_t)f2bf(vv[j][q] * te);
        } else { const int c8 = (cc - 32) * 8;
#pragma unroll
            for (int q = 0; q < 8; ++q) BT[(c8 + q) * 72 + swz(c8 + q, t)] = (bf16_t)f2bf(vv[j][q]); } }
    __syncthreads();
    f32x4 acc[2][8];
#pragma unroll
    for (int q = 0; q < 2; ++q)
#pragma unroll
        for (int nt = 0; nt < 8; ++nt) acc[q][nt] = (f32x4){0.f, 0.f, 0.f, 0.f};
#pragma unroll
    for (int ks = 0; ks < 2; ++ks) { bf16x8 xf[2];
#pragma unroll
        for (int q = 0; q < 2; ++q) { const int pr = (2 * wv + q) * 16 + (lane & 15); xf[q] = *(const LAS bf16x8*)(xT + pr * 72 + swz(pr, ks * 32 + 8 * (lane >> 4))); }
#pragma unroll
        for (int nt = 0; nt < 8; ++nt) { const int nr = nt * 16 + (lane & 15); const bf16x8 bf = *(const LAS bf16x8*)(BT + nr * 72 + swz(nr, ks * 32 + 8 * (lane >> 4)));
#pragma unroll
            for (int q = 0; q < 2; ++q) acc[q][nt] = mfma16(bf, xf[q], acc[q][nt]); } }
    float* Sb = (float*)(p.ws + WS_SSAMP) + (size_t)(sb >= 0 ? sb : 0) * 65536; bf16_t* Sb16 = (bf16_t*)(p.ws + WS_XB) + (size_t)ci * 65536;
#pragma unroll
    for (int q = 0; q < 2; ++q) { const int pall = (2 * wv + q) * 16 + (lane & 15), h = 4 * g + (pall >> 6), pp = pall & 63;
#pragma unroll
        for (int nt = 0; nt < 8; ++nt) { const size_t o = (size_t)(h * 64 + pp) * 128 + nt * 16 + (lane >> 4) * 4;
            if (sb >= 0) *(f32x4*)(Sb + o) = acc[q][nt];
            else { u32x2 w; w.x = pk2(acc[q][nt][0], acc[q][nt][1]); w.y = pk2(acc[q][nt][2], acc[q][nt][3]); *(u32x2*)(Sb16 + o) = w; } } }
    __syncthreads();
}
__device__ __forceinline__ void ssd_stepB(int wid_s, const CAS Params& p) {
    const size_t gtid = (size_t)blockIdx.x * 512 + TIDX, gstride = (size_t)gridDim.x * 512;
    const float* DEC = (const float*)(p.ws + WS_DEC);
    for (size_t e = gtid; e < 131072; e += gstride) { const int b = (int)(e >> 16), rem = (int)(e & 65535), h = rem >> 13;
        bf16_t* sp = (bf16_t*)(p.ws + WS_XB) + (size_t)b * 128 * 65536 + rem; float st = 0.f;
        for (int c0 = 0; c0 < 128; c0 += 8) { float s[8], dc[8];
#pragma unroll
            for (int i = 0; i < 8; ++i) { s[i] = bf2f((unsigned)sp[(size_t)(c0 + i) * 65536]); dc[i] = DEC[(b * 128 + c0 + i) * 8 + h]; }
#pragma unroll
            for (int i = 0; i < 8; ++i) { sp[(size_t)(c0 + i) * 65536] = (bf16_t)f2bf(st); st = st * dc[i] + s[i]; } }
        p.out[O_SSMP + e] = st; }
    const float* SS = (const float*)(p.ws + WS_SSAMP);
    for (size_t e = gtid; e < 524288; e += gstride) { const int sb = (int)(e >> 16), h = (int)(e & 65535) >> 13;
        p.out[O_SSMS + e] = p.in[I_STSSM][e] * DEC[(256 + sb) * 8 + h] + SS[e]; }
    const bf16_t* H1 = (const bf16_t*)(p.ws + WS_REGA);
    for (size_t e = gtid; e < 6144 + 24576; e += gstride) {
        if (e < 6144) { const int b = (int)e / 3072, j = ((int)e % 3072) >> 10, c = (int)e & 1023; p.out[O_SCP + e] = bf2f(H1[(size_t)(b * SEQ + SEQ - 3 + j) * NH1 + 1536 + c]); }
        else { const int e2 = (int)e - 6144, sb = e2 / 3072, j = (e2 % 3072) >> 10, c = e2 & 1023; p.out[O_SCS + e2] = bf2f(H1[(size_t)(MP + sb * 32 + 29 + j) * NH1 + 1536 + c]); } }
}
__device__ __forceinline__ void ssd_stepC(int wid_s, const CAS Params& p, LAS unsigned char* lds, int task) {
    const int lane = lane_id_(), wv = wid_s, tid = wv * 64 + lane;
    const int ci = task >> 1, g = task & 1; int row0, nvalid, sb; bool first; ssd_chunk_geom(ci, row0, nvalid, sb, first);
    const bf16_t* H1 = (const bf16_t*)(p.ws + WS_REGA); bf16_t* MIX = (bf16_t*)(p.ws + WS_MIX);
    LAS bf16_t* xT = (LAS bf16_t*)lds; LAS bf16_t* Bm = (LAS bf16_t*)(lds + 36864); LAS bf16_t* Cm = (LAS bf16_t*)(lds + 54272); LAS bf16_t* Mm = (LAS bf16_t*)(lds + 71680);
    LAS float* acum = (LAS float*)(lds + 108544); LAS float* dtv = (LAS float*)(lds + 109568); LAS float* ssq = (LAS float*)(lds + 110592);
    bf16x8 hfp[4][2];
#pragma unroll
    for (int ks = 0; ks < 4; ++ks)
#pragma unroll
        for (int q = 0; q < 2; ++q) { const int pall = (2 * wv + q) * 16 + (lane & 15), pp = pall & 63; const size_t o = (size_t)((4 * g + (wv >> 1)) * 64 + pp) * 128 + ks * 32 + 8 * (lane >> 4);
            if (sb >= 0) { float hv[8]; load8f(p.in[I_STSSM] + (size_t)sb * 65536 + o, hv); const u32x4 w = pack8(hv); hfp[ks][q] = __builtin_bit_cast(bf16x8, w); }
            else hfp[ks][q] = *(const bf16x8*)((const bf16_t*)(p.ws + WS_XB) + (size_t)ci * 65536 + o); }
    ssd_dt(wid_s, p, row0, nvalid, g, acum, dtv, nullptr);
    { float vv[8][8];
#pragma unroll
        for (int j = 0; j < 8; ++j) { const int blk = (tid >> 6) + 8 * j, t = (blk & 7) * 8 + (lane >> 3), cc = (blk >> 3) * 8 + (lane & 7);
            const int col = (cc < 32) ? 256 * g + cc * 8 : (cc < 48) ? 512 + 128 * g + (cc - 32) * 8 : 768 + 128 * g + (cc - 48) * 8;
            if (t < nvalid) ssm_conv8(p, H1, row0, t, col, sb, first, vv[j]);
            else {
#pragma unroll
                for (int q = 0; q < 8; ++q) vv[j][q] = 0.f; } }
#pragma unroll
        for (int j = 0; j < 8; ++j) { const int blk = (tid >> 6) + 8 * j, t = (blk & 7) * 8 + (lane >> 3), cc = (blk >> 3) * 8 + (lane & 7);
            if (cc < 32) {
#pragma unroll
                for (int q = 0; q < 8; ++q) xT[(cc * 8 + q) * 72 + swz(cc * 8 + q, t)] = (bf16_t)f2bf(vv[j][q]); }
            else if (cc < 48) *(LAS u32x4*)(Bm + t * 136 + (cc - 32) * 8) = pack8(vv[j]);
            else *(LAS u32x4*)(Cm + t * 136 + (cc - 48) * 8) = pack8(vv[j]); } }
    __syncthreads();
    { const int tt = wv >> 1;
#pragma unroll
        for (int q = 0; q < 2; ++q) { const int st = (wv & 1) * 2 + q; f32x4 acc = (f32x4){0.f, 0.f, 0.f, 0.f};
            if (st <= tt) {
#pragma unroll
                for (int ks = 0; ks < 4; ++ks) { const bf16x8 cf = *(const LAS bf16x8*)(Cm + (tt * 16 + (lane & 15)) * 136 + ks * 32 + 8 * (lane >> 4));
                    const bf16x8 bf = *(const LAS bf16x8*)(Bm + (st * 16 + (lane & 15)) * 136 + ks * 32 + 8 * (lane >> 4)); acc = mfma16(cf, bf, acc); } }
            const int s = st * 16 + (lane & 15);
#pragma unroll
            for (int hh = 0; hh < 4; ++hh) { const float as = acum[hh * 64 + s], ds = dtv[hh * 64 + s];
#pragma unroll
                for (int r = 0; r < 4; ++r) { const int t = tt * 16 + (lane >> 4) * 4 + r; const float val = (s <= t) ? acc[r] * __expf(acum[hh * 64 + t] - as) * ds : 0.f;
                    Mm[(hh * 64 + t) * 72 + s] = (bf16_t)f2bf(val); } } } }
    __syncthreads();
    const int hh = wv >> 1, h = 4 * g + hh;
    f32x4 yi[4][2], yo[4][2];
#pragma unroll
    for (int tt = 0; tt < 4; ++tt)
#pragma unroll
        for (int q = 0; q < 2; ++q) { yi[tt][q] = (f32x4){0.f, 0.f, 0.f, 0.f}; yo[tt][q] = (f32x4){0.f, 0.f, 0.f, 0.f}; }
#pragma unroll
    for (int ks = 0; ks < 2; ++ks) { bf16x8 xf[2];
#pragma unroll
        for (int q = 0; q < 2; ++q) { const int pr = (2 * wv + q) * 16 + (lane & 15); xf[q] = *(const LAS bf16x8*)(xT + pr * 72 + swz(pr, ks * 32 + 8 * (lane >> 4))); }
#pragma unroll
        for (int tt = 0; tt < 4; ++tt) { const bf16x8 mf = *(const LAS bf16x8*)(Mm + (hh * 64 + tt * 16 + (lane & 15)) * 72 + ks * 32 + 8 * (lane >> 4));
#pragma unroll
            for (int q = 0; q < 2; ++q) yi[tt][q] = mfma16(xf[q], mf, yi[tt][q]); } }
#pragma unroll
    for (int ks = 0; ks < 4; ++ks) {
#pragma unroll
        for (int tt = 0; tt < 4; ++tt) { const bf16x8 cf = *(const LAS bf16x8*)(Cm + (tt * 16 + (lane & 15)) * 136 + ks * 32 + 8 * (lane >> 4));
#pragma unroll
            for (int q = 0; q < 2; ++q) yo[tt][q] = mfma16(hfp[ks][q], cf, yo[tt][q]); } }
    const float dsk = p.in[I_SSMD][h];
#pragma unroll
    for (int tt = 0; tt < 4; ++tt) { const int t = tt * 16 + (lane & 15); const float ea = __expf(acum[hh * 64 + t]); float sq = 0.f;
#pragma unroll
        for (int q = 0; q < 2; ++q) { const int pall = (2 * wv + q) * 16 + (lane >> 4) * 4;
            const u32x2 zw = *(const u32x2*)(H1 + (size_t)(row0 + (t < nvalid ? t : nvalid - 1)) * NH1 + 1024 + 256 * g + pall);
            const float z0 = bf2f(zw.x & 0xffffu), z1 = __uint_as_float(zw.x & 0xffff0000u), z2 = bf2f(zw.y & 0xffffu), z3 = __uint_as_float(zw.y & 0xffff0000u);
            const float zz[4] = {z0, z1, z2, z3};
#pragma unroll
            for (int r = 0; r < 4; ++r) { const float xv = bf2f((unsigned)xT[(pall + r) * 72 + swz(pall + r, t)]); const float y = yi[tt][q][r] + ea * yo[tt][q][r] + dsk * xv; const float gv = y * siluf_(zz[r]); yi[tt][q][r] = gv; sq += gv * gv; } }
        sq += __shfl_xor(sq, 16); sq += __shfl_xor(sq, 32);
        if ((lane >> 4) == 0) ssq[t * 8 + wv] = sq; }
    __syncthreads();
#pragma unroll
    for (int tt = 0; tt < 4; ++tt) { const int t = tt * 16 + (lane & 15);
        const f32x4 s0 = *(const LAS f32x4*)(ssq + t * 8), s1 = *(const LAS f32x4*)(ssq + t * 8 + 4);
        const float tot = (s0[0] + s0[1]) + (s0[2] + s0[3]) + (s1[0] + s1[1]) + (s1[2] + s1[3]); const float rs = 1.f / sqrtf(tot * (1.f / 256.f) + 1e-5f);
        if (t < nvalid) {
#pragma unroll
            for (int q = 0; q < 2; ++q) { const int pall = (2 * wv + q) * 16 + (lane >> 4) * 4; const f32x4 nw = *(const f32x4*)(p.in[I_SSMNW] + 256 * g + pall);
                u32x2 o; o.x = pk2(yi[tt][q][0] * rs * nw[0], yi[tt][q][1] * rs * nw[1]); o.y = pk2(yi[tt][q][2] * rs * nw[2], yi[tt][q][3] * rs * nw[3]);
                *(u32x2*)(MIX + (size_t)(row0 + t) * D + 512 + 256 * g + pall) = o; } } }
    __syncthreads();
}

#define XB_TMO      128
#define XB_XCNT(j)  (256  + 64 * (j))
#define XB_XSUB(j)  (1280 + 64 * (j))
#define XB_XGEN(j)  (2304 + 64 * (j))
#define XB_TOP      3328
#define XB_TOPGEN   3392
#define XCD_BAR_WORDS 3456
#define XB_SPIN_CAP (1u << 18)

__device__ __forceinline__ unsigned xb_ld(unsigned* p)              { return __hip_atomic_load(p, __ATOMIC_RELAXED, __HIP_MEMORY_SCOPE_AGENT); }
__device__ __forceinline__ unsigned xb_add(unsigned* p, unsigned v) { return __hip_atomic_fetch_add(p, v, __ATOMIC_RELAXED, __HIP_MEMORY_SCOPE_AGENT); }
__device__ __forceinline__ unsigned xb_xcc_id() { return (unsigned)__builtin_amdgcn_s_getreg((3 << 11) | 20) & 0xFu; }
#define XB_SPIN(cond, bar) do { unsigned _sp = 0; while (cond) { __builtin_amdgcn_s_sleep(1); \
    if ((++_sp & 255u) == 0u) { if (xb_ld(&(bar)[XB_TMO])) break; if (_sp > XB_SPIN_CAP) { atomicAdd(&(bar)[XB_TMO], 1u); break; } } } } while (0)

struct XcdBarrier {
    unsigned* bar; unsigned x;
    volatile LAS unsigned* st;
};

__device__ __forceinline__ XcdBarrier xcd_barrier_post(int wid_s, unsigned* bar, volatile LAS unsigned* st) {
    XcdBarrier b; b.bar = bar; b.x = xb_xcc_id(); b.st = st;
    if (TIDX == 0) (void)xb_add(&bar[XB_XCNT(b.x)], 1u);
    return b;
}
__device__ __forceinline__ void xcd_barrier_complete(unsigned* bar, unsigned x, unsigned& nloc, unsigned& nx) {
    const unsigned G = gridDim.x * gridDim.y * gridDim.z;
    unsigned sum, cnt, mine, sp = 0u;
    for (;;) {
        sum = 0u; cnt = 0u; mine = 0u;
#pragma unroll
        for (unsigned j = 0; j < 16; ++j) { const unsigned c = xb_ld(&bar[XB_XCNT(j)]); sum += c; cnt += (c > 0u) ? 1u : 0u; mine = (j == x) ? c : mine; }
        if (sum == G) break;
        __builtin_amdgcn_s_sleep(1);
        if ((++sp & 255u) == 0u) { if (xb_ld(&bar[XB_TMO])) break; if (sp > XB_SPIN_CAP) { atomicAdd(&bar[XB_TMO], 1u); break; } }
    }
    nloc = mine > 0u ? mine : 1u; nx = cnt > 0u ? cnt : 1u;
}

__device__ __forceinline__ void xcd_barrier(int wid_s, const XcdBarrier& b) {
    asm volatile("s_waitcnt vmcnt(0)" ::: "memory");
    __syncthreads();
    if (TIDX == 0) {
        unsigned* bar = b.bar;
        __builtin_amdgcn_s_waitcnt(0);
        unsigned nloc = b.st[0], nx = b.st[1];
        if (nloc == 0u) { xcd_barrier_complete(bar, b.x, nloc, nx); b.st[0] = nloc; b.st[1] = nx; }
        const unsigned old = xb_add(&bar[XB_XSUB(b.x)], 1u);
        const unsigned gen = old / nloc;
        if (old + 1u == (gen + 1u) * nloc) {
            __builtin_amdgcn_fence(__ATOMIC_RELEASE, "agent");
            asm volatile("s_waitcnt vmcnt(0)" ::: "memory");
            const unsigned og = xb_add(&bar[XB_TOP], 1u);
            const unsigned tg = og / nx;
            if (og + 1u == (tg + 1u) * nx) xb_add(&bar[XB_TOPGEN], 1u);
            else XB_SPIN(xb_ld(&bar[XB_TOPGEN]) == tg, bar);
            __builtin_amdgcn_fence(__ATOMIC_ACQUIRE, "agent");
            xb_add(&bar[XB_XGEN(b.x)], 1u);
            asm volatile("s_waitcnt vmcnt(0)" ::: "memory");
        } else {
            XB_SPIN(xb_ld(&bar[XB_XGEN(b.x)]) == gen, bar);
            __builtin_amdgcn_fence(__ATOMIC_ACQUIRE, "agent");
            asm volatile("s_waitcnt vmcnt(0)" ::: "memory");
        }
    }
    __syncthreads();
}

__global__ void __launch_bounds__(512, 2) mega_fwd(Params p_unused) {
    extern __shared__ __attribute__((aligned(16))) unsigned char lds_raw[];
    LAS unsigned char* lds = (LAS unsigned char*)lds_raw;
    cg::grid_group grid = cg::this_grid();
    const int wid_s = __builtin_amdgcn_readfirstlane((int)(__builtin_amdgcn_workitem_id_x() >> 6));
    { LAS unsigned* z = (LAS unsigned*)(lds + 131072); if (TIDX < 128) z[TIDX] = 0u; }
    __syncthreads();
    XcdBarrier bar = xcd_barrier_post(wid_s, (unsigned*)(kargs().ws + WS_CTL) + 4096, (volatile LAS unsigned*)(lds + 131072 + 32));
#define SEAM() xcd_barrier(wid_s, bar)
#define WSP(off) (kargs().ws + (off))
#define XFP (kargs().out + O_Y)
    p0_prep<0>(wid_s, kargs(), lds);
    if (gridDim.x == 0x7fffffffu) grid.sync();
    SEAM();
    { pg8::EpiStore E{(bf16_t*)WSP(WS_REGA), NH0, -1, nullptr}; run_gemm(wid_s, lds, (const bf16_t*)WSP(WS_XB), (const bf16_t*)WSP(WS_WINE), MP, NH0, D, E);
      FinStore F{(bf16_t*)WSP(WS_REGA), NH0}; mini_gemm_tail<4>(wid_s, lds, (const bf16_t*)WSP(WS_XB), (const bf16_t*)WSP(WS_WINE), D, F); }
    { pg8::EpiStore E{(bf16_t*)WSP(WS_PB), D, -1, nullptr}; run_gemm(wid_s, lds, (const bf16_t*)WSP(WS_PLEB), (const bf16_t*)WSP(WS_WPLE), MP, D, 256, E);
      FinStore F{(bf16_t*)WSP(WS_PB), D}; mini_gemm_tail<2>(wid_s, lds, (const bf16_t*)WSP(WS_PLEB), (const bf16_t*)WSP(WS_WPLE), 256, F); }
    SEAM();
    for (int ti = blockIdx.x; ti < 256; ti += gridDim.x) even_mixer_tile(wid_s, kargs(), lds, ti);
    for (int tt = blockIdx.x; tt < 48; tt += gridDim.x) even_mixer_part(wid_s, kargs(), lds, 256 + (tt & 7), tt >> 3);
    p0_prep<1>(wid_s, kargs(), lds);
    { const CAS Params& p = kargs(); const size_t gtid = (size_t)blockIdx.x * 512 + TIDX, gstride = (size_t)gridDim.x * 512; bf16_t* PLEB = (bf16_t*)(p.ws + WS_PLEB);
      cvt_f32_bf16(p.in[I_PP] + (size_t)MP * 256, PLEB, (size_t)MP * 256 / 4, gtid, gstride);
      cvt_f32_bf16(p.in[I_PS] + (size_t)MSAMP * 256, PLEB + (size_t)MP * 256, (size_t)MSAMP * 256 / 4, gtid, gstride); }
    SEAM();
    { pg8::EpiRes3<0> E{kargs().in[I_XP], nullptr, (bf16_t*)WSP(WS_XB), ((float*)WSP(WS_STATS) + 0 * MT), ((float*)WSP(WS_STATS) + 1 * MT), nullptr, nullptr, nullptr, nullptr}; run_gemm(wid_s, lds, (const bf16_t*)WSP(WS_MIX), (const bf16_t*)WSP(WS_WOUTE), MP, D, D, E);
      FinRes F{0, kargs().in[I_XS], nullptr, (bf16_t*)WSP(WS_XB), ((float*)WSP(WS_STATS) + 0 * MT), ((float*)WSP(WS_STATS) + 1 * MT), nullptr, nullptr, nullptr, nullptr}; mini_gemm_tail<2>(wid_s, lds, (const bf16_t*)WSP(WS_MIX), (const bf16_t*)WSP(WS_WOUTE), D, F); }
    SEAM();
    { pg8::EpiSwiGLU2 E{(bf16_t*)WSP(WS_REGA), ((float*)WSP(WS_STATS) + 0 * MT), ((float*)WSP(WS_STATS) + 1 * MT), (const float*)WSP(WS_CS13), (const float*)WSP(WS_CB13)}; run_gemm(wid_s, lds, (const bf16_t*)WSP(WS_XB), (const bf16_t*)WSP(WS_W13), MT, 2 * FF, D, E); }
    SEAM();
    { pg8::EpiRes3<2> E{nullptr, (const bf16_t*)WSP(WS_XB), (bf16_t*)WSP(WS_XB), ((float*)WSP(WS_STATS) + 2 * MT), ((float*)WSP(WS_STATS) + 3 * MT), ((float*)WSP(WS_STATS) + 0 * MT), ((float*)WSP(WS_STATS) + 1 * MT), kargs().in[I_LN1G], kargs().in[I_LN1B]}; run_gemm(wid_s, lds, (const bf16_t*)WSP(WS_REGA), (const bf16_t*)WSP(WS_W2), MP, D, FF, E);
      FinRes F{2, nullptr, (const bf16_t*)WSP(WS_XB), (bf16_t*)WSP(WS_XB), ((float*)WSP(WS_STATS) + 2 * MT), ((float*)WSP(WS_STATS) + 3 * MT), ((float*)WSP(WS_STATS) + 0 * MT), ((float*)WSP(WS_STATS) + 1 * MT), kargs().in[I_LN1G], kargs().in[I_LN1B]}; mini_gemm_tail<2>(wid_s, lds, (const bf16_t*)WSP(WS_REGA), (const bf16_t*)WSP(WS_W2), FF, F); }
    SEAM();
    { pg8::EpiGate3<false> E{(const bf16_t*)WSP(WS_XB), (const bf16_t*)WSP(WS_PB), nullptr, (bf16_t*)WSP(WS_MIX), (bf16_t*)(kargs().out + O_Y), ((float*)WSP(WS_STATS) + 2 * MT), ((float*)WSP(WS_STATS) + 3 * MT), (const float*)WSP(WS_CSG), (const float*)WSP(WS_CBG), kargs().in[I_LN2G], kargs().in[I_LN2B]}; run_gemm(wid_s, lds, (const bf16_t*)WSP(WS_XB), (const bf16_t*)WSP(WS_WG), MP, D, D, E);
      FinGate F{false, E.xr, E.P, nullptr, E.ob1, E.ob2, E.ssum, E.ssq, E.cs, E.cb, E.g, E.b}; mini_gemm_tail<2>(wid_s, lds, (const bf16_t*)WSP(WS_XB), (const bf16_t*)WSP(WS_WG), D, F); }
    SEAM();
    { pg8::EpiStore E{(bf16_t*)WSP(WS_REGA), NH1, 10, (float*)WSP(WS_DT)}; run_gemm(wid_s, lds, (const bf16_t*)WSP(WS_MIX), (const bf16_t*)WSP(WS_WINO), MT, NINO, D, E); }
    SEAM();
    if (gridDim.x == 256) {
        const int b = blockIdx.x;
        if (b < 136) { sgu_block(wid_s, kargs(), lds, b); ssd_stepA(wid_s, kargs(), lds, b); }
        else { for (int t = b; t < 528; t += 120) ssd_stepA(wid_s, kargs(), lds, t); if (b >= 240) ssd_stepC(wid_s, kargs(), lds, 512 + (b - 240)); }
    } else {
        for (int t = blockIdx.x; t < 136 + 528 + 16; t += gridDim.x) { if (t < 136) sgu_block(wid_s, kargs(), lds, t); else if (t < 664) ssd_stepA(wid_s, kargs(), lds, t - 136); else ssd_stepC(wid_s, kargs(), lds, 512 + (t - 664)); }
    }
    SEAM();
    ssd_stepB(wid_s, kargs());
    SEAM();
    for (int t = blockIdx.x; t < 512; t += gridDim.x) ssd_stepC(wid_s, kargs(), lds, t);
    SEAM();
    { pg8::EpiRes3<1> E{nullptr, (const bf16_t*)(kargs().out + O_Y), (bf16_t*)WSP(WS_XB), ((float*)WSP(WS_STATS) + 4 * MT), ((float*)WSP(WS_STATS) + 5 * MT), nullptr, nullptr, nullptr, nullptr}; run_gemm(wid_s, lds, (const bf16_t*)WSP(WS_MIX), (const bf16_t*)WSP(WS_WOUTO), MP, D, D, E);
      FinRes F{1, nullptr, (const bf16_t*)(kargs().out + O_Y), (bf16_t*)WSP(WS_XB), ((float*)WSP(WS_STATS) + 4 * MT), ((float*)WSP(WS_STATS) + 5 * MT), nullptr, nullptr, nullptr, nullptr}; mini_gemm_tail<2>(wid_s, lds, (const bf16_t*)WSP(WS_MIX), (const bf16_t*)WSP(WS_WOUTO), D, F); }
    { pg8::EpiStore E{(bf16_t*)WSP(WS_PB), D, -1, nullptr}; run_gemm(wid_s, lds, (const bf16_t*)WSP(WS_PLEB), (const bf16_t*)WSP(WS_WPLE + WPLE_BYTES), MP, D, 256, E);
      FinStore F{(bf16_t*)WSP(WS_PB), D}; mini_gemm_tail<2>(wid_s, lds, (const bf16_t*)WSP(WS_PLEB), (const bf16_t*)WSP(WS_WPLE + WPLE_BYTES), 256, F); }
    SEAM();
    { pg8::EpiSwiGLU2 E{(bf16_t*)WSP(WS_REGA), ((float*)WSP(WS_STATS) + 4 * MT), ((float*)WSP(WS_STATS) + 5 * MT), (const float*)WSP(WS_CS13) + 5632, (const float*)WSP(WS_CB13) + 5632}; run_gemm(wid_s, lds, (const bf16_t*)WSP(WS_XB), (const bf16_t*)WSP(WS_W13 + W13_BYTES), MT, 2 * FF, D, E); }
    SEAM();
    { pg8::EpiRes3<2> E{nullptr, (const bf16_t*)WSP(WS_XB), (bf16_t*)WSP(WS_XB), ((float*)WSP(WS_STATS) + 6 * MT), ((float*)WSP(WS_STATS) + 7 * MT), ((float*)WSP(WS_STATS) + 4 * MT), ((float*)WSP(WS_STATS) + 5 * MT), kargs().in[I_LN1G] + D, kargs().in[I_LN1B] + D}; run_gemm(wid_s, lds, (const bf16_t*)WSP(WS_REGA), (const bf16_t*)WSP(WS_W2 + W2_BYTES), MP, D, FF, E);
      FinRes F{2, nullptr, (const bf16_t*)WSP(WS_XB), (bf16_t*)WSP(WS_XB), ((float*)WSP(WS_STATS) + 6 * MT), ((float*)WSP(WS_STATS) + 7 * MT), ((float*)WSP(WS_STATS) + 4 * MT), ((float*)WSP(WS_STATS) + 5 * MT), kargs().in[I_LN1G] + D, kargs().in[I_LN1B] + D}; mini_gemm_tail<2>(wid_s, lds, (const bf16_t*)WSP(WS_REGA), (const bf16_t*)WSP(WS_W2 + W2_BYTES), FF, F); }
    SEAM();
    { pg8::EpiGate3<true> E{(const bf16_t*)WSP(WS_XB), (const bf16_t*)WSP(WS_PB), XFP, nullptr, nullptr, ((float*)WSP(WS_STATS) + 6 * MT), ((float*)WSP(WS_STATS) + 7 * MT), (const float*)WSP(WS_CSG) + D, (const float*)WSP(WS_CBG) + D, kargs().in[I_LN2G] + D, kargs().in[I_LN2B] + D}; run_gemm(wid_s, lds, (const bf16_t*)WSP(WS_XB), (const bf16_t*)WSP(WS_WG + WG_BYTES), MP, D, D, E);
      FinGate F{true, E.xr, E.P, E.outf, nullptr, nullptr, E.ssum, E.ssq, E.cs, E.cb, E.g, E.b}; mini_gemm_tail<2>(wid_s, lds, (const bf16_t*)WSP(WS_XB), (const bf16_t*)WSP(WS_WG + WG_BYTES), D, F); }
}

extern "C" void kernel_launch(void* const* d_in, const int* in_sizes, int n_in, void* d_out, int out_size, void* d_ws, size_t ws_size, hipStream_t stream) {
    static int grid = 0;
    if (grid == 0) {
        if (n_in != 34 || ws_size < WS_END2) { fprintf(stderr, "kernel_launch: unexpected n_in %d or ws_size %zu (need %zu)\n", n_in, ws_size, (size_t)WS_END2); grid = -1; return; }
        int dev = 0, cus = 0, per_cu = 0;
        hipGetDevice(&dev); hipDeviceGetAttribute(&cus, hipDeviceAttributeMultiprocessorCount, dev);
        hipFuncSetAttribute((const void*)mega_fwd, hipFuncAttributeMaxDynamicSharedMemorySize, LDS_BYTES);
        hipOccupancyMaxActiveBlocksPerMultiprocessor(&per_cu, (const void*)mega_fwd, 512, LDS_BYTES);
        (void)hipGetLastError();
        if (per_cu < 1) per_cu = 1;
        grid = cus;
        fprintf(stderr, "kernel_launch: cus %d per_cu %d grid %d\n", cus, per_cu, grid);
    }
    if (grid < 0) return;
    if (hipMemsetAsync((char*)d_ws + WS_CTL, 0, WS_STATS, stream) != hipSuccess) { fprintf(stderr, "memset failed\n"); return; }
    Params prm{};
    for (int i = 0; i < 34; ++i) prm.in[i] = (const float*)d_in[i];
    prm.out = (float*)d_out; prm.ws = (unsigned char*)d_ws;
    void* args[] = {&prm};
    hipError_t e = hipLaunchCooperativeKernel((const void*)mega_fwd, dim3(grid), dim3(512), args, LDS_BYTES, stream);
    if (e != hipSuccess) fprintf(stderr, "cooperative launch failed: %s (grid %d)\n", hipGetErrorString(e), grid);
}
```

```cpp
#include <hip/hip_runtime.h>
#include <hip/hip_cooperative_groups.h>
#include <cstdio>
#include <cstdint>
namespace cg = cooperative_groups;
namespace pg8 {
#define PG8_LAS __attribute__((address_space(3)))
typedef unsigned short bf16_t;
typedef short bf16x8 __attribute__((ext_vector_type(8)));
typedef float f32x4 __attribute__((ext_vector_type(4)));
typedef unsigned u32x4 __attribute__((ext_vector_type(4)));
constexpr int BM = 256, BK = 64, HALF = 128, HTB = HALF * BK * 2  , STAGE_BYTES = 8 * HTB, NXCD = 8, WGM = 8;

__host__ __device__ __forceinline__ int lds_byte(int r, int c) { const int st = (r >> 4) * 2 + (c >> 5), rr = r & 15, cc = c & 31, ob = rr * 64 + cc * 2; return st * 1024 + (ob ^ (((ob >> 9) & 1) << 5)); }
__host__ __device__ __forceinline__ void stage_rc(int b, int& R, int& C) { const int st = b / 1024, sb = b % 1024, swz = sb ^ (((sb >> 9) & 1) << 5); R = (st >> 1) * 16 + swz / 64; C = (st & 1) * 32 + (swz % 64) / 2; }
__host__ __device__ __forceinline__ int perm32(int rho) { const int n = rho >> 4, i = rho & 15; return 8 * (i >> 2) + 4 * n + (i & 3); }

struct Unit { int pm, pn, ko; };
struct Gemm { const bf16_t* A; const bf16_t* Bt; int M, N, K, KL; };

struct StaticOrder {
    int nM, nN, nwg, G, c;
    __host__ __device__ void init(int M, int N, int G_, int c_) { nM = M / BM; nN = N / BM; nwg = nM * nN; G = G_; c = c_; }
    __host__ __device__ bool next(int i, Unit& u) const {
        const long L = (long)i * G + c; if (L >= nwg) return false;
        int wgid = (int)L; { const int q = nwg / NXCD, r = nwg % NXCD, xcd = wgid % NXCD, off = wgid / NXCD; wgid = (xcd < r ? xcd * (q + 1) : r * (q + 1) + (xcd - r) * q) + off; }
        const int nig = WGM * nN, gid = wgid / nig, fm = gid * WGM, gsz = (nM - fm) < WGM ? (nM - fm) : WGM;
        u.pm = fm + ((wgid % nig) % gsz); u.pn = (wgid % nig) / gsz; u.ko = 0; return true;
    }
    __device__ __forceinline__ void a_ready(const Unit&) const {}
    __device__ __forceinline__ void done(const Unit&) const {}
};
__device__ __forceinline__ unsigned cvt_pk_bf16(float lo, float hi) { unsigned r; asm volatile("v_cvt_pk_bf16_f32 %0, %1, %2" : "=v"(r) : "v"(lo), "v"(hi)); return r; }
template <class Epi, class Sched, bool ALIGN_EPI = false, bool SP2 = false>
__device__ __forceinline__ void gemm_phase(int wid_s, PG8_LAS unsigned char* lds, const Gemm g, const Sched& S, const Epi& E) {
    int lane_ = (int)__builtin_amdgcn_mbcnt_hi(~0u, __builtin_amdgcn_mbcnt_lo(~0u, 0u)); asm volatile("" : "+v"(lane_)); const int wid = wid_s, lane = lane_, tid = wid * 64 + lane, wr = wid >> 2, wc = wid & 3, fr = lane & 15, fq = lane >> 4;
    const int K = g.K, nt = g.KL / BK;
    unsigned voffA[2], voffB[2];
#pragma unroll
    for (int i = 0; i < 2; ++i) { int R, C; stage_rc(tid * 16 + i * 8192, R, C); const int Rb = Epi::PERM ? ((R & ~31) + perm32(R & 31)) : R;
        voffA[i] = (unsigned)(R * K + C) * 2u; voffB[i] = (unsigned)(Rb * K + C) * 2u; }
    const size_t kstep = (size_t)(BK * 2);
    const size_t hstep = (size_t)HALF * K * 2;
    const size_t tstep = 2 * hstep;
    const unsigned ldsw = (unsigned)wid * 1024u;
    const int aoff = lds_byte(wr * 64 + fr, fq * 8), boff = lds_byte(wc * 32 + fr, fq * 8);
#define PG8_SA(b, h) (((b) * 2 + (h)) * HTB)
#define PG8_SB(b, h) ((4 + (b) * 2 + (h)) * HTB)
#define PG8_STAGE(bufoff, gbase, voff) do { _Pragma("unroll") for (int _i = 0; _i < 2; ++_i) \
        __builtin_amdgcn_global_load_lds((const unsigned*)((const char*)(gbase) + (voff)[_i]), (PG8_LAS unsigned*)(lds + (bufoff) + ldsw + _i * 8192), 16, 0, 0); } while (0)
#define PG8_LDA(dst, b, h) do { _Pragma("unroll") for (int m = 0; m < 4; ++m) _Pragma("unroll") for (int k = 0; k < 2; ++k) dst[m][k] = *(const PG8_LAS bf16x8*)(lds + PG8_SA(b, h) + aoff + m * 2048 + k * 1024); } while (0)
#define PG8_LDB(dst, b, h) do { _Pragma("unroll") for (int n = 0; n < 2; ++n) _Pragma("unroll") for (int k = 0; k < 2; ++k) dst[n][k] = *(const PG8_LAS bf16x8*)(lds + PG8_SB(b, h) + boff + n * 2048 + k * 1024); } while (0)
#define PG8_MMA(ai, bj, At, Bt) do { __builtin_amdgcn_s_setprio(1); _Pragma("unroll") for (int m = 0; m < 4; ++m) _Pragma("unroll") for (int n = 0; n < 2; ++n) _Pragma("unroll") for (int k = 0; k < 2; ++k) \
        acc[ai][bj][m][n] = __builtin_amdgcn_mfma_f32_16x16x32_bf16(Bt[n][k], At[m][k], acc[ai][bj][m][n], 0, 0, 0); __builtin_amdgcn_s_setprio(0); } while (0)
#define PG8_WAIT_V(n) asm volatile("s_waitcnt vmcnt(" #n ")" ::: "memory")
#define PG8_WAIT_L(n) asm volatile("s_waitcnt lgkmcnt(" #n ")" ::: "memory")
#define PG8_BAR __builtin_amdgcn_s_barrier()
#define PG8_SCHED __builtin_amdgcn_sched_barrier(0)
    Unit cur, nxt; int ui = 0;
    if (!S.next(0, cur)) return;
    f32x4 acc[2][2][4][2];
#pragma unroll
    for (int a = 0; a < 2; ++a)
#pragma unroll
        for (int b = 0; b < 2; ++b)
#pragma unroll
            for (int m = 0; m < 4; ++m)
#pragma unroll
                for (int n = 0; n < 2; ++n) acc[a][b][m][n] = (f32x4){0.f, 0.f, 0.f, 0.f};
    bf16x8 At[4][2], B0[2][2], B1[2][2];
    const char* cA = (const char*)g.A + (size_t)cur.pm * tstep + (size_t)cur.ko * 2; const char* cB = (const char*)g.Bt + (size_t)cur.pn * tstep + (size_t)cur.ko * 2;
    S.a_ready(cur);
    if constexpr (SP2) {
        PG8_STAGE(PG8_SB(0, 0), cB, voffB); PG8_STAGE(PG8_SB(0, 1), cB + hstep, voffB); PG8_STAGE(PG8_SA(0, 0), cA, voffA); PG8_STAGE(PG8_SA(0, 1), cA + hstep, voffA);
        if (wr == 1) PG8_BAR;
        PG8_WAIT_V(2); PG8_BAR;
        PG8_STAGE(PG8_SB(1, 0), cB + kstep, voffB); PG8_STAGE(PG8_SA(1, 0), cA + kstep, voffA); PG8_STAGE(PG8_SB(1, 1), cB + hstep + kstep, voffB);
        PG8_WAIT_V(6); PG8_BAR;
    } else {
        PG8_STAGE(PG8_SB(0, 0), cB, voffB); PG8_STAGE(PG8_SA(0, 0), cA, voffA); PG8_STAGE(PG8_SB(0, 1), cB + hstep, voffB); PG8_STAGE(PG8_SA(0, 1), cA + hstep, voffA);
        if (wr == 1) PG8_BAR;
        PG8_WAIT_V(4); PG8_BAR;
        PG8_STAGE(PG8_SB(1, 0), cB + kstep, voffB); PG8_STAGE(PG8_SA(1, 0), cA + kstep, voffA); PG8_STAGE(PG8_SB(1, 1), cB + hstep + kstep, voffB);
        PG8_WAIT_V(6); PG8_BAR;
    }
    for (;;) {
        const bool has_next = S.next(ui + 1, nxt);
        const char* nA = has_next ? (const char*)g.A + (size_t)nxt.pm * tstep + (size_t)nxt.ko * 2 : cA; const char* nB = has_next ? (const char*)g.Bt + (size_t)nxt.pn * tstep + (size_t)nxt.ko * 2 : cB;
        for (int t = 0; t < nt; t += 2) {
            const bool last = (t == nt - 2);
            const char* a1 = cA + (size_t)(t + 1) * kstep;
            const char* a2 = last ? nA : cA + (size_t)(t + 2) * kstep; const char* b2 = last ? nB : cB + (size_t)(t + 2) * kstep;
            const char* a3 = a2 + kstep; const char* b3 = b2 + kstep;
            if (last && has_next) S.a_ready(nxt);
            if constexpr (SP2) {
            PG8_LDB(B0, 0, 0); PG8_LDB(B1, 0, 1); PG8_SCHED; PG8_LDA(At, 0, 0); PG8_STAGE(PG8_SA(1, 1), a1 + hstep, voffA);
            PG8_WAIT_V(8); PG8_WAIT_L(0); PG8_BAR; PG8_MMA(0, 0, At, B0); PG8_MMA(0, 1, At, B1); PG8_BAR; PG8_SCHED;
            PG8_LDA(At, 0, 1); PG8_STAGE(PG8_SB(0, 0), b2, voffB); PG8_STAGE(PG8_SB(0, 1), b2 + hstep, voffB); PG8_STAGE(PG8_SA(0, 0), a2, voffA);
            PG8_WAIT_V(8); PG8_WAIT_L(0); PG8_BAR; PG8_MMA(1, 0, At, B0); PG8_MMA(1, 1, At, B1); PG8_BAR; PG8_SCHED;
            PG8_LDB(B0, 1, 0); PG8_LDB(B1, 1, 1); PG8_SCHED; PG8_LDA(At, 1, 0); PG8_STAGE(PG8_SA(0, 1), a2 + hstep, voffA);
            PG8_WAIT_V(8); PG8_WAIT_L(0); PG8_BAR; PG8_MMA(0, 0, At, B0); PG8_MMA(0, 1, At, B1); PG8_BAR; PG8_SCHED;
            PG8_LDA(At, 1, 1); PG8_STAGE(PG8_SB(1, 0), b3, voffB); PG8_STAGE(PG8_SB(1, 1), b3 + hstep, voffB); PG8_STAGE(PG8_SA(1, 0), a3, voffA);
            PG8_WAIT_V(8); PG8_WAIT_L(0); PG8_BAR; PG8_MMA(1, 0, At, B0); PG8_MMA(1, 1, At, B1); PG8_BAR; PG8_SCHED;
            } else {
            PG8_LDB(B0, 0, 0); PG8_SCHED; PG8_LDA(At, 0, 0); PG8_STAGE(PG8_SA(1, 1), a1 + hstep, voffA);
            PG8_WAIT_L(8); PG8_BAR; PG8_WAIT_L(0); PG8_MMA(0, 0, At, B0); PG8_BAR; PG8_SCHED;
            PG8_LDB(B1, 0, 1); PG8_STAGE(PG8_SB(0, 0), b2, voffB);
            PG8_BAR; PG8_WAIT_L(0); PG8_MMA(0, 1, At, B1); PG8_BAR;
            PG8_LDA(At, 0, 1); PG8_STAGE(PG8_SA(0, 0), a2, voffA);
            PG8_BAR; PG8_WAIT_L(0); PG8_MMA(1, 0, At, B0); PG8_BAR; PG8_SCHED;
            PG8_STAGE(PG8_SB(0, 1), b2 + hstep, voffB);
            PG8_WAIT_V(6); PG8_BAR; PG8_MMA(1, 1, At, B1); PG8_BAR;
            PG8_LDB(B0, 1, 0); PG8_SCHED; PG8_LDA(At, 1, 0); PG8_STAGE(PG8_SA(0, 1), a2 + hstep, voffA);
            PG8_WAIT_L(8); PG8_BAR; PG8_WAIT_L(0); PG8_MMA(0, 0, At, B0); PG8_BAR; PG8_SCHED;
            PG8_LDB(B1, 1, 1); PG8_STAGE(PG8_SB(1, 0), b3, voffB);
            PG8_BAR; PG8_WAIT_L(0); PG8_MMA(0, 1, At, B1); PG8_BAR;
            PG8_LDA(At, 1, 1); PG8_STAGE(PG8_SA(1, 0), a3, voffA);
            PG8_BAR; PG8_WAIT_L(0); PG8_MMA(1, 0, At, B0); PG8_BAR; PG8_SCHED;
            PG8_STAGE(PG8_SB(1, 1), b3 + hstep, voffB);
            PG8_WAIT_V(6); PG8_BAR; PG8_MMA(1, 1, At, B1); PG8_BAR;
            }
        }
        if constexpr (ALIGN_EPI) { if (wr == 0) PG8_BAR; }
        if constexpr (!Epi::AFTER_DRAIN) { E(acc, cur, wr, wc, fr, fq); S.done(cur); }
        if (!has_next) break;
#pragma unroll
        for (int a = 0; a < 2; ++a)
#pragma unroll
            for (int b = 0; b < 2; ++b)
#pragma unroll
                for (int m = 0; m < 4; ++m)
#pragma unroll
                    for (int n = 0; n < 2; ++n) acc[a][b][m][n] = (f32x4){0.f, 0.f, 0.f, 0.f};
        cur = nxt; cA = nA; cB = nB; ++ui;
        if constexpr (ALIGN_EPI) { if (wr == 1) PG8_BAR; }
    }
    PG8_WAIT_V(0);
    if constexpr (!ALIGN_EPI) { if (wr == 0) PG8_BAR; }
    PG8_BAR;
    if constexpr (Epi::AFTER_DRAIN) { E.fused(acc, cur, wr, wc, fr, fq, lds, wid, lane); S.done(cur); }
#undef PG8_SA
#undef PG8_SB
#undef PG8_STAGE
#undef PG8_LDA
#undef PG8_LDB
#undef PG8_MMA
#undef PG8_WAIT_V
#undef PG8_WAIT_L
#undef PG8_BAR
#undef PG8_SCHED
}
}

#define LAS __attribute__((address_space(3)))
typedef unsigned short bf16_t;
typedef short bf16x8 __attribute__((ext_vector_type(8)));
typedef float f32x4 __attribute__((ext_vector_type(4)));
typedef unsigned u32x4 __attribute__((ext_vector_type(4)));
typedef unsigned u32x2 __attribute__((ext_vector_type(2)));

constexpr int D = 1024, MP = 16384, MSAMP = 256, MT = MP + MSAMP, SEQ = 8192, FF = 2816;
constexpr int NH0 = 2048, NH1 = 2560, NINO = 2816;
constexpr float ALPHA = 1.41421356237f, LN_EPS = 1e-5f;
constexpr size_t MiB = 1u << 20;
constexpr size_t WS_CTL = 0, CTL_BYTES = 1 * MiB;
constexpr size_t WS_CS13 = 64 * 1024, WS_CB13 = 112 * 1024, WS_CSG = 160 * 1024, WS_CBG = 168 * 1024, WS_STATS = 256 * 1024;
static_assert(WS_STATS + 4 * 2 * 16640 * 4 <= CTL_BYTES, "ctl map");
constexpr size_t WS_WINE = 1 * MiB, WS_WOUTE = 5 * MiB, WS_WINO = 7 * MiB, WS_WOUTO = 12 * MiB + MiB / 2;
constexpr size_t WS_W13 = 14 * MiB + MiB / 2, W13_BYTES = 11 * MiB;
constexpr size_t WS_W2 = 36 * MiB + MiB / 2, W2_BYTES = 5 * MiB + MiB / 2;
constexpr size_t WS_WG = 47 * MiB + MiB / 2, WG_BYTES = 2 * MiB;
constexpr size_t WS_WPLE = 51 * MiB + MiB / 2, WPLE_BYTES = MiB / 2;
constexpr size_t WS_WPOOL = 52 * MiB + MiB / 2, WS_WSGU = WS_WPOOL + 131072;
constexpr size_t WS_PLEB = 53 * MiB;
constexpr size_t WS_XB = 61 * MiB + MiB / 4, ACT_BYTES = (size_t)MT * D * 2;
constexpr size_t WS_PB = WS_XB + ACT_BYTES, WS_MIX = WS_PB + ACT_BYTES, WS_REGA = WS_MIX + ACT_BYTES;
constexpr size_t WS_DT = WS_REGA + 82 * MiB, WS_SSAMP = WS_REGA + 83 * MiB, WS_DEC = WS_REGA + 86 * MiB;
constexpr size_t WS_END = WS_REGA + (size_t)MT * FF * 2, WS_SLAB4 = WS_END, WS_END2 = WS_END + 4 * MiB;
static_assert(WS_END2 <= 256 * MiB, "ws map");
static_assert(WS_DEC + 264 * 8 * 4 <= WS_END, "ws map tail");
constexpr size_t O_Y = 0, O_POOLP = 17039360, O_POOLS = 17054720, O_CONVP = 17116160, O_CONVS = 17118208, O_SGUV = 17126400,
                 O_SCP = 17257472, O_SCS = 17263616, O_SSMP = 17288192, O_SSMS = 17419264;
constexpr int LDS_BYTES = 147456;

struct Params { const float* in[34]; float* out; unsigned char* ws; };
#define CAS __attribute__((address_space(4)))
#if defined(__HIP_DEVICE_COMPILE__)
__device__ __forceinline__ const CAS Params& kargs() { const CAS Params* k = (const CAS Params*)__builtin_amdgcn_kernarg_segment_ptr(); asm volatile("" : "+s"(k)); return *k; }
#else
__device__ const CAS Params& kargs();
#endif
enum { I_XP = 0, I_XS, I_PP, I_PS, I_STPOOL, I_STCONV, I_STSSMCONV, I_STSSM, I_WINE, I_POOLW, I_POOLSC, I_CONVW, I_WOUTE, I_WINO, I_SGUW, I_SGUB, I_SGULNG, I_SGULNB,
       I_SSMCW, I_SSMCB, I_DTB, I_ALOG, I_SSMD, I_SSMNW, I_WOUTO, I_LN1G, I_LN1B, I_LN2G, I_LN2B, I_FF1, I_FF3, I_FF2, I_WPLE, I_WGATE };

__device__ __forceinline__ float bf2f(unsigned b) { return __uint_as_float(b << 16); }
__device__ __forceinline__ unsigned f2bf(float f) { unsigned u = __float_as_uint(f); return (u + 0x7fffu + ((u >> 16) & 1u)) >> 16; }
__device__ __forceinline__ unsigned pk2(float lo, float hi) { return f2bf(lo) | (f2bf(hi) << 16); }
__device__ __forceinline__ void unpack8(const u32x4 w, float (&v)[8]) {
    v[0] = bf2f(w.x & 0xffffu); v[1] = __uint_as_float(w.x & 0xffff0000u); v[2] = bf2f(w.y & 0xffffu); v[3] = __uint_as_float(w.y & 0xffff0000u);
    v[4] = bf2f(w.z & 0xffffu); v[5] = __uint_as_float(w.z & 0xffff0000u); v[6] = bf2f(w.w & 0xffffu); v[7] = __uint_as_float(w.w & 0xffff0000u); }
__device__ __forceinline__ u32x4 pack8(const float (&v)[8]) { u32x4 w; w.x = pk2(v[0], v[1]); w.y = pk2(v[2], v[3]); w.z = pk2(v[4], v[5]); w.w = pk2(v[6], v[7]); return w; }
__device__ __forceinline__ void load8bf(const bf16_t* p, float (&v)[8]) { unpack8(*(const u32x4*)p, v); }
__device__ __forceinline__ void load8f(const float* p, float (&v)[8]) { const f32x4 a = *(const f32x4*)p, b = *(const f32x4*)(p + 4); v[0] = a.x; v[1] = a.y; v[2] = a.z; v[3] = a.w; v[4] = b.x; v[5] = b.y; v[6] = b.z; v[7] = b.w; }
__device__ __forceinline__ float sigmoidf_(float x) { return __builtin_amdgcn_rcpf(1.0f + __expf(-x)); }
__device__ __forceinline__ float siluf_(float x) { return x * sigmoidf_(x); }
__device__ __forceinline__ float geluf_(float x) { const float y = 0.7978845608f * (x + 0.044715f * x * x * x); return x * sigmoidf_(2.0f * y); }
__device__ __forceinline__ float softplusf_(float x) { return x > 20.f ? x : log1pf(__expf(x)); }
__device__ __forceinline__ float wave_sum(float v) {
#pragma unroll
    for (int o = 1; o < 64; o <<= 1) v += __shfl_xor(v, o);
    return v; }
__device__ __forceinline__ f32x4 mfma16(bf16x8 a, bf16x8 b, f32x4 c) { return __builtin_amdgcn_mfma_f32_16x16x32_bf16(a, b, c, 0, 0, 0); }
#define LDS_WAIT() asm volatile("s_waitcnt lgkmcnt(0)" ::: "memory")
__device__ __forceinline__ int swz(int row, int col) { return col ^ (((row >> 3) & 7) << 3); }
__device__ __forceinline__ int lane_id_() { int l = (int)__builtin_amdgcn_mbcnt_hi(~0u, __builtin_amdgcn_mbcnt_lo(~0u, 0u)); asm volatile("" : "+v"(l)); return l; }
#define TIDX (wid_s * 64 + lane_id_())

namespace pg8 {
struct EpiStore { static constexpr bool PERM = true, AFTER_DRAIN = false;
    bf16_t* O; int ldc; int dt_pn; float* DT;
    __device__ __forceinline__ void operator()(const f32x4 (&acc)[2][2][4][2], const Unit& u, int wr, int wc, int fr_, int fq_) const {
        int fr = fr_, fq = fq_; asm volatile("" : "+v"(fr), "+v"(fq));
        const int row0 = u.pm * BM + wr * 64 + fr;
        if (u.pn == dt_pn) {
            if (wc == 0 && fq == 0) {
#pragma unroll
                for (int ai = 0; ai < 2; ++ai)
#pragma unroll
                    for (int m = 0; m < 4; ++m) { float* d = DT + (size_t)(row0 + ai * HALF + m * 16) * 8; *(f32x4*)d = acc[ai][0][m][0]; *(f32x4*)(d + 4) = acc[ai][0][m][1]; }
            }
            return;
        }
        const int col0 = u.pn * BM + wc * 32 + 8 * fq;
#pragma unroll
        for (int ai = 0; ai < 2; ++ai)
#pragma unroll
            for (int m = 0; m < 4; ++m) { bf16_t* rowp = O + (size_t)(row0 + ai * HALF + m * 16) * ldc + col0;
#pragma unroll
                for (int bj = 0; bj < 2; ++bj) { const f32x4 v0 = acc[ai][bj][m][0], v1 = acc[ai][bj][m][1];
                    u32x4 w; w.x = cvt_pk_bf16(v0[0], v0[1]); w.y = cvt_pk_bf16(v0[2], v0[3]); w.z = cvt_pk_bf16(v1[0], v1[1]); w.w = cvt_pk_bf16(v1[2], v1[3]);
                    *(u32x4*)(rowp + bj * HALF) = w; } }
    }
};
struct EpiRes { static constexpr bool PERM = false, AFTER_DRAIN = false;
    const float* base; const float* base_s; float* out;
    __device__ __forceinline__ void operator()(const f32x4 (&acc)[2][2][4][2], const Unit& u, int wr, int wc, int fr_, int fq_) const {
        int fr = fr_, fq = fq_; asm volatile("" : "+v"(fr), "+v"(fq));
        const int row0 = u.pm * BM + wr * 64 + fr, col0 = u.pn * BM + wc * 32 + 4 * fq;
#pragma unroll
        for (int ai = 0; ai < 2; ++ai)
#pragma unroll
            for (int m = 0; m < 4; ++m) { const int r = row0 + ai * HALF + m * 16;
                const float* bp = (base_s != nullptr && r >= MP) ? base_s + (size_t)(r - MP) * D : base + (size_t)r * D; float* op = out + (size_t)r * D;
#pragma unroll
                for (int bj = 0; bj < 2; ++bj)
#pragma unroll
                    for (int n = 0; n < 2; ++n) { const int c = col0 + bj * HALF + n * 16; const f32x4 x = *(const f32x4*)(bp + c); *(f32x4*)(op + c) = x * ALPHA + acc[ai][bj][m][n]; }
                asm volatile("" ::: "memory"); }
    }
};
struct EpiSwiGLU { static constexpr bool PERM = true, AFTER_DRAIN = false;
    bf16_t* HF;
    __device__ __forceinline__ void operator()(const f32x4 (&acc)[2][2][4][2], const Unit& u, int wr, int wc, int fr_, int fq_) const {
        int fr = fr_, fq = fq_; asm volatile("" : "+v"(fr), "+v"(fq));
        const int row0 = u.pm * BM + wr * 64 + fr, col0 = u.pn * HALF + wc * 32 + 8 * fq;
#pragma unroll
        for (int ai = 0; ai < 2; ++ai)
#pragma unroll
            for (int m = 0; m < 4; ++m) { bf16_t* rowp = HF + (size_t)(row0 + ai * HALF + m * 16) * FF + col0;
                f32x4 h0, h1;
#pragma unroll
                for (int j = 0; j < 4; ++j) { h0[j] = siluf_(acc[ai][0][m][0][j]) * acc[ai][1][m][0][j]; h1[j] = siluf_(acc[ai][0][m][1][j]) * acc[ai][1][m][1][j]; }
                u32x4 w; w.x = cvt_pk_bf16(h0[0], h0[1]); w.y = cvt_pk_bf16(h0[2], h0[3]); w.z = cvt_pk_bf16(h1[0], h1[1]); w.w = cvt_pk_bf16(h1[2], h1[3]);
                *(u32x4*)rowp = w; asm volatile("" ::: "memory"); }
    }
};
struct EpiGate { static constexpr bool PERM = false, AFTER_DRAIN = false;
    const float* xf; const bf16_t* P; float* out; bf16_t* xb2;
    __device__ __forceinline__ void operator()(const f32x4 (&acc)[2][2][4][2], const Unit& u, int wr, int wc, int fr_, int fq_) const {
        int fr = fr_, fq = fq_; asm volatile("" : "+v"(fr), "+v"(fq));
        const int row0 = u.pm * BM + wr * 64 + fr, col0 = u.pn * BM + wc * 32 + 4 * fq;
#pragma unroll
        for (int ai = 0; ai < 2; ++ai)
#pragma unroll
            for (int m = 0; m < 4; ++m) { const size_t ro = (size_t)(row0 + ai * HALF + m * 16) * D;
#pragma unroll
                for (int bj = 0; bj < 2; ++bj)
#pragma unroll
                    for (int n = 0; n < 2; ++n) { const size_t o = ro + col0 + bj * HALF + n * 16; const f32x4 x = *(const f32x4*)(xf + o); const u32x2 pw = *(const u32x2*)(P + o);
                        const f32x4 a = acc[ai][bj][m][n]; f32x4 r;
                        r[0] = x[0] + bf2f(pw.x & 0xffffu) * sigmoidf_(a[0]); r[1] = x[1] + __uint_as_float(pw.x & 0xffff0000u) * sigmoidf_(a[1]);
                        r[2] = x[2] + bf2f(pw.y & 0xffffu) * sigmoidf_(a[2]); r[3] = x[3] + __uint_as_float(pw.y & 0xffff0000u) * sigmoidf_(a[3]);
                        *(f32x4*)(out + o) = r;
                        if (xb2) { u32x2 w; w.x = cvt_pk_bf16(r[0], r[1]); w.y = cvt_pk_bf16(r[2], r[3]); *(u32x2*)(xb2 + o) = w; } }
                asm volatile("" ::: "memory"); }
    }
};

__device__ __forceinline__ void row_stats(const float* ssum, const float* ssq, int r, float& mean, float& rstd) {
    const float s = ssum[r], q = ssq[r]; mean = s * (1.f / D); const float var = fmaxf(q * (1.f / D) - mean * mean, 0.f); rstd = 1.f / sqrtf(var + LN_EPS); }
template <int BASE> struct EpiRes3 { static constexpr bool PERM = false, AFTER_DRAIN = false;
    const float* basef; const bf16_t* baseb; bf16_t* xb; float* ssum; float* ssq; const float* pss; const float* psq; const float* g; const float* b;
    __device__ __forceinline__ void operator()(const f32x4 (&acc)[2][2][4][2], const Unit& u, int wr, int wc, int fr_, int fq_) const {
        int fr = fr_, fq = fq_; asm volatile("" : "+v"(fr), "+v"(fq));
        const int row0 = u.pm * BM + wr * 64 + fr, col0 = u.pn * BM + wc * 32 + 4 * fq;
        float mean[8], rstd[8], s1[8], s2[8];
#pragma unroll
        for (int i = 0; i < 8; ++i) { mean[i] = 0.f; rstd[i] = 1.f; s1[i] = 0.f; s2[i] = 0.f; if (BASE == 2) row_stats(pss, psq, row0 + (i >> 2) * HALF + (i & 3) * 16, mean[i], rstd[i]); }
#pragma unroll
        for (int bj = 0; bj < 2; ++bj)
#pragma unroll
            for (int n = 0; n < 2; ++n) { const int c = col0 + bj * HALF + n * 16; f32x4 gg, bb;
                if (BASE == 2) { gg = *(const f32x4*)(g + c); bb = *(const f32x4*)(b + c); }
#pragma unroll
                for (int i = 0; i < 8; ++i) { const int ai = i >> 2, m = i & 3; const size_t ro = (size_t)(row0 + ai * HALF + m * 16) * D; f32x4 x;
                    if (BASE == 0) x = *(const f32x4*)(basef + ro + c);
                    else { const u32x2 bw = *(const u32x2*)(baseb + ro + c); x = (f32x4){bf2f(bw.x & 0xffffu), __uint_as_float(bw.x & 0xffff0000u), bf2f(bw.y & 0xffffu), __uint_as_float(bw.y & 0xffff0000u)}; }
                    if (BASE == 2) x = (x - mean[i]) * rstd[i] * gg + bb;
                    const f32x4 v = x * ALPHA + acc[ai][bj][m][n];
                    u32x2 w; w.x = cvt_pk_bf16(v[0], v[1]); w.y = cvt_pk_bf16(v[2], v[3]); *(u32x2*)(xb + ro + c) = w;
                    s1[i] += (v[0] + v[1]) + (v[2] + v[3]); s2[i] += (v[0] * v[0] + v[1] * v[1]) + (v[2] * v[2] + v[3] * v[3]); }
                asm volatile("" ::: "memory"); }
#pragma unroll
        for (int i = 0; i < 8; ++i) { float a = s1[i], q = s2[i]; a += __shfl_xor(a, 16); a += __shfl_xor(a, 32); q += __shfl_xor(q, 16); q += __shfl_xor(q, 32);
            if (fq == 0) { const int r = row0 + (i >> 2) * HALF + (i & 3) * 16; atomicAdd(ssum + r, a); atomicAdd(ssq + r, q); } }
    }
};
struct EpiSwiGLU2 { static constexpr bool PERM = true, AFTER_DRAIN = false;
    bf16_t* HF; const float* ssum; const float* ssq; const float* cs; const float* cb;
    __device__ __forceinline__ void operator()(const f32x4 (&acc)[2][2][4][2], const Unit& u, int wr, int wc, int fr_, int fq_) const {
        int fr = fr_, fq = fq_; asm volatile("" : "+v"(fr), "+v"(fq));
        const int row0 = u.pm * BM + wr * 64 + fr, col0 = u.pn * HALF + wc * 32 + 8 * fq, cc0 = u.pn * BM + wc * 32 + 8 * fq;
        f32x4 csv[2][2], cbv[2][2];
#pragma unroll
        for (int bj = 0; bj < 2; ++bj)
#pragma unroll
            for (int n = 0; n < 2; ++n) { csv[bj][n] = *(const f32x4*)(cs + cc0 + bj * HALF + 4 * n); cbv[bj][n] = *(const f32x4*)(cb + cc0 + bj * HALF + 4 * n); }
#pragma unroll
        for (int ai = 0; ai < 2; ++ai)
#pragma unroll
            for (int m = 0; m < 4; ++m) { const int r = row0 + ai * HALF + m * 16; bf16_t* rowp = HF + (size_t)r * FF + col0;
                float mean, rstd; row_stats(ssum, ssq, r, mean, rstd);
                f32x4 h0, h1;
#pragma unroll
                for (int j = 0; j < 4; ++j) {
                    const float a0 = rstd * (acc[ai][0][m][0][j] - mean * csv[0][0][j]) + cbv[0][0][j], b0 = rstd * (acc[ai][1][m][0][j] - mean * csv[1][0][j]) + cbv[1][0][j];
                    const float a1 = rstd * (acc[ai][0][m][1][j] - mean * csv[0][1][j]) + cbv[0][1][j], b1 = rstd * (acc[ai][1][m][1][j] - mean * csv[1][1][j]) + cbv[1][1][j];
                    h0[j] = siluf_(a0) * b0; h1[j] = siluf_(a1) * b1; }
                u32x4 w; w.x = cvt_pk_bf16(h0[0], h0[1]); w.y = cvt_pk_bf16(h0[2], h0[3]); w.z = cvt_pk_bf16(h1[0], h1[1]); w.w = cvt_pk_bf16(h1[2], h1[3]);
                *(u32x4*)rowp = w; asm volatile("" ::: "memory"); }
    }
};
template <bool FINAL> struct EpiGate3 { static constexpr bool PERM = false, AFTER_DRAIN = false;
    const bf16_t* xr; const bf16_t* P; float* outf; bf16_t* ob1; bf16_t* ob2; const float* ssum; const float* ssq; const float* cs; const float* cb; const float* g; const float* b;
    __device__ __forceinline__ void operator()(const f32x4 (&acc)[2][2][4][2], const Unit& u, int wr, int wc, int fr_, int fq_) const {
        int fr = fr_, fq = fq_; asm volatile("" : "+v"(fr), "+v"(fq));
        const int row0 = u.pm * BM + wr * 64 + fr, col0 = u.pn * BM + wc * 32 + 4 * fq;
        float mean[8], rstd[8];
#pragma unroll
        for (int i = 0; i < 8; ++i) row_stats(ssum, ssq, row0 + (i >> 2) * HALF + (i & 3) * 16, mean[i], rstd[i]);
#pragma unroll
        for (int bj = 0; bj < 2; ++bj)
#pragma unroll
            for (int n = 0; n < 2; ++n) { const int c = col0 + bj * HALF + n * 16;
                const f32x4 gg = *(const f32x4*)(g + c), bb = *(const f32x4*)(b + c), c1 = *(const f32x4*)(cs + c), c2 = *(const f32x4*)(cb + c);
#pragma unroll
                for (int i = 0; i < 8; ++i) { const int ai = i >> 2, m = i & 3; const size_t o = (size_t)(row0 + ai * HALF + m * 16) * D + c;
                    const u32x2 rw = *(const u32x2*)(xr + o); const u32x2 pw = *(const u32x2*)(P + o);
                    const f32x4 rv = (f32x4){bf2f(rw.x & 0xffffu), __uint_as_float(rw.x & 0xffff0000u), bf2f(rw.y & 0xffffu), __uint_as_float(rw.y & 0xffff0000u)};
                    const f32x4 x = (rv - mean[i]) * rstd[i] * gg + bb; const f32x4 a = (acc[ai][bj][m][n] - c1 * mean[i]) * rstd[i] + c2; f32x4 o4;
                    o4[0] = x[0] + bf2f(pw.x & 0xffffu) * sigmoidf_(a[0]); o4[1] = x[1] + __uint_as_float(pw.x & 0xffff0000u) * sigmoidf_(a[1]);
                    o4[2] = x[2] + bf2f(pw.y & 0xffffu) * sigmoidf_(a[2]); o4[3] = x[3] + __uint_as_float(pw.y & 0xffff0000u) * sigmoidf_(a[3]);
                    if (FINAL) __builtin_nontemporal_store(o4, (f32x4*)(outf + o));
                    else { u32x2 w; w.x = cvt_pk_bf16(o4[0], o4[1]); w.y = cvt_pk_bf16(o4[2], o4[3]); *(u32x2*)(ob1 + o) = w; *(u32x2*)(ob2 + o) = w; } }
                asm volatile("" ::: "memory"); }
    }
};
}

template <class Epi>
__device__ __forceinline__ void run_gemm(int wid_s, LAS unsigned char* lds, const bf16_t* A, const bf16_t* Bt, int Mrows, int N, int K, const Epi& E) {
    pg8::Gemm g{A, Bt, Mrows, N, K, K}; pg8::StaticOrder S; S.init(Mrows, N, (int)gridDim.x, (int)blockIdx.x);
    pg8::gemm_phase<Epi, pg8::StaticOrder, true, true>(wid_s, lds, g, S, E);
}
namespace pg8 {
struct SplitOrder { int nN, nS, G, c;
    __device__ bool next(int i, Unit& u) const { const int L = i * G + c; if (L >= nN * nS) return false; u.pm = 64; u.pn = L % nN; u.ko = (L / nN) * 256; return true; }
    __device__ __forceinline__ void a_ready(const Unit&) const {}
    __device__ __forceinline__ void done(const Unit&) const {}
};
struct EpiSlab { static constexpr bool PERM = false, AFTER_DRAIN = false;
    float* slab;
    __device__ __forceinline__ void operator()(const f32x4 (&acc)[2][2][4][2], const Unit& u, int wr, int wc, int fr_, int fq_) const {
        int fr = fr_, fq = fq_; asm volatile("" : "+v"(fr), "+v"(fq));
        const int row0 = wr * 64 + fr, col0 = u.pn * BM + wc * 32 + 4 * fq; float* sp = slab + (size_t)(u.ko >> 8) * (256 * D);
#pragma unroll
        for (int ai = 0; ai < 2; ++ai)
#pragma unroll
            for (int m = 0; m < 4; ++m) { float* op = sp + (size_t)(row0 + ai * HALF + m * 16) * D;
#pragma unroll
                for (int bj = 0; bj < 2; ++bj)
#pragma unroll
                    for (int n = 0; n < 2; ++n) *(f32x4*)(op + col0 + bj * HALF + n * 16) = acc[ai][bj][m][n]; }
    }
};
}
__device__ __forceinline__ void run_gemm_split(int wid_s, LAS unsigned char* lds, const bf16_t* A, const bf16_t* Bt, int K, float* slab) {
    pg8::Gemm g{A, Bt, MT, D, K, 256}; pg8::SplitOrder S{4, K / 256, (int)gridDim.x, (int)(gridDim.x - 1 - blockIdx.x)}; pg8::EpiSlab E{slab};
    pg8::gemm_phase<pg8::EpiSlab, pg8::SplitOrder, true, true>(wid_s, lds, g, S, E);
}

template <int NCT, class Fin>
__device__ __forceinline__ void mini_gemm_tail(int wid_s, LAS unsigned char* lds, const bf16_t* A, const bf16_t* Bt, int K, const Fin& fin) {
    const int lane = lane_id_(), wv = wid_s, tid = wv * 64 + lane; LAS float* red = (LAS float*)lds; constexpr int NB = 16 * NCT;
    for (int blk = blockIdx.x; blk < 256; blk += gridDim.x) {
        const int rows0 = MP + (blk >> 5) * 32, cols0 = (blk & 31) * NB, kw = K >> 3;
        f32x4 acc[2][NCT];
#pragma unroll
        for (int rt = 0; rt < 2; ++rt)
#pragma unroll
            for (int ct = 0; ct < NCT; ++ct) acc[rt][ct] = (f32x4){0.f, 0.f, 0.f, 0.f};
        const bf16_t* ap = A + (size_t)(rows0 + (lane & 15)) * K + wv * kw + 8 * (lane >> 4);
        const bf16_t* bp = Bt + (size_t)(cols0 + (lane & 15)) * K + wv * kw + 8 * (lane >> 4);
#pragma unroll 4
        for (int k0 = 0; k0 < kw; k0 += 32) {
            const bf16x8 a0 = *(const bf16x8*)(ap + k0), a1 = *(const bf16x8*)(ap + (size_t)16 * K + k0);
#pragma unroll
            for (int ct = 0; ct < NCT; ++ct) { const bf16x8 bf = *(const bf16x8*)(bp + (size_t)(16 * ct) * K + k0); acc[0][ct] = mfma16(bf, a0, acc[0][ct]); acc[1][ct] = mfma16(bf, a1, acc[1][ct]); } }
#pragma unroll
        for (int rt = 0; rt < 2; ++rt)
#pragma unroll
            for (int ct = 0; ct < NCT; ++ct) *(LAS f32x4*)(red + ((wv * 32 + rt * 16 + (lane & 15)) * NB + ct * 16 + (lane >> 4) * 4)) = acc[rt][ct];
        __syncthreads();
        if (tid < 8 * NB) { const int row = tid / (NB / 4), cg = (tid % (NB / 4)) * 4; f32x4 s = (f32x4){0.f, 0.f, 0.f, 0.f};
#pragma unroll
            for (int w = 0; w < 8; ++w) s += *(const LAS f32x4*)(red + ((w * 32 + row) * NB + cg));
            fin(rows0 + row, cols0 + cg, s); }
        __syncthreads();
    }
}
struct FinStore { bf16_t* O; int ldc;
    __device__ __forceinline__ void operator()(int r, int c, const f32x4 acc) const { u32x2 w; w.x = pk2(acc[0], acc[1]); w.y = pk2(acc[2], acc[3]); *(u32x2*)(O + (size_t)r * ldc + c) = w; } };
struct FinRes { int kind; const float* basef; const bf16_t* baseb; bf16_t* xb; float* ssum; float* ssq; const float* pss; const float* psq; const float* g; const float* b;
    __device__ __forceinline__ void operator()(int r, int c, const f32x4 acc) const { const size_t o = (size_t)r * D + c; f32x4 x;
        if (kind == 0) x = *(const f32x4*)(basef + (size_t)(r - MP) * D + c);
        else { const u32x2 bw = *(const u32x2*)(baseb + o); x = (f32x4){bf2f(bw.x & 0xffffu), __uint_as_float(bw.x & 0xffff0000u), bf2f(bw.y & 0xffffu), __uint_as_float(bw.y & 0xffff0000u)}; }
        if (kind == 2) { float mean, rstd; pg8::row_stats(pss, psq, r, mean, rstd); x = (x - mean) * rstd * *(const f32x4*)(g + c) + *(const f32x4*)(b + c); }
        const f32x4 v = x * ALPHA + acc; u32x2 w; w.x = pk2(v[0], v[1]); w.y = pk2(v[2], v[3]); *(u32x2*)(xb + o) = w;
        float s1 = (v[0] + v[1]) + (v[2] + v[3]), s2 = (v[0] * v[0] + v[1] * v[1]) + (v[2] * v[2] + v[3] * v[3]);
        s1 += __shfl_xor(s1, 1); s1 += __shfl_xor(s1, 2); s1 += __shfl_xor(s1, 4); s2 += __shfl_xor(s2, 1); s2 += __shfl_xor(s2, 2); s2 += __shfl_xor(s2, 4);
        if ((c & 31) == 0) { atomicAdd(ssum + r, s1); atomicAdd(ssq + r, s2); } }
};
struct FinGate { bool final_; const bf16_t* xr; const bf16_t* P; float* outf; bf16_t* ob1; bf16_t* ob2; const float* ssum; const float* ssq; const float* cs; const float* cb; const float* g; const float* b;
    __device__ __forceinline__ void operator()(int r, int c, const f32x4 acc) const {
        float mean, rstd; pg8::row_stats(ssum, ssq, r, mean, rstd); const size_t o = (size_t)r * D + c;
        const u32x2 rw = *(const u32x2*)(xr + o); const u32x2 pw = *(const u32x2*)(P + o);
        const f32x4 gg = *(const f32x4*)(g + c), bb = *(const f32x4*)(b + c), c1 = *(const f32x4*)(cs + c), c2 = *(const f32x4*)(cb + c);
        const f32x4 rv = (f32x4){bf2f(rw.x & 0xffffu), __uint_as_float(rw.x & 0xffff0000u), bf2f(rw.y & 0xffffu), __uint_as_float(rw.y & 0xffff0000u)};
        const f32x4 x = (rv - mean) * rstd * gg + bb; const f32x4 a = (acc - c1 * mean) * rstd + c2; f32x4 o4;
        o4[0] = x[0] + bf2f(pw.x & 0xffffu) * sigmoidf_(a[0]); o4[1] = x[1] + __uint_as_float(pw.x & 0xffff0000u) * sigmoidf_(a[1]);
        o4[2] = x[2] + bf2f(pw.y & 0xffffu) * sigmoidf_(a[2]); o4[3] = x[3] + __uint_as_float(pw.y & 0xffff0000u) * sigmoidf_(a[3]);
        if (final_) __builtin_nontemporal_store(o4, (f32x4*)(outf + o));
        else { u32x2 w; w.x = pk2(o4[0], o4[1]); w.y = pk2(o4[2], o4[3]); *(u32x2*)(ob1 + o) = w; *(u32x2*)(ob2 + o) = w; } }
};

__device__ __forceinline__ void tr_item(const float* W, int ldw, int nvalid, int k0, int n0, bf16_t* WT, int ldt, int drow0, LAS float* scr, int lane,
                                        const float* gs = nullptr, const float* bs = nullptr, float* cs = nullptr, float* cb = nullptr) {
    float wv_[32];
#pragma unroll
    for (int i = 0; i < 32; ++i) { const int kk = 2 * i + (lane >> 5), n = n0 + (lane & 31); wv_[i] = (n < nvalid) ? W[(size_t)(k0 + kk) * ldw + n] : 0.f; }
#pragma unroll
    for (int i = 0; i < 32; ++i) scr[(2 * i + (lane >> 5)) * 33 + (lane & 31)] = wv_[i];
    LDS_WAIT();
    const int c = lane & 7;
    float gk[8], bk[8];
    if (gs != nullptr) { load8f(gs + k0 + 8 * c, gk); load8f(bs + k0 + 8 * c, bk); }
#pragma unroll
    for (int j = 0; j < 4; ++j) { const int n = (lane >> 3) + 8 * j; const LAS float* s = scr + (8 * c) * 33 + n; float w[8];
#pragma unroll
        for (int q = 0; q < 8; ++q) w[q] = s[q * 33];
        if (gs != nullptr) { float csp = 0.f, cbp = 0.f;
#pragma unroll
            for (int q = 0; q < 8; ++q) { cbp += w[q] * bk[q]; w[q] *= gk[q]; csp += bf2f(f2bf(w[q])); }
            csp += __shfl_xor(csp, 1); csp += __shfl_xor(csp, 2); csp += __shfl_xor(csp, 4); cbp += __shfl_xor(cbp, 1); cbp += __shfl_xor(cbp, 2); cbp += __shfl_xor(cbp, 4);
            if (c == 0 && n0 + n < nvalid) { atomicAdd(cs + drow0 + n, csp); atomicAdd(cb + drow0 + n, cbp); } }
        u32x4 o; o.x = pk2(w[0], w[1]); o.y = pk2(w[2], w[3]); o.z = pk2(w[4], w[5]); o.w = pk2(w[6], w[7]);
        if (n0 + n < nvalid) *(u32x4*)(WT + (size_t)(drow0 + n) * ldt + k0 + 8 * c) = o; }
    LDS_WAIT();
}
__device__ __forceinline__ void tr_plain(const float* W, int K, int N, bf16_t* WT, int item, LAS float* scr, int lane) {
    const int nblk = (N + 31) / 32, kb = item / nblk, nb = item % nblk; tr_item(W, N, N, 64 * kb, 32 * nb, WT, K, 32 * nb, scr, lane);
}
__device__ __forceinline__ void cvt_f32_bf16(const float* src, bf16_t* dst, size_t n4, size_t gtid, size_t gstride) {
    size_t i = gtid;
    for (; i + 7 * gstride < n4; i += 8 * gstride) { f32x4 v[8];
#pragma unroll
        for (int j = 0; j < 8; ++j) v[j] = *(const f32x4*)(src + 4 * (i + j * gstride));
#pragma unroll
        for (int j = 0; j < 8; ++j) { u32x2 w; w.x = pk2(v[j].x, v[j].y); w.y = pk2(v[j].z, v[j].w); *(u32x2*)(dst + 4 * (i + j * gstride)) = w; } }
    for (; i < n4; i += gstride) { const f32x4 v = *(const f32x4*)(src + 4 * i); u32x2 w; w.x = pk2(v.x, v.y); w.y = pk2(v.z, v.w); *(u32x2*)(dst + 4 * i) = w; }
}
template <int PART>
__device__ __forceinline__ void p0_prep(int wid_s, const CAS Params& p, LAS unsigned char* lds) {
    const int lane = lane_id_(), wv = wid_s, tid = wv * 64 + lane;
    LAS float* scr = (LAS float*)(lds + wv * 16384);
    const int gw = blockIdx.x * 8 + wv, NGW = gridDim.x * 8;
    unsigned char* ws = p.ws;
    constexpr int I_INE = 16 * 64, I_SQ = 16 * 32, I_INO = 16 * 81, I_F1 = 16 * 88, I_F2 = 44 * 32, I_PL = 4 * 32, I_POOL = 32;
    constexpr int PER_L = 2 * I_F1 + I_F2 + I_SQ + I_PL;
    constexpr int NITEMS = PART == 0 ? (I_INE + I_SQ + PER_L + I_POOL) : (I_INO + I_SQ + PER_L);
    constexpr int l = PART;
    for (int it = gw; it < NITEMS; it += NGW) {
        int r = it;
        if (PART == 0) {
            if (r < I_INE) { tr_plain(p.in[I_WINE], D, 2048, (bf16_t*)(ws + WS_WINE), r, scr, lane); continue; } r -= I_INE;
            if (r < I_SQ) { tr_plain(p.in[I_WOUTE], D, D, (bf16_t*)(ws + WS_WOUTE), r, scr, lane); continue; } r -= I_SQ;
        } else {
            if (r < I_INO) { tr_plain(p.in[I_WINO], D, 2568, (bf16_t*)(ws + WS_WINO), r, scr, lane); continue; } r -= I_INO;
            if (r < I_SQ) { tr_plain(p.in[I_WOUTO], D, D, (bf16_t*)(ws + WS_WOUTO), r, scr, lane); continue; } r -= I_SQ;
        }
        if (r < PER_L) {
            if (r < 2 * I_F1) { const int which = r / I_F1, rr = r % I_F1, kb = rr / 88, nb = rr % 88, n0 = 32 * nb;
                const float* W = p.in[which ? I_FF3 : I_FF1] + (size_t)l * D * FF;
                tr_item(W, FF, FF, 64 * kb, n0, (bf16_t*)(ws + WS_W13 + l * W13_BYTES), D, (n0 >> 7) * 256 + which * 128 + (n0 & 127), scr, lane,
                        p.in[I_LN1G] + l * D, p.in[I_LN1B] + l * D, (float*)(ws + WS_CS13) + l * 5632, (float*)(ws + WS_CB13) + l * 5632); continue; } r -= 2 * I_F1;
            if (r < I_F2) { tr_plain(p.in[I_FF2] + (size_t)l * FF * D, FF, D, (bf16_t*)(ws + WS_W2 + l * W2_BYTES), r, scr, lane); continue; } r -= I_F2;
            if (r < I_SQ) { const int kb = r / 32, nb = r % 32; tr_item(p.in[I_WGATE] + (size_t)l * D * D, D, D, 64 * kb, 32 * nb, (bf16_t*)(ws + WS_WG + l * WG_BYTES), D, 32 * nb, scr, lane,
                        p.in[I_LN2G] + l * D, p.in[I_LN2B] + l * D, (float*)(ws + WS_CSG) + l * D, (float*)(ws + WS_CBG) + l * D); continue; } r -= I_SQ;
            tr_plain(p.in[I_WPLE] + (size_t)l * 256 * D, 256, D, (bf16_t*)(ws + WS_WPLE + l * WPLE_BYTES), r, scr, lane); continue; }
        r -= PER_L;
        if (PART == 0) { const int g = r >> 3, rr = r & 7; tr_plain(p.in[I_POOLW] + g * 16384, 128, 128, (bf16_t*)(ws + WS_WPOOL) + g * 16384, rr, scr, lane); }
    }
    const size_t gtid = (size_t)blockIdx.x * 512 + tid, gstride = (size_t)gridDim.x * 512;
    if (PART == 0) {
        { u32x4* z = (u32x4*)(ws + WS_STATS); const size_t n = (size_t)4 * 2 * MT * 4 / 16; for (size_t i = gtid; i < n; i += gstride) z[i] = (u32x4){0u, 0u, 0u, 0u}; }
        cvt_f32_bf16(p.in[I_XP], (bf16_t*)(ws + WS_XB), (size_t)MP * D / 4, gtid, gstride);
        cvt_f32_bf16(p.in[I_XS], (bf16_t*)(ws + WS_XB) + (size_t)MP * D, (size_t)MSAMP * D / 4, gtid, gstride);
        cvt_f32_bf16(p.in[I_PP], (bf16_t*)(ws + WS_PLEB), (size_t)MP * 256 / 4, gtid, gstride);
        cvt_f32_bf16(p.in[I_PS], (bf16_t*)(ws + WS_PLEB) + (size_t)MP * 256, (size_t)MSAMP * 256 / 4, gtid, gstride);
    } else {
        { u32x4* z = (u32x4*)(ws + WS_WINO + (size_t)2568 * D * 2); const size_t n = (size_t)(NINO - 2568) * D * 2 / 16; for (size_t i = gtid; i < n; i += gstride) z[i] = (u32x4){0u, 0u, 0u, 0u}; }
        { bf16_t* o = (bf16_t*)(ws + WS_WSGU); const float* w = p.in[I_SGUW]; for (size_t i = gtid; i < 65536; i += gstride) { const int t = (int)(i >> 7) & 127, s = (int)i & 127; o[i] = (bf16_t)((s <= t) ? f2bf(w[i]) : 0u); } }
    }
}

__device__ __forceinline__ void ln_sample(int wid_s, bf16_t* xb, const float* slab, int nsl, const float* sbf, const bf16_t* sbb, float* ssum, float* ssq,
                                          const float* pss, const float* psq, const float* g, const float* b) {
    const int lane = lane_id_(), wv = wid_s;
    const int gw = blockIdx.x * 8 + wv, NGW = gridDim.x * 8;
    for (int m = MP + gw; m < MT; m += NGW) {
        f32x4 v[4];
        if (sbf != nullptr) { const f32x4* br = (const f32x4*)(sbf + (size_t)(m - MP) * D) + lane;
#pragma unroll
            for (int j = 0; j < 4; ++j) v[j] = br[64 * j]; }
        else { const u32x2* br = (const u32x2*)(sbb + (size_t)(m - MP) * D) + lane;
#pragma unroll
            for (int j = 0; j < 4; ++j) { const u32x2 bw = br[64 * j]; v[j] = (f32x4){bf2f(bw.x & 0xffffu), __uint_as_float(bw.x & 0xffff0000u), bf2f(bw.y & 0xffffu), __uint_as_float(bw.y & 0xffff0000u)}; } }
        if (pss != nullptr) { float mean, rstd; pg8::row_stats(pss, psq, m, mean, rstd);
#pragma unroll
            for (int j = 0; j < 4; ++j) v[j] = (v[j] - mean) * rstd * *(const f32x4*)(g + 4 * lane + 256 * j) + *(const f32x4*)(b + 4 * lane + 256 * j); }
#pragma unroll
        for (int j = 0; j < 4; ++j) v[j] = v[j] * ALPHA;
        for (int sl = 0; sl < nsl; ++sl) { const f32x4* sr = (const f32x4*)(slab + (size_t)sl * (256 * D) + (size_t)(m - MP) * D) + lane;
#pragma unroll
            for (int j = 0; j < 4; ++j) v[j] += sr[64 * j]; }
        float s = 0.f, q = 0.f;
#pragma unroll
        for (int j = 0; j < 4; ++j) { s += (v[j].x + v[j].y) + (v[j].z + v[j].w); q += (v[j].x * v[j].x + v[j].y * v[j].y) + (v[j].z * v[j].z + v[j].w * v[j].w); }
        s = wave_sum(s); q = wave_sum(q);
        if (lane == 0) { ssum[m] = s; ssq[m] = q; }
        u32x2* o8 = (u32x2*)(xb + (size_t)m * D) + lane;
#pragma unroll
        for (int j = 0; j < 4; ++j) { u32x2 w; w.x = pk2(v[j].x, v[j].y); w.y = pk2(v[j].z, v[j].w); o8[64 * j] = w; }
    }
}

__device__ __forceinline__ void even_mixer_tile(int wid_s, const CAS Params& p, LAS unsigned char* lds, int ti) {
    const int lane = lane_id_(), wv = wid_s, tid = wv * 64 + lane;
    int row0, nvalid, tpos0, sb = -1, b = 0;
    if (ti < 256) { row0 = ti * 64; nvalid = 64; tpos0 = row0 & (SEQ - 1); b = ti >> 7; } else { sb = ti - 256; row0 = MP + sb * 32; nvalid = 32; tpos0 = 4096; }
    const bf16_t* H0 = (const bf16_t*)(p.ws + WS_REGA); bf16_t* MIX = (bf16_t*)(p.ws + WS_MIX);
    const bf16_t* poolT = (const bf16_t*)(p.ws + WS_WPOOL);
    constexpr int LDA = 520;
    LAS bf16_t* A2 = (LAS bf16_t*)lds;
    const bool first = (sb < 0 && tpos0 == 0);
    const bool lasttile = (sb >= 0) || (tpos0 == SEQ - 64);
#pragma unroll 5
    for (int it = tid; it < 79 * 64; it += 512) { const int j = it >> 6, c8 = (it & 63) * 8, tok = j - 15; u32x4 w = (u32x4){0u, 0u, 0u, 0u};
        if (tok < nvalid) {
            if (tok >= 0 || (sb < 0 && !first)) w = *(const u32x4*)(H0 + (size_t)(row0 + tok) * NH0 + c8);
            else if (sb >= 0) { float v[8]; load8f(p.in[I_STPOOL] + (size_t)(sb * 15 + j) * 512 + c8, v); w = pack8(v); } }
        *(LAS u32x4*)(A2 + j * LDA + c8) = w; }
    __syncthreads();
    { const int c = tid, gi = c >> 7, w = 2 << gi; float W = 0.f;
        for (int k = 0; k < w; ++k) W += bf2f((unsigned)A2[(15 + 63 - k) * LDA + c]);
        const float inv = 1.f / (float)w;
        for (int t = 63; t >= 0; --t) { const float a = bf2f((unsigned)A2[(15 + t) * LDA + c]);
            if (lasttile && t < nvalid && t >= nvalid - 15) { const int j = t - (nvalid - 15); p.out[((sb >= 0) ? O_POOLS + (size_t)(sb * 15 + j) * 512 : O_POOLP + (size_t)(b * 15 + j) * 512) + c] = a; }
            const float sc = (first && t + 1 < w) ? 1.f / (float)(t + 1) : inv;
            const float d = W * sc - a;
            if (t > 0) W += bf2f((unsigned)A2[(15 + t - w) * LDA + c]) - a;
            A2[(15 + t) * LDA + c] = (bf16_t)f2bf(d); } }
    __syncthreads();
    { const int gi = wv >> 1, eb = (wv & 1) * 4; f32x4 acc[4][4];
#pragma unroll
        for (int tt = 0; tt < 4; ++tt)
#pragma unroll
            for (int q = 0; q < 4; ++q) acc[tt][q] = (f32x4){0.f, 0.f, 0.f, 0.f};
#pragma unroll
        for (int ks = 0; ks < 4; ++ks) { bf16x8 bfr[4];
#pragma unroll
            for (int q = 0; q < 4; ++q) bfr[q] = *(const bf16x8*)(poolT + gi * 16384 + ((eb + q) * 16 + (lane & 15)) * 128 + ks * 32 + 8 * (lane >> 4));
#pragma unroll
            for (int tt = 0; tt < 4; ++tt) { const bf16x8 af = *(const LAS bf16x8*)(A2 + (15 + tt * 16 + (lane & 15)) * LDA + gi * 128 + ks * 32 + 8 * (lane >> 4));
#pragma unroll
                for (int q = 0; q < 4; ++q) acc[tt][q] = mfma16(bfr[q], af, acc[tt][q]); } }
#pragma unroll
        for (int q = 0; q < 4; ++q) { const int e0 = (eb + q) * 16 + (lane >> 4) * 4; const f32x4 sc = *(const f32x4*)(p.in[I_POOLSC] + gi * 128 + e0);
#pragma unroll
            for (int tt = 0; tt < 4; ++tt) { const int t = tt * 16 + (lane & 15);
                if (t < nvalid) { u32x2 o; o.x = pk2(acc[tt][q][0] * sc[0], acc[tt][q][1] * sc[1]); o.y = pk2(acc[tt][q][2] * sc[2], acc[tt][q][3] * sc[3]);
                    *(u32x2*)(MIX + (size_t)(row0 + t) * D + gi * 128 + e0) = o; } } } }
    const float* cw = p.in[I_CONVW];
#pragma unroll 2
    for (int it = tid; it < nvalid * 64; it += 512) { const int t = it >> 6, c8 = (it & 63) * 8; float cg[3][8];
        { float cgt[3][8], hv[3][8];
#pragma unroll
            for (int dk = 0; dk < 3; ++dk) { const int tok = t - 2 + dk; const int tokc = (tok < 0 && (first || sb >= 0)) ? 0 : tok;
                load8bf(H0 + (size_t)(row0 + tokc) * NH0 + 1024 + c8, cgt[dk]); load8bf(H0 + (size_t)(row0 + tokc) * NH0 + 1536 + c8, hv[dk]); }
#pragma unroll
            for (int dk = 0; dk < 3; ++dk)
#pragma unroll
                for (int q = 0; q < 8; ++q) cg[dk][q] = cgt[dk][q] * hv[dk][q];
            if (sb >= 0) {
#pragma unroll
                for (int dk = 0; dk < 2; ++dk) { const int tok = t - 2 + dk; if (tok < 0) load8f(p.in[I_STCONV] + (size_t)(sb * 2 + 2 + tok) * 512 + c8, cg[dk]); }
            } else if (first) {
#pragma unroll
                for (int dk = 0; dk < 2; ++dk) { const bool hist = (t - 2 + dk) < 0;
#pragma unroll
                    for (int q = 0; q < 8; ++q) cg[dk][q] = hist ? 0.f : cg[dk][q]; } } }
        float bg[8], w0[8], w1[8], w2[8], y[8];
        load8bf(H0 + (size_t)(row0 + t) * NH0 + 512 + c8, bg); load8f(cw + c8, w0); load8f(cw + 512 + c8, w1); load8f(cw + 1024 + c8, w2);
#pragma unroll
        for (int q = 0; q < 8; ++q) y[q] = bg[q] * (w0[q] * cg[0][q] + w1[q] * cg[1][q] + w2[q] * cg[2][q]);
        *(u32x4*)(MIX + (size_t)(row0 + t) * D + 512 + c8) = pack8(y);
        if (lasttile && t >= nvalid - 2) { const int j = t - (nvalid - 2); float* o = p.out + ((sb >= 0) ? O_CONVS + (size_t)(sb * 2 + j) * 512 + c8 : O_CONVP + (size_t)(b * 2 + j) * 512 + c8);
            *(f32x4*)o = (f32x4){cg[2][0], cg[2][1], cg[2][2], cg[2][3]}; *(f32x4*)(o + 4) = (f32x4){cg[2][4], cg[2][5], cg[2][6], cg[2][7]}; }
    }
    __syncthreads();
}

__device__ __forceinline__ void even_mixer_part(int wid_s, const CAS Params& p, LAS unsigned char* lds, int ti, int part) {
    const int lane = lane_id_(), wv = wid_s, tid = wv * 64 + lane;
    int row0, nvalid, tpos0, sb = -1, b = 0;
    if (ti < 256) { row0 = ti * 64; nvalid = 64; tpos0 = row0 & (SEQ - 1); b = ti >> 7; } else { sb = ti - 256; row0 = MP + sb * 32; nvalid = 32; tpos0 = 4096; }
    const bf16_t* H0 = (const bf16_t*)(p.ws + WS_REGA); bf16_t* MIX = (bf16_t*)(p.ws + WS_MIX);
    const bf16_t* poolT = (const bf16_t*)(p.ws + WS_WPOOL);
    LAS float* araw = (LAS float*)lds; LAS bf16_t* dA = (LAS bf16_t*)(lds + 40448);
    const bool first = (sb < 0 && tpos0 == 0);
    const bool lasttile = (sb >= 0) || (tpos0 == SEQ - 64);
    if (part < 4) { const int gi = part;
        for (int it = tid; it < 79 * 16; it += 512) { const int j = it >> 4, c8 = (it & 15) * 8, tok = j - 15; float v[8];
#pragma unroll
            for (int q = 0; q < 8; ++q) v[q] = 0.f;
            if (tok < nvalid) {
                if (tok >= 0 || (sb < 0 && !first)) load8bf(H0 + (size_t)(row0 + tok) * NH0 + gi * 128 + c8, v);
                else if (sb >= 0) load8f(p.in[I_STPOOL] + (size_t)(sb * 15 + j) * 512 + gi * 128 + c8, v);
            }
            *(LAS f32x4*)(araw + j * 128 + c8) = (f32x4){v[0], v[1], v[2], v[3]}; *(LAS f32x4*)(araw + j * 128 + c8 + 4) = (f32x4){v[4], v[5], v[6], v[7]}; }
        __syncthreads();
        if (lasttile) { for (int it = tid; it < 15 * 128; it += 512) { const int j = it >> 7, c = it & 127, t = nvalid - 15 + j;
                const size_t o = (sb >= 0) ? O_POOLS + (size_t)(sb * 15 + j) * 512 + gi * 128 + c : O_POOLP + (size_t)(b * 15 + j) * 512 + gi * 128 + c;
                p.out[o] = araw[(15 + t) * 128 + c]; } }
        const int w = 2 << gi;
        for (int it = tid; it < 64 * 128; it += 512) { const int t = it >> 7, c = it & 127; float s = 0.f;
            for (int k = 0; k < w; ++k) s += araw[(15 + t - k) * 128 + c];
            const int cnt = first ? (w < t + 1 ? w : t + 1) : w;
            dA[t * 136 + c] = (bf16_t)f2bf(s / (float)cnt - araw[(15 + t) * 128 + c]); }
        __syncthreads();
        { const int tt = wv & 3, eb = (wv >> 2) * 4; f32x4 acc[4];
#pragma unroll
            for (int q = 0; q < 4; ++q) acc[q] = (f32x4){0.f, 0.f, 0.f, 0.f};
#pragma unroll
            for (int ks = 0; ks < 4; ++ks) { const bf16x8 af = *(const LAS bf16x8*)(dA + (tt * 16 + (lane & 15)) * 136 + ks * 32 + 8 * (lane >> 4));
#pragma unroll
                for (int q = 0; q < 4; ++q) { const bf16x8 bf = *(const bf16x8*)(poolT + gi * 16384 + ((eb + q) * 16 + (lane & 15)) * 128 + ks * 32 + 8 * (lane >> 4)); acc[q] = mfma16(bf, af, acc[q]); } }
            const int t = tt * 16 + (lane & 15);
            if (t < nvalid) {
#pragma unroll
                for (int q = 0; q < 4; ++q) { const int e0 = (eb + q) * 16 + (lane >> 4) * 4; const f32x4 sc = *(const f32x4*)(p.in[I_POOLSC] + gi * 128 + e0);
                    u32x2 o; o.x = pk2(acc[q][0] * sc[0], acc[q][1] * sc[1]); o.y = pk2(acc[q][2] * sc[2], acc[q][3] * sc[3]);
                    *(u32x2*)(MIX + (size_t)(row0 + t) * D + gi * 128 + e0) = o; } } }
        __syncthreads();
    }
    if (part < 4) return;
    const float* cw = p.in[I_CONVW];
    for (int it = tid; it < nvalid * 32; it += 512) { const int t = it >> 5, c8 = (part - 4) * 256 + (it & 31) * 8; float cg[3][8];
#pragma unroll
        for (int dk = 0; dk < 3; ++dk) { const int tok = t - 2 + dk;
            if (tok >= 0 || (sb < 0 && !first)) { float cgt[8], hv[8]; load8bf(H0 + (size_t)(row0 + tok) * NH0 + 1024 + c8, cgt); load8bf(H0 + (size_t)(row0 + tok) * NH0 + 1536 + c8, hv);
#pragma unroll
                for (int q = 0; q < 8; ++q) cg[dk][q] = cgt[q] * hv[q]; }
            else if (sb >= 0) { float hv[8]; load8f(p.in[I_STCONV] + (size_t)(sb * 2 + 2 + tok) * 512 + c8, hv);
#pragma unroll
                for (int q = 0; q < 8; ++q) cg[dk][q] = hv[q]; }
            else {
#pragma unroll
                for (int q = 0; q < 8; ++q) cg[dk][q] = 0.f; } }
        float bg[8], w0[8], w1[8], w2[8], y[8];
        load8bf(H0 + (size_t)(row0 + t) * NH0 + 512 + c8, bg); load8f(cw + c8, w0); load8f(cw + 512 + c8, w1); load8f(cw + 1024 + c8, w2);
#pragma unroll
        for (int q = 0; q < 8; ++q) y[q] = bg[q] * (w0[q] * cg[0][q] + w1[q] * cg[1][q] + w2[q] * cg[2][q]);
        *(u32x4*)(MIX + (size_t)(row0 + t) * D + 512 + c8) = pack8(y);
        if (lasttile && t >= nvalid - 2) { const int j = t - (nvalid - 2); float* o = p.out + ((sb >= 0) ? O_CONVS + (size_t)(sb * 2 + j) * 512 + c8 : O_CONVP + (size_t)(b * 2 + j) * 512 + c8);
            *(f32x4*)o = (f32x4){cg[2][0], cg[2][1], cg[2][2], cg[2][3]}; *(f32x4*)(o + 4) = (f32x4){cg[2][4], cg[2][5], cg[2][6], cg[2][7]}; }
    }
    __syncthreads();
}

__device__ __forceinline__ void sgu_block(int wid_s, const CAS Params& p, LAS unsigned char* lds, int bi) {
    const int lane = lane_id_(), wv = wid_s, tid = wv * 64 + lane;
    int row0, nvalid, sb = -1;
    if (bi < 128) { row0 = bi * 128; nvalid = 128; } else { sb = bi - 128; row0 = MP + sb * 32; nvalid = 32; }
    const bf16_t* H1 = (const bf16_t*)(p.ws + WS_REGA); bf16_t* MIX = (bf16_t*)(p.ws + WS_MIX); const bf16_t* sguW = (const bf16_t*)(p.ws + WS_WSGU);
    LAS float* stats = (LAS float*)lds; LAS bf16_t* vT = (LAS bf16_t*)(lds + 1024);
    { const int t = wv * 16 + (lane >> 2), sub = lane & 3;
        float s = 0.f, s2 = 0.f;
        if (t < nvalid) {
#pragma unroll 4
            for (int i = 0; i < 16; ++i) { float v[8]; load8bf(H1 + (size_t)(row0 + t) * NH1 + 512 + sub * 128 + i * 8, v);
#pragma unroll
                for (int q = 0; q < 8; ++q) { const float gv = geluf_(v[q]); s += gv; s2 += gv * gv; } } }
        s += __shfl_xor(s, 1); s += __shfl_xor(s, 2); s2 += __shfl_xor(s2, 1); s2 += __shfl_xor(s2, 2);
        const float mean = s * (1.f / 512.f), var = fmaxf(s2 * (1.f / 512.f) - mean * mean, 0.f);
        if (t < nvalid && sub == 0) { stats[2 * t] = mean; stats[2 * t + 1] = 1.f / sqrtf(var + LN_EPS); } }
    __syncthreads();
    for (int g = 0; g < 4; ++g) {
#pragma unroll 4
    for (int it = tid; it < 128 * 16; it += 512) { const int blk = it >> 6, s = (blk & 15) * 8 + (lane >> 3), d8 = ((blk >> 4) * 8 + (lane & 7)) * 8;
            if (s < nvalid) { float v[8], lg[8], lb[8]; load8bf(H1 + (size_t)(row0 + s) * NH1 + 512 + g * 128 + d8, v); load8f(p.in[I_SGULNG] + g * 128 + d8, lg); load8f(p.in[I_SGULNB] + g * 128 + d8, lb);
                const float mean = stats[2 * s], rstd = stats[2 * s + 1];
#pragma unroll
                for (int q = 0; q < 8; ++q) { v[q] = (geluf_(v[q]) - mean) * rstd * lg[q] + lb[q]; vT[(d8 + q) * 136 + swz(d8 + q, s)] = (bf16_t)f2bf(v[q]); }
                if (sb >= 0) { float* o = p.out + O_SGUV + (size_t)(sb * 32 + s) * 512 + g * 128 + d8; *(f32x4*)o = (f32x4){v[0], v[1], v[2], v[3]}; *(f32x4*)(o + 4) = (f32x4){v[4], v[5], v[6], v[7]}; }
            } else {
#pragma unroll
                for (int q = 0; q < 8; ++q) vT[(d8 + q) * 136 + swz(d8 + q, s)] = (bf16_t)0; } }
        __syncthreads();
        if (wv * 16 < nvalid) {
            f32x4 acc[8];
#pragma unroll
            for (int q = 0; q < 8; ++q) acc[q] = (f32x4){0.f, 0.f, 0.f, 0.f};
            const int nks = (wv + 2) >> 1;
            for (int ks = 0; ks < nks; ++ks) { const bf16x8 wf = *(const bf16x8*)(sguW + g * 16384 + (wv * 16 + (lane & 15)) * 128 + ks * 32 + 8 * (lane >> 4));
#pragma unroll
                for (int q = 0; q < 8; ++q) { const int dr = q * 16 + (lane & 15); const bf16x8 vf = *(const LAS bf16x8*)(vT + dr * 136 + swz(dr, ks * 32 + 8 * (lane >> 4))); acc[q] = mfma16(vf, wf, acc[q]); } }
            const int t = wv * 16 + (lane & 15);
            if (t < nvalid) { const float bias = p.in[I_SGUB][g * 128 + t];
#pragma unroll
                for (int q = 0; q < 8; ++q) { const int d0 = q * 16 + (lane >> 4) * 4; const u32x2 uw = *(const u32x2*)(H1 + (size_t)(row0 + t) * NH1 + g * 128 + d0);
                    const float u0 = geluf_(bf2f(uw.x & 0xffffu)), u1 = geluf_(__uint_as_float(uw.x & 0xffff0000u)), u2 = geluf_(bf2f(uw.y & 0xffffu)), u3 = geluf_(__uint_as_float(uw.y & 0xffff0000u));
                    u32x2 o; o.x = pk2(u0 * (acc[q][0] + bias), u1 * (acc[q][1] + bias)); o.y = pk2(u2 * (acc[q][2] + bias), u3 * (acc[q][3] + bias));
                    *(u32x2*)(MIX + (size_t)(row0 + t) * D + g * 128 + d0) = o; } } }
        __syncthreads();
    }
}

__device__ __forceinline__ void ssm_conv8(const CAS Params& p, const bf16_t* H1, int row0, int t, int col8, int sb, bool first, float (&o)[8]) {
    float a[8]; load8f(p.in[I_SSMCB] + col8, a);
    float xv[4][8], wk[4][8];
#pragma unroll
    for (int k = 0; k < 4; ++k) { const int tok = t - 3 + k; const int tokc = (tok < 0 && (first || sb >= 0)) ? 0 : tok;
        load8bf(H1 + (size_t)(row0 + tokc) * NH1 + 1536 + col8, xv[k]); load8f(p.in[I_SSMCW] + k * 1024 + col8, wk[k]); }
    if (sb >= 0) {
#pragma unroll
        for (int k = 0; k < 3; ++k) { const int tok = t - 3 + k; if (tok < 0) load8f(p.in[I_STSSMCONV] + (size_t)(sb * 3 + 3 + tok) * 1024 + col8, xv[k]); }
    } else if (first) {
#pragma unroll
        for (int k = 0; k < 3; ++k) { const bool hist = (t - 3 + k) < 0;
#pragma unroll
            for (int q = 0; q < 8; ++q) xv[k][q] = hist ? 0.f : xv[k][q]; }
    }
#pragma unroll
    for (int k = 0; k < 4; ++k)
#pragma unroll
        for (int q = 0; q < 8; ++q) a[q] += wk[k][q] * xv[k][q];
#pragma unroll
    for (int q = 0; q < 8; ++q) o[q] = siluf_(a[q]);
}
__device__ __forceinline__ void ssd_dt(int wid_s, const CAS Params& p, int row0, int nvalid, int g, LAS float* acum, LAS float* dtv, float* dec_out  ) {
    const int lane = lane_id_(), wv = wid_s, tid = wv * 64 + lane;
    if (wv < 4) { const int h = 4 * g + wv; const float* DT = (const float*)(p.ws + WS_DT);
        float dt = 0.f; if (lane < nvalid) dt = softplusf_(DT[(size_t)(row0 + lane) * 8 + h] + p.in[I_DTB][h]);
        const float a = -__expf(p.in[I_ALOG][h]); float v = dt * a;
#pragma unroll
        for (int o = 1; o < 64; o <<= 1) { const float t = __shfl_up(v, o); if (lane >= o) v += t; }
        acum[wv * 64 + lane] = v; dtv[wv * 64 + lane] = dt;
        if (dec_out != nullptr && lane == 63) dec_out[h] = __expf(v); }
}
__device__ __forceinline__ void ssd_chunk_geom(int ci, int& row0, int& nvalid, int& sb, bool& first) {
    if (ci < 256) { row0 = ci * 64; nvalid = 64; sb = -1; first = (ci & 127) == 0; } else { sb = ci - 256; row0 = MP + sb * 32; nvalid = 32; first = false; }
}
__device__ __forceinline__ void ssd_stepA(int wid_s, const CAS Params& p, LAS unsigned char* lds, int task) {
    const int lane = lane_id_(), wv = wid_s, tid = wv * 64 + lane;
    const int ci = task >> 1, g = task & 1; int row0, nvalid, sb; bool first; ssd_chunk_geom(ci, row0, nvalid, sb, first);
    const bf16_t* H1 = (const bf16_t*)(p.ws + WS_REGA);
    LAS bf16_t* xT = (LAS bf16_t*)lds; LAS bf16_t* BT = (LAS bf16_t*)(lds + 36864); LAS float* acum = (LAS float*)(lds + 55296); LAS float* dtv = (LAS float*)(lds + 56320);
    ssd_dt(wid_s, p, row0, nvalid, g, acum, dtv, (float*)(p.ws + WS_DEC) + ci * 8);
    float vv[6][8];
#pragma unroll
    for (int j = 0; j < 6; ++j) { const int blk = (tid >> 6) + 8 * j, t = (blk & 7) * 8 + (lane >> 3), cc = (blk >> 3) * 8 + (lane & 7);
        const int col = (cc < 32) ? 256 * g + cc * 8 : 512 + 128 * g + (cc - 32) * 8;
        if (t < nvalid) ssm_conv8(p, H1, row0, t, col, sb, first, vv[j]);
        else {
#pragma unroll
            for (int q = 0; q < 8; ++q) vv[j][q] = 0.f; } }
    __syncthreads();
#pragma unroll
    for (int j = 0; j < 6; ++j) { const int blk = (tid >> 6) + 8 * j, t = (blk & 7) * 8 + (lane >> 3), cc = (blk >> 3) * 8 + (lane & 7);
        if (cc < 32) { const int c8 = cc * 8, hh = c8 >> 6; const float te = __expf(acum[hh * 64 + 63] - acum[hh * 64 + t]) * dtv[hh * 64 + t];
#pragma unroll
            for (int q = 0; q < 8; ++q) xT[(c8 + q) * 72 + swz(c8 + q, t)] = (bf16_t)f2bf(vv[j][q] * te);
        } else { const int c8 = (cc - 32) * 8;
#pragma unroll
            for (int q = 0; q < 8; ++q) BT[(c8 + q) * 72 + swz(c8 + q, t)] = (bf16_t)f2bf(vv[j][q]); } }
    __syncthreads();
    f32x4 acc[2][8];
#pragma unroll
    for (int q = 0; q < 2; ++q)
#pragma unroll
        for (int nt = 0; nt < 8; ++nt) acc[q][nt] = (f32x4){0.f, 0.f, 0.f, 0.f};
#pragma unroll
    for (int ks = 0; ks < 2; ++ks) { bf16x8 xf[2];
#pragma unroll
        for (int q = 0; q < 2; ++q) { const int pr = (2 * wv + q) * 16 + (lane & 15); xf[q] = *(const LAS bf16x8*)(xT + pr * 72 + swz(pr, ks * 32 + 8 * (lane >> 4))); }
#pragma unroll
        for (int nt = 0; nt < 8; ++nt) { const int nr = nt * 16 + (lane & 15); const bf16x8 bf = *(const LAS bf16x8*)(BT + nr * 72 + swz(nr, ks * 32 + 8 * (lane >> 4)));
#pragma unroll
            for (int q = 0; q < 2; ++q) acc[q][nt] = mfma16(bf, xf[q], acc[q][nt]); } }
    float* Sb = (float*)(p.ws + WS_SSAMP) + (size_t)(sb >= 0 ? sb : 0) * 65536; bf16_t* Sb16 = (bf16_t*)(p.ws + WS_XB) + (size_t)ci * 65536;
#pragma unroll
    for (int q = 0; q < 2; ++q) { const int pall = (2 * wv + q) * 16 + (lane & 15), h = 4 * g + (pall >> 6), pp = pall & 63;
#pragma unroll
        for (int nt = 0; nt < 8; ++nt) { const size_t o = (size_t)(h * 64 + pp) * 128 + nt * 16 + (lane >> 4) * 4;
            if (sb >= 0) *(f32x4*)(Sb + o) = acc[q][nt];
            else { u32x2 w; w.x = pk2(acc[q][nt][0], acc[q][nt][1]); w.y = pk2(acc[q][nt][2], acc[q][nt][3]); *(u32x2*)(Sb16 + o) = w; } } }
    __syncthreads();
}
__device__ __forceinline__ void ssd_stepB(int wid_s, const CAS Params& p) {
    const size_t gtid = (size_t)blockIdx.x * 512 + TIDX, gstride = (size_t)gridDim.x * 512;
    const float* DEC = (const float*)(p.ws + WS_DEC);
    for (size_t e = gtid; e < 131072; e += gstride) { const int b = (int)(e >> 16), rem = (int)(e & 65535), h = rem >> 13;
        bf16_t* sp = (bf16_t*)(p.ws + WS_XB) + (size_t)b * 128 * 65536 + rem; float st = 0.f;
        for (int c0 = 0; c0 < 128; c0 += 8) { float s[8], dc[8];
#pragma unroll
            for (int i = 0; i < 8; ++i) { s[i] = bf2f((unsigned)sp[(size_t)(c0 + i) * 65536]); dc[i] = DEC[(b * 128 + c0 + i) * 8 + h]; }
#pragma unroll
            for (int i = 0; i < 8; ++i) { sp[(size_t)(c0 + i) * 65536] = (bf16_t)f2bf(st); st = st * dc[i] + s[i]; } }
        p.out[O_SSMP + e] = st; }
    const float* SS = (const float*)(p.ws + WS_SSAMP);
    for (size_t e = gtid; e < 524288; e += gstride) { const int sb = (int)(e >> 16), h = (int)(e & 65535) >> 13;
        p.out[O_SSMS + e] = p.in[I_STSSM][e] * DEC[(256 + sb) * 8 + h] + SS[e]; }
    const bf16_t* H1 = (const bf16_t*)(p.ws + WS_REGA);
    for (size_t e = gtid; e < 6144 + 24576; e += gstride) {
        if (e < 6144) { const int b = (int)e / 3072, j = ((int)e % 3072) >> 10, c = (int)e & 1023; p.out[O_SCP + e] = bf2f(H1[(size_t)(b * SEQ + SEQ - 3 + j) * NH1 + 1536 + c]); }
        else { const int e2 = (int)e - 6144, sb = e2 / 3072, j = (e2 % 3072) >> 10, c = e2 & 1023; p.out[O_SCS + e2] = bf2f(H1[(size_t)(MP + sb * 32 + 29 + j) * NH1 + 1536 + c]); } }
}
__device__ __forceinline__ void ssd_stepC(int wid_s, const CAS Params& p, LAS unsigned char* lds, int task) {
    const int lane = lane_id_(), wv = wid_s, tid = wv * 64 + lane;
    const int ci = task >> 1, g = task & 1; int row0, nvalid, sb; bool first; ssd_chunk_geom(ci, row0, nvalid, sb, first);
    const bf16_t* H1 = (const bf16_t*)(p.ws + WS_REGA); bf16_t* MIX = (bf16_t*)(p.ws + WS_MIX);
    LAS bf16_t* xT = (LAS bf16_t*)lds; LAS bf16_t* Bm = (LAS bf16_t*)(lds + 36864); LAS bf16_t* Cm = (LAS bf16_t*)(lds + 54272); LAS bf16_t* Mm = (LAS bf16_t*)(lds + 71680);
    LAS float* acum = (LAS float*)(lds + 108544); LAS float* dtv = (LAS float*)(lds + 109568); LAS float* ssq = (LAS float*)(lds + 110592);
    bf16x8 hfp[4][2];
#pragma unroll
    for (int ks = 0; ks < 4; ++ks)
#pragma unroll
        for (int q = 0; q < 2; ++q) { const int pall = (2 * wv + q) * 16 + (lane & 15), pp = pall & 63; const size_t o = (size_t)((4 * g + (wv >> 1)) * 64 + pp) * 128 + ks * 32 + 8 * (lane >> 4);
            if (sb >= 0) { float hv[8]; load8f(p.in[I_STSSM] + (size_t)sb * 65536 + o, hv); const u32x4 w = pack8(hv); hfp[ks][q] = __builtin_bit_cast(bf16x8, w); }
            else hfp[ks][q] = *(const bf16x8*)((const bf16_t*)(p.ws + WS_XB) + (size_t)ci * 65536 + o); }
    ssd_dt(wid_s, p, row0, nvalid, g, acum, dtv, nullptr);
    { float vv[8][8];
#pragma unroll
        for (int j = 0; j < 8; ++j) { const int blk = (tid >> 6) + 8 * j, t = (blk & 7) * 8 + (lane >> 3), cc = (blk >> 3) * 8 + (lane & 7);
            const int col = (cc < 32) ? 256 * g + cc * 8 : (cc < 48) ? 512 + 128 * g + (cc - 32) * 8 : 768 + 128 * g + (cc - 48) * 8;
            if (t < nvalid) ssm_conv8(p, H1, row0, t, col, sb, first, vv[j]);
            else {
#pragma unroll
                for (int q = 0; q < 8; ++q) vv[j][q] = 0.f; } }
#pragma unroll
        for (int j = 0; j < 8; ++j) { const int blk = (tid >> 6) + 8 * j, t = (blk & 7) * 8 + (lane >> 3), cc = (blk >> 3) * 8 + (lane & 7);
            if (cc < 32) {
#pragma unroll
                for (int q = 0; q < 8; ++q) xT[(cc * 8 + q) * 72 + swz(cc * 8 + q, t)] = (bf16_t)f2bf(vv[j][q]); }
            else if (cc < 48) *(LAS u32x4*)(Bm + t * 136 + (cc - 32) * 8) = pack8(vv[j]);
            else *(LAS u32x4*)(Cm + t * 136 + (cc - 48) * 8) = pack8(vv[j]); } }
    __syncthreads();
    { const int tt = wv >> 1;
#pragma unroll
        for (int q = 0; q < 2; ++q) { const int st = (wv & 1) * 2 + q; f32x4 acc = (f32x4){0.f, 0.f, 0.f, 0.f};
            if (st <= tt) {
#pragma unroll
                for (int ks = 0; ks < 4; ++ks) { const bf16x8 cf = *(const LAS bf16x8*)(Cm + (tt * 16 + (lane & 15)) * 136 + ks * 32 + 8 * (lane >> 4));
                    const bf16x8 bf = *(const LAS bf16x8*)(Bm + (st * 16 + (lane & 15)) * 136 + ks * 32 + 8 * (lane >> 4)); acc = mfma16(cf, bf, acc); } }
            const int s = st * 16 + (lane & 15);
#pragma unroll
            for (int hh = 0; hh < 4; ++hh) { const float as = acum[hh * 64 + s], ds = dtv[hh * 64 + s];
#pragma unroll
                for (int r = 0; r < 4; ++r) { const int t = tt * 16 + (lane >> 4) * 4 + r; const float val = (s <= t) ? acc[r] * __expf(acum[hh * 64 + t] - as) * ds : 0.f;
                    Mm[(hh * 64 + t) * 72 + s] = (bf16_t)f2bf(val); } } } }
    __syncthreads();
    const int hh = wv >> 1, h = 4 * g + hh;
    f32x4 yi[4][2], yo[4][2];
#pragma unroll
    for (int tt = 0; tt < 4; ++tt)
#pragma unroll
        for (int q = 0; q < 2; ++q) { yi[tt][q] = (f32x4){0.f, 0.f, 0.f, 0.f}; yo[tt][q] = (f32x4){0.f, 0.f, 0.f, 0.f}; }
#pragma unroll
    for (int ks = 0; ks < 2; ++ks) { bf16x8 xf[2];
#pragma unroll
        for (int q = 0; q < 2; ++q) { const int pr = (2 * wv + q) * 16 + (lane & 15); xf[q] = *(const LAS bf16x8*)(xT + pr * 72 + swz(pr, ks * 32 + 8 * (lane >> 4))); }
#pragma unroll
        for (int tt = 0; tt < 4; ++tt) { const bf16x8 mf = *(const LAS bf16x8*)(Mm + (hh * 64 + tt * 16 + (lane & 15)) * 72 + ks * 32 + 8 * (lane >> 4));
#pragma unroll
            for (int q = 0; q < 2; ++q) yi[tt][q] = mfma16(xf[q], mf, yi[tt][q]); } }
#pragma unroll
    for (int ks = 0; ks < 4; ++ks) {
#pragma unroll
        for (int tt = 0; tt < 4; ++tt) { const bf16x8 cf = *(const LAS bf16x8*)(Cm + (tt * 16 + (lane & 15)) * 136 + ks * 32 + 8 * (lane >> 4));
#pragma unroll
            for (int q = 0; q < 2; ++q) yo[tt][q] = mfma16(hfp[ks][q], cf, yo[tt][q]); } }
    const float dsk = p.in[I_SSMD][h];
#pragma unroll
    for (int tt = 0; tt < 4; ++tt) { const int t = tt * 16 + (lane & 15); const float ea = __expf(acum[hh * 64 + t]); float sq = 0.f;
#pragma unroll
        for (int q = 0; q < 2; ++q) { const int pall = (2 * wv + q) * 16 + (lane >> 4) * 4;
            const u32x2 zw = *(const u32x2*)(H1 + (size_t)(row0 + (t < nvalid ? t : nvalid - 1)) * NH1 + 1024 + 256 * g + pall);
            const float z0 = bf2f(zw.x & 0xffffu), z1 = __uint_as_float(zw.x & 0xffff0000u), z2 = bf2f(zw.y & 0xffffu), z3 = __uint_as_float(zw.y & 0xffff0000u);
            const float zz[4] = {z0, z1, z2, z3};
#pragma unroll
            for (int r = 0; r < 4; ++r) { const float xv = bf2f((unsigned)xT[(pall + r) * 72 + swz(pall + r, t)]); const float y = yi[tt][q][r] + ea * yo[tt][q][r] + dsk * xv; const float gv = y * siluf_(zz[r]); yi[tt][q][r] = gv; sq += gv * gv; } }
        sq += __shfl_xor(sq, 16); sq += __shfl_xor(sq, 32);
        if ((lane >> 4) == 0) ssq[t * 8 + wv] = sq; }
    __syncthreads();
#pragma unroll
    for (int tt = 0; tt < 4; ++tt) { const int t = tt * 16 + (lane & 15);
        const f32x4 s0 = *(const LAS f32x4*)(ssq + t * 8), s1 = *(const LAS f32x4*)(ssq + t * 8 + 4);
        const float tot = (s0[0] + s0[1]) + (s0[2] + s0[3]) + (s1[0] + s1[1]) + (s1[2] + s1[3]); const float rs = 1.f / sqrtf(tot * (1.f / 256.f) + 1e-5f);
        if (t < nvalid) {
#pragma unroll
            for (int q = 0; q < 2; ++q) { const int pall = (2 * wv + q) * 16 + (lane >> 4) * 4; const f32x4 nw = *(const f32x4*)(p.in[I_SSMNW] + 256 * g + pall);
                u32x2 o; o.x = pk2(yi[tt][q][0] * rs * nw[0], yi[tt][q][1] * rs * nw[1]); o.y = pk2(yi[tt][q][2] * rs * nw[2], yi[tt][q][3] * rs * nw[3]);
                *(u32x2*)(MIX + (size_t)(row0 + t) * D + 512 + 256 * g + pall) = o; } } }
    __syncthreads();
}

#define XB_TMO      128
#define XB_XCNT(j)  (256  + 64 * (j))
#define XB_XSUB(j)  (1280 + 64 * (j))
#define XB_XGEN(j)  (2304 + 64 * (j))
#define XB_TOP      3328
#define XB_TOPGEN   3392
#define XCD_BAR_WORDS 3456
#define XB_SPIN_CAP (1u << 18)

__device__ __forceinline__ unsigned xb_ld(unsigned* p)              { return __hip_atomic_load(p, __ATOMIC_RELAXED, __HIP_MEMORY_SCOPE_AGENT); }
__device__ __forceinline__ unsigned xb_add(unsigned* p, unsigned v) { return __hip_atomic_fetch_add(p, v, __ATOMIC_RELAXED, __HIP_MEMORY_SCOPE_AGENT); }
__device__ __forceinline__ unsigned xb_xcc_id() { return (unsigned)__builtin_amdgcn_s_getreg((3 << 11) | 20) & 0xFu; }
#define XB_SPIN(cond, bar) do { unsigned _sp = 0; while (cond) { __builtin_amdgcn_s_sleep(1); \
    if ((++_sp & 255u) == 0u) { if (xb_ld(&(bar)[XB_TMO])) break; if (_sp > XB_SPIN_CAP) { atomicAdd(&(bar)[XB_TMO], 1u); break; } } } } while (0)

struct XcdBarrier {
    unsigned* bar; unsigned x;
    volatile LAS unsigned* st;
};

__device__ __forceinline__ XcdBarrier xcd_barrier_post(int wid_s, unsigned* bar, volatile LAS unsigned* st) {
    XcdBarrier b; b.bar = bar; b.x = xb_xcc_id(); b.st = st;
    if (TIDX == 0) (void)xb_add(&bar[XB_XCNT(b.x)], 1u);
    return b;
}
__device__ __forceinline__ void xcd_barrier_complete(unsigned* bar, unsigned x, unsigned& nloc, unsigned& nx) {
    const unsigned G = gridDim.x * gridDim.y * gridDim.z;
    unsigned sum, cnt, mine, sp = 0u;
    for (;;) {
        sum = 0u; cnt = 0u; mine = 0u;
#pragma unroll
        for (unsigned j = 0; j < 16; ++j) { const unsigned c = xb_ld(&bar[XB_XCNT(j)]); sum += c; cnt += (c > 0u) ? 1u : 0u; mine = (j == x) ? c : mine; }
        if (sum == G) break;
        __builtin_amdgcn_s_sleep(1);
        if ((++sp & 255u) == 0u) { if (xb_ld(&bar[XB_TMO])) break; if (sp > XB_SPIN_CAP) { atomicAdd(&bar[XB_TMO], 1u); break; } }
    }
    nloc = mine > 0u ? mine : 1u; nx = cnt > 0u ? cnt : 1u;
}

__device__ __forceinline__ void xcd_barrier(int wid_s, const XcdBarrier& b) {
    asm volatile("s_waitcnt vmcnt(0)" ::: "memory");
    __syncthreads();
    if (TIDX == 0) {
        unsigned* bar = b.bar;
        __builtin_amdgcn_s_waitcnt(0);
        unsigned nloc = b.st[0], nx = b.st[1];
        if (nloc == 0u) { xcd_barrier_complete(bar, b.x, nloc, nx); b.st[0] = nloc; b.st[1] = nx; }
        const unsigned old = xb_add(&bar[XB_XSUB(b.x)], 1u);
        const unsigned gen = old / nloc;
        if (old + 1u == (gen + 1u) * nloc) {
            __builtin_amdgcn_fence(__ATOMIC_RELEASE, "agent");
            asm volatile("s_waitcnt vmcnt(0)" ::: "memory");
            const unsigned og = xb_add(&bar[XB_TOP], 1u);
            const unsigned tg = og / nx;
            if (og + 1u == (tg + 1u) * nx) xb_add(&bar[XB_TOPGEN], 1u);
            else XB_SPIN(xb_ld(&bar[XB_TOPGEN]) == tg, bar);
            __builtin_amdgcn_fence(__ATOMIC_ACQUIRE, "agent");
            xb_add(&bar[XB_XGEN(b.x)], 1u);
            asm volatile("s_waitcnt vmcnt(0)" ::: "memory");
        } else {
            XB_SPIN(xb_ld(&bar[XB_XGEN(b.x)]) == gen, bar);
            __builtin_amdgcn_fence(__ATOMIC_ACQUIRE, "agent");
            asm volatile("s_waitcnt vmcnt(0)" ::: "memory");
        }
    }
    __syncthreads();
}

__global__ void __launch_bounds__(512, 2) mega_fwd(Params p_unused) {
    extern __shared__ __attribute__((aligned(16))) unsigned char lds_raw[];
    LAS unsigned char* lds = (LAS unsigned char*)lds_raw;
    cg::grid_group grid = cg::this_grid();
    const int wid_s = __builtin_amdgcn_readfirstlane((int)(__builtin_amdgcn_workitem_id_x() >> 6));
    { LAS unsigned* z = (LAS unsigned*)(lds + 131072); if (TIDX < 128) z[TIDX] = 0u; }
    __syncthreads();
    XcdBarrier bar = xcd_barrier_post(wid_s, (unsigned*)(kargs().ws + WS_CTL) + 4096, (volatile LAS unsigned*)(lds + 131072 + 32));
#define SEAM() xcd_barrier(wid_s, bar)
#define WSP(off) (kargs().ws + (off))
#define XFP (kargs().out + O_Y)
    p0_prep<0>(wid_s, kargs(), lds);
    if (gridDim.x == 0x7fffffffu) grid.sync();
    SEAM();
    { pg8::EpiStore E{(bf16_t*)WSP(WS_REGA), NH0, -1, nullptr}; run_gemm(wid_s, lds, (const bf16_t*)WSP(WS_XB), (const bf16_t*)WSP(WS_WINE), MP, NH0, D, E);
      FinStore F{(bf16_t*)WSP(WS_REGA), NH0}; mini_gemm_tail<4>(wid_s, lds, (const bf16_t*)WSP(WS_XB), (const bf16_t*)WSP(WS_WINE), D, F); }
    { pg8::EpiStore E{(bf16_t*)WSP(WS_PB), D, -1, nullptr}; run_gemm(wid_s, lds, (const bf16_t*)WSP(WS_PLEB), (const bf16_t*)WSP(WS_WPLE), MP, D, 256, E);
      FinStore F{(bf16_t*)WSP(WS_PB), D}; mini_gemm_tail<2>(wid_s, lds, (const bf16_t*)WSP(WS_PLEB), (const bf16_t*)WSP(WS_WPLE), 256, F); }
    SEAM();
    for (int ti = blockIdx.x; ti < 256; ti += gridDim.x) even_mixer_tile(wid_s, kargs(), lds, ti);
    for (int tt = blockIdx.x; tt < 48; tt += gridDim.x) even_mixer_part(wid_s, kargs(), lds, 256 + (tt & 7), tt >> 3);
    p0_prep<1>(wid_s, kargs(), lds);
    { const CAS Params& p = kargs(); const size_t gtid = (size_t)blockIdx.x * 512 + TIDX, gstride = (size_t)gridDim.x * 512; bf16_t* PLEB = (bf16_t*)(p.ws + WS_PLEB);
      cvt_f32_bf16(p.in[I_PP] + (size_t)MP * 256, PLEB, (size_t)MP * 256 / 4, gtid, gstride);
      cvt_f32_bf16(p.in[I_PS] + (size_t)MSAMP * 256, PLEB + (size_t)MP * 256, (size_t)MSAMP * 256 / 4, gtid, gstride); }
    SEAM();
    { pg8::EpiRes3<1> E{nullptr, (const bf16_t*)WSP(WS_XB), (bf16_t*)WSP(WS_XB), ((float*)WSP(WS_STATS) + 0 * MT), ((float*)WSP(WS_STATS) + 1 * MT), nullptr, nullptr, nullptr, nullptr}; run_gemm(wid_s, lds, (const bf16_t*)WSP(WS_MIX), (const bf16_t*)WSP(WS_WOUTE), MP, D, D, E);
      FinRes F{1, nullptr, (const bf16_t*)WSP(WS_XB), (bf16_t*)WSP(WS_XB), ((float*)WSP(WS_STATS) + 0 * MT), ((float*)WSP(WS_STATS) + 1 * MT), nullptr, nullptr, nullptr, nullptr}; mini_gemm_tail<2>(wid_s, lds, (const bf16_t*)WSP(WS_MIX), (const bf16_t*)WSP(WS_WOUTE), D, F); }
    SEAM();
    { pg8::EpiSwiGLU2 E{(bf16_t*)WSP(WS_REGA), ((float*)WSP(WS_STATS) + 0 * MT), ((float*)WSP(WS_STATS) + 1 * MT), (const float*)WSP(WS_CS13), (const float*)WSP(WS_CB13)}; run_gemm(wid_s, lds, (const bf16_t*)WSP(WS_XB), (const bf16_t*)WSP(WS_W13), MT, 2 * FF, D, E); }
    SEAM();
    { pg8::EpiRes3<2> E{nullptr, (const bf16_t*)WSP(WS_XB), (bf16_t*)WSP(WS_XB), ((float*)WSP(WS_STATS) + 2 * MT), ((float*)WSP(WS_STATS) + 3 * MT), ((float*)WSP(WS_STATS) + 0 * MT), ((float*)WSP(WS_STATS) + 1 * MT), kargs().in[I_LN1G], kargs().in[I_LN1B]}; run_gemm(wid_s, lds, (const bf16_t*)WSP(WS_REGA), (const bf16_t*)WSP(WS_W2), MP, D, FF, E);
      FinRes F{2, nullptr, (const bf16_t*)WSP(WS_XB), (bf16_t*)WSP(WS_XB), ((float*)WSP(WS_STATS) + 2 * MT), ((float*)WSP(WS_STATS) + 3 * MT), ((float*)WSP(WS_STATS) + 0 * MT), ((float*)WSP(WS_STATS) + 1 * MT), kargs().in[I_LN1G], kargs().in[I_LN1B]}; mini_gemm_tail<2>(wid_s, lds, (const bf16_t*)WSP(WS_REGA), (const bf16_t*)WSP(WS_W2), FF, F); }
    SEAM();
    { pg8::EpiGate3<false> E{(const bf16_t*)WSP(WS_XB), (const bf16_t*)WSP(WS_PB), nullptr, (bf16_t*)WSP(WS_MIX), (bf16_t*)(kargs().out + O_Y), ((float*)WSP(WS_STATS) + 2 * MT), ((float*)WSP(WS_STATS) + 3 * MT), (const float*)WSP(WS_CSG), (const float*)WSP(WS_CBG), kargs().in[I_LN2G], kargs().in[I_LN2B]}; run_gemm(wid_s, lds, (const bf16_t*)WSP(WS_XB), (const bf16_t*)WSP(WS_WG), MP, D, D, E);
      FinGate F{false, E.xr, E.P, nullptr, E.ob1, E.ob2, E.ssum, E.ssq, E.cs, E.cb, E.g, E.b}; mini_gemm_tail<2>(wid_s, lds, (const bf16_t*)WSP(WS_XB), (const bf16_t*)WSP(WS_WG), D, F); }
    SEAM();
    { pg8::EpiStore E{(bf16_t*)WSP(WS_REGA), NH1, 10, (float*)WSP(WS_DT)}; run_gemm(wid_s, lds, (const bf16_t*)WSP(WS_MIX), (const bf16_t*)WSP(WS_WINO), MT, NINO, D, E); }
    SEAM();
    if (gridDim.x == 256) {
        const int b = blockIdx.x;
        if (b < 136) { sgu_block(wid_s, kargs(), lds, b); ssd_stepA(wid_s, kargs(), lds, b); }
        else { for (int t = b; t < 528; t += 120) ssd_stepA(wid_s, kargs(), lds, t); if (b >= 240) ssd_stepC(wid_s, kargs(), lds, 512 + (b - 240)); }
    } else {
        for (int t = blockIdx.x; t < 136 + 528 + 16; t += gridDim.x) { if (t < 136) sgu_block(wid_s, kargs(), lds, t); else if (t < 664) ssd_stepA(wid_s, kargs(), lds, t - 136); else ssd_stepC(wid_s, kargs(), lds, 512 + (t - 664)); }
    }
    SEAM();
    ssd_stepB(wid_s, kargs());
    SEAM();
    for (int t = blockIdx.x; t < 512; t += gridDim.x) ssd_stepC(wid_s, kargs(), lds, t);
    SEAM();
    { pg8::EpiRes3<1> E{nullptr, (const bf16_t*)(kargs().out + O_Y), (bf16_t*)WSP(WS_XB), ((float*)WSP(WS_STATS) + 4 * MT), ((float*)WSP(WS_STATS) + 5 * MT), nullptr, nullptr, nullptr, nullptr}; run_gemm(wid_s, lds, (const bf16_t*)WSP(WS_MIX), (const bf16_t*)WSP(WS_WOUTO), MP, D, D, E);
      FinRes F{1, nullptr, (const bf16_t*)(kargs().out + O_Y), (bf16_t*)WSP(WS_XB), ((float*)WSP(WS_STATS) + 4 * MT), ((float*)WSP(WS_STATS) + 5 * MT), nullptr, nullptr, nullptr, nullptr}; mini_gemm_tail<2>(wid_s, lds, (const bf16_t*)WSP(WS_MIX), (const bf16_t*)WSP(WS_WOUTO), D, F); }
    { pg8::EpiStore E{(bf16_t*)WSP(WS_PB), D, -1, nullptr}; run_gemm(wid_s, lds, (const bf16_t*)WSP(WS_PLEB), (const bf16_t*)WSP(WS_WPLE + WPLE_BYTES), MP, D, 256, E);
      FinStore F{(bf16_t*)WSP(WS_PB), D}; mini_gemm_tail<2>(wid_s, lds, (const bf16_t*)WSP(WS_PLEB), (const bf16_t*)WSP(WS_WPLE + WPLE_BYTES), 256, F); }
    SEAM();
    { pg8::EpiSwiGLU2 E{(bf16_t*)WSP(WS_REGA), ((float*)WSP(WS_STATS) + 4 * MT), ((float*)WSP(WS_STATS) + 5 * MT), (const float*)WSP(WS_CS13) + 5632, (const float*)WSP(WS_CB13) + 5632}; run_gemm(wid_s, lds, (const bf16_t*)WSP(WS_XB), (const bf16_t*)WSP(WS_W13 + W13_BYTES), MT, 2 * FF, D, E); }
    SEAM();
    { pg8::EpiRes3<2> E{nullptr, (const bf16_t*)WSP(WS_XB), (bf16_t*)WSP(WS_XB), ((float*)WSP(WS_STATS) + 6 * MT), ((float*)WSP(WS_STATS) + 7 * MT), ((float*)WSP(WS_STATS) + 4 * MT), ((float*)WSP(WS_STATS) + 5 * MT), kargs().in[I_LN1G] + D, kargs().in[I_LN1B] + D}; run_gemm(wid_s, lds, (const bf16_t*)WSP(WS_REGA), (const bf16_t*)WSP(WS_W2 + W2_BYTES), MP, D, FF, E);
      FinRes F{2, nullptr, (const bf16_t*)WSP(WS_XB), (bf16_t*)WSP(WS_XB), ((float*)WSP(WS_STATS) + 6 * MT), ((float*)WSP(WS_STATS) + 7 * MT), ((float*)WSP(WS_STATS) + 4 * MT), ((float*)WSP(WS_STATS) + 5 * MT), kargs().in[I_LN1G] + D, kargs().in[I_LN1B] + D}; mini_gemm_tail<2>(wid_s, lds, (const bf16_t*)WSP(WS_REGA), (const bf16_t*)WSP(WS_W2 + W2_BYTES), FF, F); }
    SEAM();
    { pg8::EpiGate3<true> E{(const bf16_t*)WSP(WS_XB), (const bf16_t*)WSP(WS_PB), XFP, nullptr, nullptr, ((float*)WSP(WS_STATS) + 6 * MT), ((float*)WSP(WS_STATS) + 7 * MT), (const float*)WSP(WS_CSG) + D, (const float*)WSP(WS_CBG) + D, kargs().in[I_LN2G] + D, kargs().in[I_LN2B] + D}; run_gemm(wid_s, lds, (const bf16_t*)WSP(WS_XB), (const bf16_t*)WSP(WS_WG + WG_BYTES), MP, D, D, E);
      FinGate F{true, E.xr, E.P, E.outf, nullptr, nullptr, E.ssum, E.ssq, E.cs, E.cb, E.g, E.b}; mini_gemm_tail<2>(wid_s, lds, (const bf16_t*)WSP(WS_XB), (const bf16_t*)WSP(WS_WG + WG_BYTES), D, F); }
}

extern "C" void kernel_launch(void* const* d_in, const int* in_sizes, int n_in, void* d_out, int out_size, void* d_ws, size_t ws_size, hipStream_t stream) {
    static int grid = 0;
    if (grid == 0) {
        if (n_in != 34 || ws_size < WS_END2) { fprintf(stderr, "kernel_launch: unexpected n_in %d or ws_size %zu (need %zu)\n", n_in, ws_size, (size_t)WS_END2); grid = -1; return; }
        int dev = 0, cus = 0, per_cu = 0;
        hipGetDevice(&dev); hipDeviceGetAttribute(&cus, hipDeviceAttributeMultiprocessorCount, dev);
        hipFuncSetAttribute((const void*)mega_fwd, hipFuncAttributeMaxDynamicSharedMemorySize, LDS_BYTES);
        hipOccupancyMaxActiveBlocksPerMultiprocessor(&per_cu, (const void*)mega_fwd, 512, LDS_BYTES);
        (void)hipGetLastError();
        if (per_cu < 1) per_cu = 1;
        grid = cus;
        fprintf(stderr, "kernel_launch: cus %d per_cu %d grid %d\n", cus, per_cu, grid);
    }
    if (grid < 0) return;
    if (hipMemsetAsync((char*)d_ws + WS_CTL, 0, WS_STATS, stream) != hipSuccess) { fprintf(stderr, "memset failed\n"); return; }
    Params prm{};
    for (int i = 0; i < 34; ++i) prm.in[i] = (const float*)d_in[i];
    prm.out = (float*)d_out; prm.ws = (unsigned char*)d_ws;
    void* args[] = {&prm};
    hipError_t e = hipLaunchCooperativeKernel((const void*)mega_fwd, dim3(grid), dim3(512), args, LDS_BYTES, stream);
    if (e != hipSuccess) fprintf(stderr, "cooperative launch failed: %s (grid %d)\n", hipGetErrorString(e), grid);
}
```

```cpp
#include <hip/hip_runtime.h>
#include <hip/hip_cooperative_groups.h>
#include <cstdio>
#include <cstdint>
namespace cg = cooperative_groups;
namespace pg8 {
#define PG8_LAS __attribute__((address_space(3)))
typedef unsigned short bf16_t;
typedef short bf16x8 __attribute__((ext_vector_type(8)));
typedef float f32x4 __attribute__((ext_vector_type(4)));
typedef unsigned u32x4 __attribute__((ext_vector_type(4)));
constexpr int BM = 256, BK = 64, HALF = 128, HTB = HALF * BK * 2  , STAGE_BYTES = 8 * HTB, NXCD = 8, WGM = 8;

__host__ __device__ __forceinline__ int lds_byte(int r, int c) { const int st = (r >> 4) * 2 + (c >> 5), rr = r & 15, cc = c & 31, ob = rr * 64 + cc * 2; return st * 1024 + (ob ^ (((ob >> 9) & 1) << 5)); }
__host__ __device__ __forceinline__ void stage_rc(int b, int& R, int& C) { const int st = b / 1024, sb = b % 1024, swz = sb ^ (((sb >> 9) & 1) << 5); R = (st >> 1) * 16 + swz / 64; C = (st & 1) * 32 + (swz % 64) / 2; }
__host__ __device__ __forceinline__ int perm32(int rho) { const int n = rho >> 4, i = rho & 15; return 8 * (i >> 2) + 4 * n + (i & 3); }

struct Unit { int pm, pn, ko; };
struct Gemm { const bf16_t* A; const bf16_t* Bt; int M, N, K, KL; };

struct StaticOrder {
    int nM, nN, nwg, G, c;
    __host__ __device__ void init(int M, int N, int G_, int c_) { nM = M / BM; nN = N / BM; nwg = nM * nN; G = G_; c = c_; }
    __host__ __device__ bool next(int i, Unit& u) const {
        const long L = (long)i * G + c; if (L >= nwg) return false;
        int wgid = (int)L; { const int q = nwg / NXCD, r = nwg % NXCD, xcd = wgid % NXCD, off = wgid / NXCD; wgid = (xcd < r ? xcd * (q + 1) : r * (q + 1) + (xcd - r) * q) + off; }
        const int nig = WGM * nN, gid = wgid / nig, fm = gid * WGM, gsz = (nM - fm) < WGM ? (nM - fm) : WGM;
        u.pm = fm + ((wgid % nig) % gsz); u.pn = (wgid % nig) / gsz; u.ko = 0; return true;
    }
    __device__ __forceinline__ void a_ready(const Unit&) const {}
    __device__ __forceinline__ void done(const Unit&) const {}
};
__device__ __forceinline__ unsigned cvt_pk_bf16(float lo, float hi) { unsigned r; asm volatile("v_cvt_pk_bf16_f32 %0, %1, %2" : "=v"(r) : "v"(lo), "v"(hi)); return r; }
template <class Epi, class Sched, bool ALIGN_EPI = false, bool SP2 = false>
__device__ __forceinline__ void gemm_phase(int wid_s, PG8_LAS unsigned char* lds, const Gemm g, const Sched& S, const Epi& E) {
    int lane_ = (int)__builtin_amdgcn_mbcnt_hi(~0u, __builtin_amdgcn_mbcnt_lo(~0u, 0u)); asm volatile("" : "+v"(lane_)); const int wid = wid_s, lane = lane_, tid = wid * 64 + lane, wr = wid >> 2, wc = wid & 3, fr = lane & 15, fq = lane >> 4;
    const int K = g.K, nt = g.KL / BK;
    unsigned voffA[2], voffB[2];
#pragma unroll
    for (int i = 0; i < 2; ++i) { int R, C; stage_rc(tid * 16 + i * 8192, R, C); const int Rb = Epi::PERM ? ((R & ~31) + perm32(R & 31)) : R;
        voffA[i] = (unsigned)(R * K + C) * 2u; voffB[i] = (unsigned)(Rb * K + C) * 2u; }
    const size_t kstep = (size_t)(BK * 2);
    const size_t hstep = (size_t)HALF * K * 2;
    const size_t tstep = 2 * hstep;
    const unsigned ldsw = (unsigned)wid * 1024u;
    const int aoff = lds_byte(wr * 64 + fr, fq * 8), boff = lds_byte(wc * 32 + fr, fq * 8);
#define PG8_SA(b, h) (((b) * 2 + (h)) * HTB)
#define PG8_SB(b, h) ((4 + (b) * 2 + (h)) * HTB)
#define PG8_STAGE(bufoff, gbase, voff) do { _Pragma("unroll") for (int _i = 0; _i < 2; ++_i) \
        __builtin_amdgcn_global_load_lds((const unsigned*)((const char*)(gbase) + (voff)[_i]), (PG8_LAS unsigned*)(lds + (bufoff) + ldsw + _i * 8192), 16, 0, 0); } while (0)
#define PG8_LDA(dst, b, h) do { _Pragma("unroll") for (int m = 0; m < 4; ++m) _Pragma("unroll") for (int k = 0; k < 2; ++k) dst[m][k] = *(const PG8_LAS bf16x8*)(lds + PG8_SA(b, h) + aoff + m * 2048 + k * 1024); } while (0)
#define PG8_LDB(dst, b, h) do { _Pragma("unroll") for (int n = 0; n < 2; ++n) _Pragma("unroll") for (int k = 0; k < 2; ++k) dst[n][k] = *(const PG8_LAS bf16x8*)(lds + PG8_SB(b, h) + boff + n * 2048 + k * 1024); } while (0)
#define PG8_MMA(ai, bj, At, Bt) do { __builtin_amdgcn_s_setprio(1); _Pragma("unroll") for (int m = 0; m < 4; ++m) _Pragma("unroll") for (int n = 0; n < 2; ++n) _Pragma("unroll") for (int k = 0; k < 2; ++k) \
        acc[ai][bj][m][n] = __builtin_amdgcn_mfma_f32_16x16x32_bf16(Bt[n][k], At[m][k], acc[ai][bj][m][n], 0, 0, 0); __builtin_amdgcn_s_setprio(0); } while (0)
#define PG8_WAIT_V(n) asm volatile("s_waitcnt vmcnt(" #n ")" ::: "memory")
#define PG8_WAIT_L(n) asm volatile("s_waitcnt lgkmcnt(" #n ")" ::: "memory")
#define PG8_BAR __builtin_amdgcn_s_barrier()
#define PG8_SCHED __builtin_amdgcn_sched_barrier(0)
    Unit cur, nxt; int ui = 0;
    if (!S.next(0, cur)) return;
    f32x4 acc[2][2][4][2];
#pragma unroll
    for (int a = 0; a < 2; ++a)
#pragma unroll
        for (int b = 0; b < 2; ++b)
#pragma unroll
            for (int m = 0; m < 4; ++m)
#pragma unroll
                for (int n = 0; n < 2; ++n) acc[a][b][m][n] = (f32x4){0.f, 0.f, 0.f, 0.f};
    bf16x8 At[4][2], B0[2][2], B1[2][2];
    const char* cA = (const char*)g.A + (size_t)cur.pm * tstep + (size_t)cur.ko * 2; const char* cB = (const char*)g.Bt + (size_t)cur.pn * tstep + (size_t)cur.ko * 2;
    S.a_ready(cur);
    if constexpr (SP2) {
        PG8_STAGE(PG8_SB(0, 0), cB, voffB); PG8_STAGE(PG8_SB(0, 1), cB + hstep, voffB); PG8_STAGE(PG8_SA(0, 0), cA, voffA); PG8_STAGE(PG8_SA(0, 1), cA + hstep, voffA);
        if (wr == 1) PG8_BAR;
        PG8_WAIT_V(2); PG8_BAR;
        PG8_STAGE(PG8_SB(1, 0), cB + kstep, voffB); PG8_STAGE(PG8_SA(1, 0), cA + kstep, voffA); PG8_STAGE(PG8_SB(1, 1), cB + hstep + kstep, voffB);
        PG8_WAIT_V(6); PG8_BAR;
    } else {
        PG8_STAGE(PG8_SB(0, 0), cB, voffB); PG8_STAGE(PG8_SA(0, 0), cA, voffA); PG8_STAGE(PG8_SB(0, 1), cB + hstep, voffB); PG8_STAGE(PG8_SA(0, 1), cA + hstep, voffA);
        if (wr == 1) PG8_BAR;
        PG8_WAIT_V(4); PG8_BAR;
        PG8_STAGE(PG8_SB(1, 0), cB + kstep, voffB); PG8_STAGE(PG8_SA(1, 0), cA + kstep, voffA); PG8_STAGE(PG8_SB(1, 1), cB + hstep + kstep, voffB);
        PG8_WAIT_V(6); PG8_BAR;
    }
    for (;;) {
        const bool has_next = S.next(ui + 1, nxt);
        const char* nA = has_next ? (const char*)g.A + (size_t)nxt.pm * tstep + (size_t)nxt.ko * 2 : cA; const char* nB = has_next ? (const char*)g.Bt + (size_t)nxt.pn * tstep + (size_t)nxt.ko * 2 : cB;
        for (int t = 0; t < nt; t += 2) {
            const bool last = (t == nt - 2);
            const char* a1 = cA + (size_t)(t + 1) * kstep;
            const char* a2 = last ? nA : cA + (size_t)(t + 2) * kstep; const char* b2 = last ? nB : cB + (size_t)(t + 2) * kstep;
            const char* a3 = a2 + kstep; const char* b3 = b2 + kstep;
            if (last && has_next) S.a_ready(nxt);
            if constexpr (SP2) {
            PG8_LDB(B0, 0, 0); PG8_LDB(B1, 0, 1); PG8_SCHED; PG8_LDA(At, 0, 0); PG8_STAGE(PG8_SA(1, 1), a1 + hstep, voffA);
            PG8_WAIT_V(8); PG8_WAIT_L(0); PG8_BAR; PG8_MMA(0, 0, At, B0); PG8_MMA(0, 1, At, B1); PG8_BAR; PG8_SCHED;
            PG8_LDA(At, 0, 1); PG8_STAGE(PG8_SB(0, 0), b2, voffB); PG8_STAGE(PG8_SB(0, 1), b2 + hstep, voffB); PG8_STAGE(PG8_SA(0, 0), a2, voffA);
            PG8_WAIT_V(8); PG8_WAIT_L(0); PG8_BAR; PG8_MMA(1, 0, At, B0); PG8_MMA(1, 1, At, B1); PG8_BAR; PG8_SCHED;
            PG8_LDB(B0, 1, 0); PG8_LDB(B1, 1, 1); PG8_SCHED; PG8_LDA(At, 1, 0); PG8_STAGE(PG8_SA(0, 1), a2 + hstep, voffA);
            PG8_WAIT_V(8); PG8_WAIT_L(0); PG8_BAR; PG8_MMA(0, 0, At, B0); PG8_MMA(0, 1, At, B1); PG8_BAR; PG8_SCHED;
            PG8_LDA(At, 1, 1); PG8_STAGE(PG8_SB(1, 0), b3, voffB); PG8_STAGE(PG8_SB(1, 1), b3 + hstep, voffB); PG8_STAGE(PG8_SA(1, 0), a3, voffA);
            PG8_WAIT_V(8); PG8_WAIT_L(0); PG8_BAR; PG8_MMA(1, 0, At, B0); PG8_MMA(1, 1, At, B1); PG8_BAR; PG8_SCHED;
            } else {
            PG8_LDB(B0, 0, 0); PG8_SCHED; PG8_LDA(At, 0, 0); PG8_STAGE(PG8_SA(1, 1), a1 + hstep, voffA);
            PG8_WAIT_L(8); PG8_BAR; PG8_WAIT_L(0); PG8_MMA(0, 0, At, B0); PG8_BAR; PG8_SCHED;
            PG8_LDB(B1, 0, 1); PG8_STAGE(PG8_SB(0, 0), b2, voffB);
            PG8_BAR; PG8_WAIT_L(0); PG8_MMA(0, 1, At, B1); PG8_BAR;
            PG8_LDA(At, 0, 1); PG8_STAGE(PG8_SA(0, 0), a2, voffA);
            PG8_BAR; PG8_WAIT_L(0); PG8_MMA(1, 0, At, B0); PG8_BAR; PG8_SCHED;
            PG8_STAGE(PG8_SB(0, 1), b2 + hstep, voffB);
            PG8_WAIT_V(6); PG8_BAR; PG8_MMA(1, 1, At, B1); PG8_BAR;
            PG8_LDB(B0, 1, 0); PG8_SCHED; PG8_LDA(At, 1, 0); PG8_STAGE(PG8_SA(0, 1), a2 + hstep, voffA);
            PG8_WAIT_L(8); PG8_BAR; PG8_WAIT_L(0); PG8_MMA(0, 0, At, B0); PG8_BAR; PG8_SCHED;
            PG8_LDB(B1, 1, 1); PG8_STAGE(PG8_SB(1, 0), b3, voffB);
            PG8_BAR; PG8_WAIT_L(0); PG8_MMA(0, 1, At, B1); PG8_BAR;
            PG8_LDA(At, 1, 1); PG8_STAGE(PG8_SA(1, 0), a3, voffA);
            PG8_BAR; PG8_WAIT_L(0); PG8_MMA(1, 0, At, B0); PG8_BAR; PG8_SCHED;
            PG8_STAGE(PG8_SB(1, 1), b3 + hstep, voffB);
            PG8_WAIT_V(6); PG8_BAR; PG8_MMA(1, 1, At, B1); PG8_BAR;
            }
        }
        if constexpr (ALIGN_EPI) { if (wr == 0) PG8_BAR; }
        if constexpr (!Epi::AFTER_DRAIN) { E(acc, cur, wr, wc, fr, fq); S.done(cur); }
        if (!has_next) break;
#pragma unroll
        for (int a = 0; a < 2; ++a)
#pragma unroll
            for (int b = 0; b < 2; ++b)
#pragma unroll
                for (int m = 0; m < 4; ++m)
#pragma unroll
                    for (int n = 0; n < 2; ++n) acc[a][b][m][n] = (f32x4){0.f, 0.f, 0.f, 0.f};
        cur = nxt; cA = nA; cB = nB; ++ui;
        if constexpr (ALIGN_EPI) { if (wr == 1) PG8_BAR; }
    }
    PG8_WAIT_V(0);
    if constexpr (!ALIGN_EPI) { if (wr == 0) PG8_BAR; }
    PG8_BAR;
    if constexpr (Epi::AFTER_DRAIN) { E.fused(acc, cur, wr, wc, fr, fq, lds, wid, lane); S.done(cur); }
#undef PG8_SA
#undef PG8_SB
#undef PG8_STAGE
#undef PG8_LDA
#undef PG8_LDB
#undef PG8_MMA
#undef PG8_WAIT_V
#undef PG8_WAIT_L
#undef PG8_BAR
#undef PG8_SCHED
}
}

#define LAS __attribute__((address_space(3)))
typedef unsigned short bf16_t;
typedef short bf16x8 __attribute__((ext_vector_type(8)));
typedef float f32x4 __attribute__((ext_vector_type(4)));
typedef unsigned u32x4 __attribute__((ext_vector_type(4)));
typedef unsigned u32x2 __attribute__((ext_vector_type(2)));

constexpr int D = 1024, MP = 16384, MSAMP = 256, MT = MP + MSAMP, SEQ = 8192, FF = 2816;
constexpr int NH0 = 2048, NH1 = 2560, NINO = 2816;
constexpr float ALPHA = 1.41421356237f, LN_EPS = 1e-5f;
constexpr size_t MiB = 1u << 20;
constexpr size_t WS_CTL = 0, CTL_BYTES = 1 * MiB;
constexpr size_t WS_CS13 = 64 * 1024, WS_CB13 = 112 * 1024, WS_CSG = 160 * 1024, WS_CBG = 168 * 1024, WS_STATS = 256 * 1024;
static_assert(WS_STATS + 4 * 2 * 16640 * 4 <= CTL_BYTES, "ctl map");
constexpr size_t WS_WINE = 1 * MiB, WS_WOUTE = 5 * MiB, WS_WINO = 7 * MiB, WS_WOUTO = 12 * MiB + MiB / 2;
constexpr size_t WS_W13 = 14 * MiB + MiB / 2, W13_BYTES = 11 * MiB;
constexpr size_t WS_W2 = 36 * MiB + MiB / 2, W2_BYTES = 5 * MiB + MiB / 2;
constexpr size_t WS_WG = 47 * MiB + MiB / 2, WG_BYTES = 2 * MiB;
constexpr size_t WS_WPLE = 51 * MiB + MiB / 2, WPLE_BYTES = MiB / 2;
constexpr size_t WS_WPOOL = 52 * MiB + MiB / 2, WS_WSGU = WS_WPOOL + 131072;
constexpr size_t WS_PLEB = 53 * MiB;
constexpr size_t WS_XB = 61 * MiB + MiB / 4, ACT_BYTES = (size_t)MT * D * 2;
constexpr size_t WS_PB = WS_XB + ACT_BYTES, WS_MIX = WS_PB + ACT_BYTES, WS_REGA = WS_MIX + ACT_BYTES;
constexpr size_t WS_DT = WS_REGA + 82 * MiB, WS_SSAMP = WS_REGA + 83 * MiB, WS_DEC = WS_REGA + 86 * MiB;
constexpr size_t WS_END = WS_REGA + (size_t)MT * FF * 2, WS_SLAB4 = WS_END, WS_END2 = WS_END + 4 * MiB;
static_assert(WS_END2 <= 256 * MiB, "ws map");
static_assert(WS_DEC + 264 * 8 * 4 <= WS_END, "ws map tail");
constexpr size_t O_Y = 0, O_POOLP = 17039360, O_POOLS = 17054720, O_CONVP = 17116160, O_CONVS = 17118208, O_SGUV = 17126400,
                 O_SCP = 17257472, O_SCS = 17263616, O_SSMP = 17288192, O_SSMS = 17419264;
constexpr int LDS_BYTES = 147456;

struct Params { const float* in[34]; float* out; unsigned char* ws; };
#define CAS __attribute__((address_space(4)))
#if defined(__HIP_DEVICE_COMPILE__)
__device__ __forceinline__ const CAS Params& kargs() { const CAS Params* k = (const CAS Params*)__builtin_amdgcn_kernarg_segment_ptr(); asm volatile("" : "+s"(k)); return *k; }
#else
__device__ const CAS Params& kargs();
#endif
enum { I_XP = 0, I_XS, I_PP, I_PS, I_STPOOL, I_STCONV, I_STSSMCONV, I_STSSM, I_WINE, I_POOLW, I_POOLSC, I_CONVW, I_WOUTE, I_WINO, I_SGUW, I_SGUB, I_SGULNG, I_SGULNB,
       I_SSMCW, I_SSMCB, I_DTB, I_ALOG, I_SSMD, I_SSMNW, I_WOUTO, I_LN1G, I_LN1B, I_LN2G, I_LN2B, I_FF1, I_FF3, I_FF2, I_WPLE, I_WGATE };

__device__ __forceinline__ float bf2f(unsigned b) { return __uint_as_float(b << 16); }
__device__ __forceinline__ unsigned f2bf(float f) { unsigned u = __float_as_uint(f); return (u + 0x7fffu + ((u >> 16) & 1u)) >> 16; }
__device__ __forceinline__ unsigned pk2(float lo, float hi) { return f2bf(lo) | (f2bf(hi) << 16); }
__device__ __forceinline__ void unpack8(const u32x4 w, float (&v)[8]) {
    v[0] = bf2f(w.x & 0xffffu); v[1] = __uint_as_float(w.x & 0xffff0000u); v[2] = bf2f(w.y & 0xffffu); v[3] = __uint_as_float(w.y & 0xffff0000u);
    v[4] = bf2f(w.z & 0xffffu); v[5] = __uint_as_float(w.z & 0xffff0000u); v[6] = bf2f(w.w & 0xffffu); v[7] = __uint_as_float(w.w & 0xffff0000u); }
__device__ __forceinline__ u32x4 pack8(const float (&v)[8]) { u32x4 w; w.x = pk2(v[0], v[1]); w.y = pk2(v[2], v[3]); w.z = pk2(v[4], v[5]); w.w = pk2(v[6], v[7]); return w; }
__device__ __forceinline__ void load8bf(const bf16_t* p, float (&v)[8]) { unpack8(*(const u32x4*)p, v); }
__device__ __forceinline__ void load8f(const float* p, float (&v)[8]) { const f32x4 a = *(const f32x4*)p, b = *(const f32x4*)(p + 4); v[0] = a.x; v[1] = a.y; v[2] = a.z; v[3] = a.w; v[4] = b.x; v[5] = b.y; v[6] = b.z; v[7] = b.w; }
__device__ __forceinline__ float sigmoidf_(float x) { return __builtin_amdgcn_rcpf(1.0f + __expf(-x)); }
__device__ __forceinline__ float siluf_(float x) { return x * sigmoidf_(x); }
__device__ __forceinline__ float geluf_(float x) { const float y = 0.7978845608f * (x + 0.044715f * x * x * x); return x * sigmoidf_(2.0f * y); }
__device__ __forceinline__ float softplusf_(float x) { return x > 20.f ? x : log1pf(__expf(x)); }
__device__ __forceinline__ float wave_sum(float v) {
#pragma unroll
    for (int o = 1; o < 64; o <<= 1) v += __shfl_xor(v, o);
    return v; }
__device__ __forceinline__ f32x4 mfma16(bf16x8 a, bf16x8 b, f32x4 c) { return __builtin_amdgcn_mfma_f32_16x16x32_bf16(a, b, c, 0, 0, 0); }
#define LDS_WAIT() asm volatile("s_waitcnt lgkmcnt(0)" ::: "memory")
__device__ __forceinline__ int swz(int row, int col) { return col ^ (((row >> 3) & 7) << 3); }
__device__ __forceinline__ int lane_id_() { int l = (int)__builtin_amdgcn_mbcnt_hi(~0u, __builtin_amdgcn_mbcnt_lo(~0u, 0u)); asm volatile("" : "+v"(l)); return l; }
#define TIDX (wid_s * 64 + lane_id_())

namespace pg8 {
struct EpiStore { static constexpr bool PERM = true, AFTER_DRAIN = false;
    bf16_t* O; int ldc; int dt_pn; float* DT;
    __device__ __forceinline__ void operator()(const f32x4 (&acc)[2][2][4][2], const Unit& u, int wr, int wc, int fr_, int fq_) const {
        int fr = fr_, fq = fq_; asm volatile("" : "+v"(fr), "+v"(fq));
        const int row0 = u.pm * BM + wr * 64 + fr;
        if (u.pn == dt_pn) {
            if (wc == 0 && fq == 0) {
#pragma unroll
                for (int ai = 0; ai < 2; ++ai)
#pragma unroll
                    for (int m = 0; m < 4; ++m) { float* d = DT + (size_t)(row0 + ai * HALF + m * 16) * 8; *(f32x4*)d = acc[ai][0][m][0]; *(f32x4*)(d + 4) = acc[ai][0][m][1]; }
            }
            return;
        }
        const int col0 = u.pn * BM + wc * 32 + 8 * fq;
#pragma unroll
        for (int ai = 0; ai < 2; ++ai)
#pragma unroll
            for (int m = 0; m < 4; ++m) { bf16_t* rowp = O + (size_t)(row0 + ai * HALF + m * 16) * ldc + col0;
#pragma unroll
                for (int bj = 0; bj < 2; ++bj) { const f32x4 v0 = acc[ai][bj][m][0], v1 = acc[ai][bj][m][1];
                    u32x4 w; w.x = cvt_pk_bf16(v0[0], v0[1]); w.y = cvt_pk_bf16(v0[2], v0[3]); w.z = cvt_pk_bf16(v1[0], v1[1]); w.w = cvt_pk_bf16(v1[2], v1[3]);
                    *(u32x4*)(rowp + bj * HALF) = w; } }
    }
};
struct EpiRes { static constexpr bool PERM = false, AFTER_DRAIN = false;
    const float* base; const float* base_s; float* out;
    __device__ __forceinline__ void operator()(const f32x4 (&acc)[2][2][4][2], const Unit& u, int wr, int wc, int fr_, int fq_) const {
        int fr = fr_, fq = fq_; asm volatile("" : "+v"(fr), "+v"(fq));
        const int row0 = u.pm * BM + wr * 64 + fr, col0 = u.pn * BM + wc * 32 + 4 * fq;
#pragma unroll
        for (int ai = 0; ai < 2; ++ai)
#pragma unroll
            for (int m = 0; m < 4; ++m) { const int r = row0 + ai * HALF + m * 16;
                const float* bp = (base_s != nullptr && r >= MP) ? base_s + (size_t)(r - MP) * D : base + (size_t)r * D; float* op = out + (size_t)r * D;
#pragma unroll
                for (int bj = 0; bj < 2; ++bj)
#pragma unroll
                    for (int n = 0; n < 2; ++n) { const int c = col0 + bj * HALF + n * 16; const f32x4 x = *(const f32x4*)(bp + c); *(f32x4*)(op + c) = x * ALPHA + acc[ai][bj][m][n]; }
                asm volatile("" ::: "memory"); }
    }
};
struct EpiSwiGLU { static constexpr bool PERM = true, AFTER_DRAIN = false;
    bf16_t* HF;
    __device__ __forceinline__ void operator()(const f32x4 (&acc)[2][2][4][2], const Unit& u, int wr, int wc, int fr_, int fq_) const {
        int fr = fr_, fq = fq_; asm volatile("" : "+v"(fr), "+v"(fq));
        const int row0 = u.pm * BM + wr * 64 + fr, col0 = u.pn * HALF + wc * 32 + 8 * fq;
#pragma unroll
        for (int ai = 0; ai < 2; ++ai)
#pragma unroll
            for (int m = 0; m < 4; ++m) { bf16_t* rowp = HF + (size_t)(row0 + ai * HALF + m * 16) * FF + col0;
                f32x4 h0, h1;
#pragma unroll
                for (int j = 0; j < 4; ++j) { h0[j] = siluf_(acc[ai][0][m][0][j]) * acc[ai][1][m][0][j]; h1[j] = siluf_(acc[ai][0][m][1][j]) * acc[ai][1][m][1][j]; }
                u32x4 w; w.x = cvt_pk_bf16(h0[0], h0[1]); w.y = cvt_pk_bf16(h0[2], h0[3]); w.z = cvt_pk_bf16(h1[0], h1[1]); w.w = cvt_pk_bf16(h1[2], h1[3]);
                *(u32x4*)rowp = w; asm volatile("" ::: "memory"); }
    }
};
struct EpiGate { static constexpr bool PERM = false, AFTER_DRAIN = false;
    const float* xf; const bf16_t* P; float* out; bf16_t* xb2;
    __device__ __forceinline__ void operator()(const f32x4 (&acc)[2][2][4][2], const Unit& u, int wr, int wc, int fr_, int fq_) const {
        int fr = fr_, fq = fq_; asm volatile("" : "+v"(fr), "+v"(fq));
        const int row0 = u.pm * BM + wr * 64 + fr, col0 = u.pn * BM + wc * 32 + 4 * fq;
#pragma unroll
        for (int ai = 0; ai < 2; ++ai)
#pragma unroll
            for (int m = 0; m < 4; ++m) { const size_t ro = (size_t)(row0 + ai * HALF + m * 16) * D;
#pragma unroll
                for (int bj = 0; bj < 2; ++bj)
#pragma unroll
                    for (int n = 0; n < 2; ++n) { const size_t o = ro + col0 + bj * HALF + n * 16; const f32x4 x = *(const f32x4*)(xf + o); const u32x2 pw = *(const u32x2*)(P + o);
                        const f32x4 a = acc[ai][bj][m][n]; f32x4 r;
                        r[0] = x[0] + bf2f(pw.x & 0xffffu) * sigmoidf_(a[0]); r[1] = x[1] + __uint_as_float(pw.x & 0xffff0000u) * sigmoidf_(a[1]);
                        r[2] = x[2] + bf2f(pw.y & 0xffffu) * sigmoidf_(a[2]); r[3] = x[3] + __uint_as_float(pw.y & 0xffff0000u) * sigmoidf_(a[3]);
                        *(f32x4*)(out + o) = r;
                        if (xb2) { u32x2 w; w.x = cvt_pk_bf16(r[0], r[1]); w.y = cvt_pk_bf16(r[2], r[3]); *(u32x2*)(xb2 + o) = w; } }
                asm volatile("" ::: "memory"); }
    }
};

__device__ __forceinline__ void row_stats(const float* ssum, const float* ssq, int r, float& mean, float& rstd) {
    const float s = ssum[r], q = ssq[r]; mean = s * (1.f / D); const float var = fmaxf(q * (1.f / D) - mean * mean, 0.f); rstd = __builtin_amdgcn_rsqf(var + LN_EPS); }
template <int BASE> struct EpiRes3 { static constexpr bool PERM = false, AFTER_DRAIN = false;
    const float* basef; const bf16_t* baseb; bf16_t* xb; float* ssum; float* ssq; const float* pss; const float* psq; const float* g; const float* b;
    __device__ __forceinline__ void operator()(const f32x4 (&acc)[2][2][4][2], const Unit& u, int wr, int wc, int fr_, int fq_) const {
        int fr = fr_, fq = fq_; asm volatile("" : "+v"(fr), "+v"(fq));
        const int row0 = u.pm * BM + wr * 64 + fr, col0 = u.pn * BM + wc * 32 + 4 * fq;
        float mean[8], rstd[8], s1[8], s2[8];
#pragma unroll
        for (int i = 0; i < 8; ++i) { mean[i] = 0.f; rstd[i] = 1.f; s1[i] = 0.f; s2[i] = 0.f; if (BASE == 2) row_stats(pss, psq, row0 + (i >> 2) * HALF + (i & 3) * 16, mean[i], rstd[i]); }
#pragma unroll
        for (int bj = 0; bj < 2; ++bj)
#pragma unroll
            for (int n = 0; n < 2; ++n) { const int c = col0 + bj * HALF + n * 16; f32x4 gg, bb;
                if (BASE == 2) { gg = *(const f32x4*)(g + c); bb = *(const f32x4*)(b + c); }
#pragma unroll
                for (int i = 0; i < 8; ++i) { const int ai = i >> 2, m = i & 3; const size_t ro = (size_t)(row0 + ai * HALF + m * 16) * D; f32x4 x;
                    if (BASE == 0) x = *(const f32x4*)(basef + ro + c);
                    else { const u32x2 bw = *(const u32x2*)(baseb + ro + c); x = (f32x4){bf2f(bw.x & 0xffffu), __uint_as_float(bw.x & 0xffff0000u), bf2f(bw.y & 0xffffu), __uint_as_float(bw.y & 0xffff0000u)}; }
                    if (BASE == 2) x = (x - mean[i]) * rstd[i] * gg + bb;
                    const f32x4 v = x * ALPHA + acc[ai][bj][m][n];
                    u32x2 w; w.x = cvt_pk_bf16(v[0], v[1]); w.y = cvt_pk_bf16(v[2], v[3]); *(u32x2*)(xb + ro + c) = w;
                    s1[i] += (v[0] + v[1]) + (v[2] + v[3]); s2[i] += (v[0] * v[0] + v[1] * v[1]) + (v[2] * v[2] + v[3] * v[3]); }
                asm volatile("" ::: "memory"); }
#pragma unroll
        for (int i = 0; i < 8; ++i) { float a = s1[i], q = s2[i]; a += __shfl_xor(a, 16); a += __shfl_xor(a, 32); q += __shfl_xor(q, 16); q += __shfl_xor(q, 32);
            if (fq == 0) { const int r = row0 + (i >> 2) * HALF + (i & 3) * 16; atomicAdd(ssum + r, a); atomicAdd(ssq + r, q); } }
    }
};
struct EpiSwiGLU2 { static constexpr bool PERM = true, AFTER_DRAIN = false;
    bf16_t* HF; const float* ssum; const float* ssq; const float* cs; const float* cb;
    __device__ __forceinline__ void operator()(const f32x4 (&acc)[2][2][4][2], const Unit& u, int wr, int wc, int fr_, int fq_) const {
        int fr = fr_, fq = fq_; asm volatile("" : "+v"(fr), "+v"(fq));
        const int row0 = u.pm * BM + wr * 64 + fr, col0 = u.pn * HALF + wc * 32 + 8 * fq, cc0 = u.pn * BM + wc * 32 + 8 * fq;
        f32x4 csv[2][2], cbv[2][2];
#pragma unroll
        for (int bj = 0; bj < 2; ++bj)
#pragma unroll
            for (int n = 0; n < 2; ++n) { csv[bj][n] = *(const f32x4*)(cs + cc0 + bj * HALF + 4 * n); cbv[bj][n] = *(const f32x4*)(cb + cc0 + bj * HALF + 4 * n); }
#pragma unroll
        for (int ai = 0; ai < 2; ++ai)
#pragma unroll
            for (int m = 0; m < 4; ++m) { const int r = row0 + ai * HALF + m * 16; bf16_t* rowp = HF + (size_t)r * FF + col0;
                float mean, rstd; row_stats(ssum, ssq, r, mean, rstd);
                f32x4 h0, h1;
#pragma unroll
                for (int j = 0; j < 4; ++j) {
                    const float a0 = rstd * (acc[ai][0][m][0][j] - mean * csv[0][0][j]) + cbv[0][0][j], b0 = rstd * (acc[ai][1][m][0][j] - mean * csv[1][0][j]) + cbv[1][0][j];
                    const float a1 = rstd * (acc[ai][0][m][1][j] - mean * csv[0][1][j]) + cbv[0][1][j], b1 = rstd * (acc[ai][1][m][1][j] - mean * csv[1][1][j]) + cbv[1][1][j];
                    h0[j] = siluf_(a0) * b0; h1[j] = siluf_(a1) * b1; }
                u32x4 w; w.x = cvt_pk_bf16(h0[0], h0[1]); w.y = cvt_pk_bf16(h0[2], h0[3]); w.z = cvt_pk_bf16(h1[0], h1[1]); w.w = cvt_pk_bf16(h1[2], h1[3]);
                *(u32x4*)rowp = w; asm volatile("" ::: "memory"); }
    }
};
template <bool FINAL> struct EpiGate3 { static constexpr bool PERM = false, AFTER_DRAIN = false;
    const bf16_t* xr; const bf16_t* P; float* outf; bf16_t* ob1; bf16_t* ob2; const float* ssum; const float* ssq; const float* cs; const float* cb; const float* g; const float* b;
    __device__ __forceinline__ void operator()(const f32x4 (&acc)[2][2][4][2], const Unit& u, int wr, int wc, int fr_, int fq_) const {
        int fr = fr_, fq = fq_; asm volatile("" : "+v"(fr), "+v"(fq));
        const int row0 = u.pm * BM + wr * 64 + fr, col0 = u.pn * BM + wc * 32 + 4 * fq;
        float mean[8], rstd[8];
#pragma unroll
        for (int i = 0; i < 8; ++i) row_stats(ssum, ssq, row0 + (i >> 2) * HALF + (i & 3) * 16, mean[i], rstd[i]);
#pragma unroll
        for (int bj = 0; bj < 2; ++bj)
#pragma unroll
            for (int n = 0; n < 2; ++n) { const int c = col0 + bj * HALF + n * 16;
                const f32x4 gg = *(const f32x4*)(g + c), bb = *(const f32x4*)(b + c), c1 = *(const f32x4*)(cs + c), c2 = *(const f32x4*)(cb + c);
#pragma unroll
                for (int i = 0; i < 8; ++i) { const int ai = i >> 2, m = i & 3; const size_t o = (size_t)(row0 + ai * HALF + m * 16) * D + c;
                    const u32x2 rw = *(const u32x2*)(xr + o); const u32x2 pw = *(const u32x2*)(P + o);
                    const f32x4 rv = (f32x4){bf2f(rw.x & 0xffffu), __uint_as_float(rw.x & 0xffff0000u), bf2f(rw.y & 0xffffu), __uint_as_float(rw.y & 0xffff0000u)};
                    const f32x4 x = (rv - mean[i]) * rstd[i] * gg + bb; const f32x4 a = (acc[ai][bj][m][n] - c1 * mean[i]) * rstd[i] + c2; f32x4 o4;
                    o4[0] = x[0] + bf2f(pw.x & 0xffffu) * sigmoidf_(a[0]); o4[1] = x[1] + __uint_as_float(pw.x & 0xffff0000u) * sigmoidf_(a[1]);
                    o4[2] = x[2] + bf2f(pw.y & 0xffffu) * sigmoidf_(a[2]); o4[3] = x[3] + __uint_as_float(pw.y & 0xffff0000u) * sigmoidf_(a[3]);
                    if (FINAL) __builtin_nontemporal_store(o4, (f32x4*)(outf + o));
                    else { u32x2 w; w.x = cvt_pk_bf16(o4[0], o4[1]); w.y = cvt_pk_bf16(o4[2], o4[3]); *(u32x2*)(ob1 + o) = w; *(u32x2*)(ob2 + o) = w; } }
                asm volatile("" ::: "memory"); }
    }
};
}

template <class Epi>
__device__ __forceinline__ void run_gemm(int wid_s, LAS unsigned char* lds, const bf16_t* A, const bf16_t* Bt, int Mrows, int N, int K, const Epi& E) {
    pg8::Gemm g{A, Bt, Mrows, N, K, K}; pg8::StaticOrder S; S.init(Mrows, N, (int)gridDim.x, (int)blockIdx.x);
    pg8::gemm_phase<Epi, pg8::StaticOrder, true, true>(wid_s, lds, g, S, E);
}
namespace pg8 {
struct SplitOrder { int nN, nS, G, c;
    __device__ bool next(int i, Unit& u) const { const int L = i * G + c; if (L >= nN * nS) return false; u.pm = 64; u.pn = L % nN; u.ko = (L / nN) * 256; return true; }
    __device__ __forceinline__ void a_ready(const Unit&) const {}
    __device__ __forceinline__ void done(const Unit&) const {}
};
struct EpiSlab { static constexpr bool PERM = false, AFTER_DRAIN = false;
    float* slab;
    __device__ __forceinline__ void operator()(const f32x4 (&acc)[2][2][4][2], const Unit& u, int wr, int wc, int fr_, int fq_) const {
        int fr = fr_, fq = fq_; asm volatile("" : "+v"(fr), "+v"(fq));
        const int row0 = wr * 64 + fr, col0 = u.pn * BM + wc * 32 + 4 * fq; float* sp = slab + (size_t)(u.ko >> 8) * (256 * D);
#pragma unroll
        for (int ai = 0; ai < 2; ++ai)
#pragma unroll
            for (int m = 0; m < 4; ++m) { float* op = sp + (size_t)(row0 + ai * HALF + m * 16) * D;
#pragma unroll
                for (int bj = 0; bj < 2; ++bj)
#pragma unroll
                    for (int n = 0; n < 2; ++n) *(f32x4*)(op + col0 + bj * HALF + n * 16) = acc[ai][bj][m][n]; }
    }
};
}
__device__ __forceinline__ void run_gemm_split(int wid_s, LAS unsigned char* lds, const bf16_t* A, const bf16_t* Bt, int K, float* slab) {
    pg8::Gemm g{A, Bt, MT, D, K, 256}; pg8::SplitOrder S{4, K / 256, (int)gridDim.x, (int)(gridDim.x - 1 - blockIdx.x)}; pg8::EpiSlab E{slab};
    pg8::gemm_phase<pg8::EpiSlab, pg8::SplitOrder, true, true>(wid_s, lds, g, S, E);
}

template <int NCT, class Fin>
__device__ __forceinline__ void mini_gemm_tail(int wid_s, LAS unsigned char* lds, const bf16_t* A, const bf16_t* Bt, int K, const Fin& fin) {
    const int lane = lane_id_(), wv = wid_s, tid = wv * 64 + lane; LAS float* red = (LAS float*)lds; constexpr int NB = 16 * NCT;
    for (int blk = blockIdx.x; blk < 256; blk += gridDim.x) {
        const int rows0 = MP + (blk >> 5) * 32, cols0 = (blk & 31) * NB, kw = K >> 3;
        f32x4 acc[2][NCT];
#pragma unroll
        for (int rt = 0; rt < 2; ++rt)
#pragma unroll
            for (int ct = 0; ct < NCT; ++ct) acc[rt][ct] = (f32x4){0.f, 0.f, 0.f, 0.f};
        const bf16_t* ap = A + (size_t)(rows0 + (lane & 15)) * K + wv * kw + 8 * (lane >> 4);
        const bf16_t* bp = Bt + (size_t)(cols0 + (lane & 15)) * K + wv * kw + 8 * (lane >> 4);
#pragma unroll 4
        for (int k0 = 0; k0 < kw; k0 += 32) {
            const bf16x8 a0 = *(const bf16x8*)(ap + k0), a1 = *(const bf16x8*)(ap + (size_t)16 * K + k0);
#pragma unroll
            for (int ct = 0; ct < NCT; ++ct) { const bf16x8 bf = *(const bf16x8*)(bp + (size_t)(16 * ct) * K + k0); acc[0][ct] = mfma16(bf, a0, acc[0][ct]); acc[1][ct] = mfma16(bf, a1, acc[1][ct]); } }
#pragma unroll
        for (int rt = 0; rt < 2; ++rt)
#pragma unroll
            for (int ct = 0; ct < NCT; ++ct) *(LAS f32x4*)(red + ((wv * 32 + rt * 16 + (lane & 15)) * NB + ct * 16 + (lane >> 4) * 4)) = acc[rt][ct];
        __syncthreads();
        if (tid < 8 * NB) { const int row = tid / (NB / 4), cg = (tid % (NB / 4)) * 4; f32x4 s = (f32x4){0.f, 0.f, 0.f, 0.f};
#pragma unroll
            for (int w = 0; w < 8; ++w) s += *(const LAS f32x4*)(red + ((w * 32 + row) * NB + cg));
            fin(rows0 + row, cols0 + cg, s); }
        __syncthreads();
    }
}
struct FinStore { bf16_t* O; int ldc;
    __device__ __forceinline__ void operator()(int r, int c, const f32x4 acc) const { u32x2 w; w.x = pk2(acc[0], acc[1]); w.y = pk2(acc[2], acc[3]); *(u32x2*)(O + (size_t)r * ldc + c) = w; } };
struct FinRes { int kind; const float* basef; const bf16_t* baseb; bf16_t* xb; float* ssum; float* ssq; const float* pss; const float* psq; const float* g; const float* b;
    __device__ __forceinline__ void operator()(int r, int c, const f32x4 acc) const { const size_t o = (size_t)r * D + c; f32x4 x;
        if (kind == 0) x = *(const f32x4*)(basef + (size_t)(r - MP) * D + c);
        else { const u32x2 bw = *(const u32x2*)(baseb + o); x = (f32x4){bf2f(bw.x & 0xffffu), __uint_as_float(bw.x & 0xffff0000u), bf2f(bw.y & 0xffffu), __uint_as_float(bw.y & 0xffff0000u)}; }
        if (kind == 2) { float mean, rstd; pg8::row_stats(pss, psq, r, mean, rstd); x = (x - mean) * rstd * *(const f32x4*)(g + c) + *(const f32x4*)(b + c); }
        const f32x4 v = x * ALPHA + acc; u32x2 w; w.x = pk2(v[0], v[1]); w.y = pk2(v[2], v[3]); *(u32x2*)(xb + o) = w;
        float s1 = (v[0] + v[1]) + (v[2] + v[3]), s2 = (v[0] * v[0] + v[1] * v[1]) + (v[2] * v[2] + v[3] * v[3]);
        s1 += __shfl_xor(s1, 1); s1 += __shfl_xor(s1, 2); s1 += __shfl_xor(s1, 4); s2 += __shfl_xor(s2, 1); s2 += __shfl_xor(s2, 2); s2 += __shfl_xor(s2, 4);
        if ((c & 31) == 0) { atomicAdd(ssum + r, s1); atomicAdd(ssq + r, s2); } }
};
struct FinGate { bool final_; const bf16_t* xr; const bf16_t* P; float* outf; bf16_t* ob1; bf16_t* ob2; const float* ssum; const float* ssq; const float* cs; const float* cb; const float* g; const float* b;
    __device__ __forceinline__ void operator()(int r, int c, const f32x4 acc) const {
        float mean, rstd; pg8::row_stats(ssum, ssq, r, mean, rstd); const size_t o = (size_t)r * D + c;
        const u32x2 rw = *(const u32x2*)(xr + o); const u32x2 pw = *(const u32x2*)(P + o);
        const f32x4 gg = *(const f32x4*)(g + c), bb = *(const f32x4*)(b + c), c1 = *(const f32x4*)(cs + c), c2 = *(const f32x4*)(cb + c);
        const f32x4 rv = (f32x4){bf2f(rw.x & 0xffffu), __uint_as_float(rw.x & 0xffff0000u), bf2f(rw.y & 0xffffu), __uint_as_float(rw.y & 0xffff0000u)};
        const f32x4 x = (rv - mean) * rstd * gg + bb; const f32x4 a = (acc - c1 * mean) * rstd + c2; f32x4 o4;
        o4[0] = x[0] + bf2f(pw.x & 0xffffu) * sigmoidf_(a[0]); o4[1] = x[1] + __uint_as_float(pw.x & 0xffff0000u) * sigmoidf_(a[1]);
        o4[2] = x[2] + bf2f(pw.y & 0xffffu) * sigmoidf_(a[2]); o4[3] = x[3] + __uint_as_float(pw.y & 0xffff0000u) * sigmoidf_(a[3]);
        if (final_) __builtin_nontemporal_store(o4, (f32x4*)(outf + o));
        else { u32x2 w; w.x = pk2(o4[0], o4[1]); w.y = pk2(o4[2], o4[3]); *(u32x2*)(ob1 + o) = w; *(u32x2*)(ob2 + o) = w; } }
};

__device__ __forceinline__ void tr_item(const float* W, int ldw, int nvalid, int k0, int n0, bf16_t* WT, int ldt, int drow0, LAS float* scr, int lane,
                                        const float* gs = nullptr, const float* bs = nullptr, float* cs = nullptr, float* cb = nullptr) {
    float wv_[32];
#pragma unroll
    for (int i = 0; i < 32; ++i) { const int kk = 2 * i + (lane >> 5), n = n0 + (lane & 31); wv_[i] = (n < nvalid) ? W[(size_t)(k0 + kk) * ldw + n] : 0.f; }
#pragma unroll
    for (int i = 0; i < 32; ++i) scr[(2 * i + (lane >> 5)) * 33 + (lane & 31)] = wv_[i];
    LDS_WAIT();
    const int c = lane & 7;
    float gk[8], bk[8];
    if (gs != nullptr) { load8f(gs + k0 + 8 * c, gk); load8f(bs + k0 + 8 * c, bk); }
#pragma unroll
    for (int j = 0; j < 4; ++j) { const int n = (lane >> 3) + 8 * j; const LAS float* s = scr + (8 * c) * 33 + n; float w[8];
#pragma unroll
        for (int q = 0; q < 8; ++q) w[q] = s[q * 33];
        if (gs != nullptr) { float csp = 0.f, cbp = 0.f;
#pragma unroll
            for (int q = 0; q < 8; ++q) { cbp += w[q] * bk[q]; w[q] *= gk[q]; csp += bf2f(f2bf(w[q])); }
            csp += __shfl_xor(csp, 1); csp += __shfl_xor(csp, 2); csp += __shfl_xor(csp, 4); cbp += __shfl_xor(cbp, 1); cbp += __shfl_xor(cbp, 2); cbp += __shfl_xor(cbp, 4);
            if (c == 0 && n0 + n < nvalid) { atomicAdd(cs + drow0 + n, csp); atomicAdd(cb + drow0 + n, cbp); } }
        u32x4 o; o.x = pk2(w[0], w[1]); o.y = pk2(w[2], w[3]); o.z = pk2(w[4], w[5]); o.w = pk2(w[6], w[7]);
        if (n0 + n < nvalid) *(u32x4*)(WT + (size_t)(drow0 + n) * ldt + k0 + 8 * c) = o; }
    LDS_WAIT();
}
__device__ __forceinline__ void tr_plain(const float* W, int K, int N, bf16_t* WT, int item, LAS float* scr, int lane) {
    const int nblk = (N + 31) / 32, kb = item / nblk, nb = item % nblk; tr_item(W, N, N, 64 * kb, 32 * nb, WT, K, 32 * nb, scr, lane);
}
__device__ __forceinline__ void cvt_f32_bf16(const float* src, bf16_t* dst, size_t n4, size_t gtid, size_t gstride) {
    size_t i = gtid;
    for (; i + 7 * gstride < n4; i += 8 * gstride) { f32x4 v[8];
#pragma unroll
        for (int j = 0; j < 8; ++j) v[j] = *(const f32x4*)(src + 4 * (i + j * gstride));
#pragma unroll
        for (int j = 0; j < 8; ++j) { u32x2 w; w.x = pk2(v[j].x, v[j].y); w.y = pk2(v[j].z, v[j].w); *(u32x2*)(dst + 4 * (i + j * gstride)) = w; } }
    for (; i < n4; i += gstride) { const f32x4 v = *(const f32x4*)(src + 4 * i); u32x2 w; w.x = pk2(v.x, v.y); w.y = pk2(v.z, v.w); *(u32x2*)(dst + 4 * i) = w; }
}
template <int PART>
__device__ __forceinline__ void p0_prep(int wid_s, const CAS Params& p, LAS unsigned char* lds) {
    const int lane = lane_id_(), wv = wid_s, tid = wv * 64 + lane;
    LAS float* scr = (LAS float*)(lds + wv * 16384);
    const int gw = blockIdx.x * 8 + wv, NGW = gridDim.x * 8;
    unsigned char* ws = p.ws;
    constexpr int I_INE = 16 * 64, I_SQ = 16 * 32, I_INO = 16 * 81, I_F1 = 16 * 88, I_F2 = 44 * 32, I_PL = 4 * 32, I_POOL = 32;
    constexpr int PER_L = 2 * I_F1 + I_F2 + I_SQ + I_PL;
    constexpr int NITEMS = PART == 0 ? (I_INE + I_SQ + PER_L + I_POOL) : (I_INO + I_SQ + PER_L);
    constexpr int l = PART;
    for (int it = gw; it < NITEMS; it += NGW) {
        int r = it;
        if (PART == 0) {
            if (r < I_INE) { tr_plain(p.in[I_WINE], D, 2048, (bf16_t*)(ws + WS_WINE), r, scr, lane); continue; } r -= I_INE;
            if (r < I_SQ) { tr_plain(p.in[I_WOUTE], D, D, (bf16_t*)(ws + WS_WOUTE), r, scr, lane); continue; } r -= I_SQ;
        } else {
            if (r < I_INO) { tr_plain(p.in[I_WINO], D, 2568, (bf16_t*)(ws + WS_WINO), r, scr, lane); continue; } r -= I_INO;
            if (r < I_SQ) { tr_plain(p.in[I_WOUTO], D, D, (bf16_t*)(ws + WS_WOUTO), r, scr, lane); continue; } r -= I_SQ;
        }
        if (r < PER_L) {
            if (r < 2 * I_F1) { const int which = r / I_F1, rr = r % I_F1, kb = rr / 88, nb = rr % 88, n0 = 32 * nb;
                const float* W = p.in[which ? I_FF3 : I_FF1] + (size_t)l * D * FF;
                tr_item(W, FF, FF, 64 * kb, n0, (bf16_t*)(ws + WS_W13 + l * W13_BYTES), D, (n0 >> 7) * 256 + which * 128 + (n0 & 127), scr, lane,
                        p.in[I_LN1G] + l * D, p.in[I_LN1B] + l * D, (float*)(ws + WS_CS13) + l * 5632, (float*)(ws + WS_CB13) + l * 5632); continue; } r -= 2 * I_F1;
            if (r < I_F2) { tr_plain(p.in[I_FF2] + (size_t)l * FF * D, FF, D, (bf16_t*)(ws + WS_W2 + l * W2_BYTES), r, scr, lane); continue; } r -= I_F2;
            if (r < I_SQ) { const int kb = r / 32, nb = r % 32; tr_item(p.in[I_WGATE] + (size_t)l * D * D, D, D, 64 * kb, 32 * nb, (bf16_t*)(ws + WS_WG + l * WG_BYTES), D, 32 * nb, scr, lane,
                        p.in[I_LN2G] + l * D, p.in[I_LN2B] + l * D, (float*)(ws + WS_CSG) + l * D, (float*)(ws + WS_CBG) + l * D); continue; } r -= I_SQ;
            tr_plain(p.in[I_WPLE] + (size_t)l * 256 * D, 256, D, (bf16_t*)(ws + WS_WPLE + l * WPLE_BYTES), r, scr, lane); continue; }
        r -= PER_L;
        if (PART == 0) { const int g = r >> 3, rr = r & 7; tr_plain(p.in[I_POOLW] + g * 16384, 128, 128, (bf16_t*)(ws + WS_WPOOL) + g * 16384, rr, scr, lane); }
    }
    const size_t gtid = (size_t)blockIdx.x * 512 + tid, gstride = (size_t)gridDim.x * 512;
    if (PART == 0) {
        { u32x4* z = (u32x4*)(ws + WS_STATS); const size_t n = (size_t)4 * 2 * MT * 4 / 16; for (size_t i = gtid; i < n; i += gstride) z[i] = (u32x4){0u, 0u, 0u, 0u}; }
        cvt_f32_bf16(p.in[I_XP], (bf16_t*)(ws + WS_XB), (size_t)MP * D / 4, gtid, gstride);
        cvt_f32_bf16(p.in[I_XS], (bf16_t*)(ws + WS_XB) + (size_t)MP * D, (size_t)MSAMP * D / 4, gtid, gstride);
        cvt_f32_bf16(p.in[I_PP], (bf16_t*)(ws + WS_PLEB), (size_t)MP * 256 / 4, gtid, gstride);
        cvt_f32_bf16(p.in[I_PS], (bf16_t*)(ws + WS_PLEB) + (size_t)MP * 256, (size_t)MSAMP * 256 / 4, gtid, gstride);
    } else {
        { u32x4* z = (u32x4*)(ws + WS_WINO + (size_t)2568 * D * 2); const size_t n = (size_t)(NINO - 2568) * D * 2 / 16; for (size_t i = gtid; i < n; i += gstride) z[i] = (u32x4){0u, 0u, 0u, 0u}; }
        { bf16_t* o = (bf16_t*)(ws + WS_WSGU); const float* w = p.in[I_SGUW]; for (size_t i = gtid; i < 65536; i += gstride) { const int t = (int)(i >> 7) & 127, s = (int)i & 127; o[i] = (bf16_t)((s <= t) ? f2bf(w[i]) : 0u); } }
    }
}

__device__ __forceinline__ void ln_sample(int wid_s, bf16_t* xb, const float* slab, int nsl, const float* sbf, const bf16_t* sbb, float* ssum, float* ssq,
                                          const float* pss, const float* psq, const float* g, const float* b) {
    const int lane = lane_id_(), wv = wid_s;
    const int gw = blockIdx.x * 8 + wv, NGW = gridDim.x * 8;
    for (int m = MP + gw; m < MT; m += NGW) {
        f32x4 v[4];
        if (sbf != nullptr) { const f32x4* br = (const f32x4*)(sbf + (size_t)(m - MP) * D) + lane;
#pragma unroll
            for (int j = 0; j < 4; ++j) v[j] = br[64 * j]; }
        else { const u32x2* br = (const u32x2*)(sbb + (size_t)(m - MP) * D) + lane;
#pragma unroll
            for (int j = 0; j < 4; ++j) { const u32x2 bw = br[64 * j]; v[j] = (f32x4){bf2f(bw.x & 0xffffu), __uint_as_float(bw.x & 0xffff0000u), bf2f(bw.y & 0xffffu), __uint_as_float(bw.y & 0xffff0000u)}; } }
        if (pss != nullptr) { float mean, rstd; pg8::row_stats(pss, psq, m, mean, rstd);
#pragma unroll
            for (int j = 0; j < 4; ++j) v[j] = (v[j] - mean) * rstd * *(const f32x4*)(g + 4 * lane + 256 * j) + *(const f32x4*)(b + 4 * lane + 256 * j); }
#pragma unroll
        for (int j = 0; j < 4; ++j) v[j] = v[j] * ALPHA;
        for (int sl = 0; sl < nsl; ++sl) { const f32x4* sr = (const f32x4*)(slab + (size_t)sl * (256 * D) + (size_t)(m - MP) * D) + lane;
#pragma unroll
            for (int j = 0; j < 4; ++j) v[j] += sr[64 * j]; }
        float s = 0.f, q = 0.f;
#pragma unroll
        for (int j = 0; j < 4; ++j) { s += (v[j].x + v[j].y) + (v[j].z + v[j].w); q += (v[j].x * v[j].x + v[j].y * v[j].y) + (v[j].z * v[j].z + v[j].w * v[j].w); }
        s = wave_sum(s); q = wave_sum(q);
        if (lane == 0) { ssum[m] = s; ssq[m] = q; }
        u32x2* o8 = (u32x2*)(xb + (size_t)m * D) + lane;
#pragma unroll
        for (int j = 0; j < 4; ++j) { u32x2 w; w.x = pk2(v[j].x, v[j].y); w.y = pk2(v[j].z, v[j].w); o8[64 * j] = w; }
    }
}

__device__ __forceinline__ void even_mixer_tile(int wid_s, const CAS Params& p, LAS unsigned char* lds, int ti) {
    const int lane = lane_id_(), wv = wid_s, tid = wv * 64 + lane;
    int row0, nvalid, tpos0, sb = -1, b = 0;
    if (ti < 256) { row0 = ti * 64; nvalid = 64; tpos0 = row0 & (SEQ - 1); b = ti >> 7; } else { sb = ti - 256; row0 = MP + sb * 32; nvalid = 32; tpos0 = 4096; }
    const bf16_t* H0 = (const bf16_t*)(p.ws + WS_REGA); bf16_t* MIX = (bf16_t*)(p.ws + WS_MIX);
    const bf16_t* poolT = (const bf16_t*)(p.ws + WS_WPOOL);
    constexpr int LDA = 520;
    LAS bf16_t* A2 = (LAS bf16_t*)lds;
    const bool first = (sb < 0 && tpos0 == 0);
    const bool lasttile = (sb >= 0) || (tpos0 == SEQ - 64);
#pragma unroll 5
    for (int it = tid; it < 79 * 64; it += 512) { const int j = it >> 6, c8 = (it & 63) * 8, tok = j - 15; u32x4 w = (u32x4){0u, 0u, 0u, 0u};
        if (tok < nvalid) {
            if (tok >= 0 || (sb < 0 && !first)) w = *(const u32x4*)(H0 + (size_t)(row0 + tok) * NH0 + c8);
            else if (sb >= 0) { float v[8]; load8f(p.in[I_STPOOL] + (size_t)(sb * 15 + j) * 512 + c8, v); w = pack8(v); } }
        *(LAS u32x4*)(A2 + j * LDA + c8) = w; }
    __syncthreads();
    { const int c = tid, gi = c >> 7, w = 2 << gi; float W = 0.f;
        for (int k = 0; k < w; ++k) W += bf2f((unsigned)A2[(15 + 63 - k) * LDA + c]);
        const float inv = 1.f / (float)w;
        for (int t = 63; t >= 0; --t) { const float a = bf2f((unsigned)A2[(15 + t) * LDA + c]);
            if (lasttile && t < nvalid && t >= nvalid - 15) { const int j = t - (nvalid - 15); p.out[((sb >= 0) ? O_POOLS + (size_t)(sb * 15 + j) * 512 : O_POOLP + (size_t)(b * 15 + j) * 512) + c] = a; }
            const float sc = (first && t + 1 < w) ? 1.f / (float)(t + 1) : inv;
            const float d = W * sc - a;
            if (t > 0) W += bf2f((unsigned)A2[(15 + t - w) * LDA + c]) - a;
            A2[(15 + t) * LDA + c] = (bf16_t)f2bf(d); } }
    __syncthreads();
    { const int gi = wv >> 1, eb = (wv & 1) * 4; f32x4 acc[4][4];
#pragma unroll
        for (int tt = 0; tt < 4; ++tt)
#pragma unroll
            for (int q = 0; q < 4; ++q) acc[tt][q] = (f32x4){0.f, 0.f, 0.f, 0.f};
#pragma unroll
        for (int ks = 0; ks < 4; ++ks) { bf16x8 bfr[4];
#pragma unroll
            for (int q = 0; q < 4; ++q) bfr[q] = *(const bf16x8*)(poolT + gi * 16384 + ((eb + q) * 16 + (lane & 15)) * 128 + ks * 32 + 8 * (lane >> 4));
#pragma unroll
            for (int tt = 0; tt < 4; ++tt) { const bf16x8 af = *(const LAS bf16x8*)(A2 + (15 + tt * 16 + (lane & 15)) * LDA + gi * 128 + ks * 32 + 8 * (lane >> 4));
#pragma unroll
                for (int q = 0; q < 4; ++q) acc[tt][q] = mfma16(bfr[q], af, acc[tt][q]); } }
#pragma unroll
        for (int q = 0; q < 4; ++q) { const int e0 = (eb + q) * 16 + (lane >> 4) * 4; const f32x4 sc = *(const f32x4*)(p.in[I_POOLSC] + gi * 128 + e0);
#pragma unroll
            for (int tt = 0; tt < 4; ++tt) { const int t = tt * 16 + (lane & 15);
                if (t < nvalid) { u32x2 o; o.x = pk2(acc[tt][q][0] * sc[0], acc[tt][q][1] * sc[1]); o.y = pk2(acc[tt][q][2] * sc[2], acc[tt][q][3] * sc[3]);
                    *(u32x2*)(MIX + (size_t)(row0 + t) * D + gi * 128 + e0) = o; } } } }
    const float* cw = p.in[I_CONVW];
#pragma unroll 2
    for (int it = tid; it < nvalid * 64; it += 512) { const int t = it >> 6, c8 = (it & 63) * 8; float cg[3][8];
        { float cgt[3][8], hv[3][8];
#pragma unroll
            for (int dk = 0; dk < 3; ++dk) { const int tok = t - 2 + dk; const int tokc = (tok < 0 && (first || sb >= 0)) ? 0 : tok;
                load8bf(H0 + (size_t)(row0 + tokc) * NH0 + 1024 + c8, cgt[dk]); load8bf(H0 + (size_t)(row0 + tokc) * NH0 + 1536 + c8, hv[dk]); }
#pragma unroll
            for (int dk = 0; dk < 3; ++dk)
#pragma unroll
                for (int q = 0; q < 8; ++q) cg[dk][q] = cgt[dk][q] * hv[dk][q];
            if (sb >= 0) {
#pragma unroll
                for (int dk = 0; dk < 2; ++dk) { const int tok = t - 2 + dk; if (tok < 0) load8f(p.in[I_STCONV] + (size_t)(sb * 2 + 2 + tok) * 512 + c8, cg[dk]); }
            } else if (first) {
#pragma unroll
                for (int dk = 0; dk < 2; ++dk) { const bool hist = (t - 2 + dk) < 0;
#pragma unroll
                    for (int q = 0; q < 8; ++q) cg[dk][q] = hist ? 0.f : cg[dk][q]; } } }
        float bg[8], w0[8], w1[8], w2[8], y[8];
        load8bf(H0 + (size_t)(row0 + t) * NH0 + 512 + c8, bg); load8f(cw + c8, w0); load8f(cw + 512 + c8, w1); load8f(cw + 1024 + c8, w2);
#pragma unroll
        for (int q = 0; q < 8; ++q) y[q] = bg[q] * (w0[q] * cg[0][q] + w1[q] * cg[1][q] + w2[q] * cg[2][q]);
        *(u32x4*)(MIX + (size_t)(row0 + t) * D + 512 + c8) = pack8(y);
        if (lasttile && t >= nvalid - 2) { const int j = t - (nvalid - 2); float* o = p.out + ((sb >= 0) ? O_CONVS + (size_t)(sb * 2 + j) * 512 + c8 : O_CONVP + (size_t)(b * 2 + j) * 512 + c8);
            *(f32x4*)o = (f32x4){cg[2][0], cg[2][1], cg[2][2], cg[2][3]}; *(f32x4*)(o + 4) = (f32x4){cg[2][4], cg[2][5], cg[2][6], cg[2][7]}; }
    }
    __syncthreads();
}

__device__ __forceinline__ void even_mixer_part(int wid_s, const CAS Params& p, LAS unsigned char* lds, int ti, int part) {
    const int lane = lane_id_(), wv = wid_s, tid = wv * 64 + lane;
    int row0, nvalid, tpos0, sb = -1, b = 0;
    if (ti < 256) { row0 = ti * 64; nvalid = 64; tpos0 = row0 & (SEQ - 1); b = ti >> 7; } else { sb = ti - 256; row0 = MP + sb * 32; nvalid = 32; tpos0 = 4096; }
    const bf16_t* H0 = (const bf16_t*)(p.ws + WS_REGA); bf16_t* MIX = (bf16_t*)(p.ws + WS_MIX);
    const bf16_t* poolT = (const bf16_t*)(p.ws + WS_WPOOL);
    LAS float* araw = (LAS float*)lds; LAS bf16_t* dA = (LAS bf16_t*)(lds + 40448);
    const bool first = (sb < 0 && tpos0 == 0);
    const bool lasttile = (sb >= 0) || (tpos0 == SEQ - 64);
    if (part < 4) { const int gi = part;
        for (int it = tid; it < 79 * 16; it += 512) { const int j = it >> 4, c8 = (it & 15) * 8, tok = j - 15; float v[8];
#pragma unroll
            for (int q = 0; q < 8; ++q) v[q] = 0.f;
            if (tok < nvalid) {
                if (tok >= 0 || (sb < 0 && !first)) load8bf(H0 + (size_t)(row0 + tok) * NH0 + gi * 128 + c8, v);
                else if (sb >= 0) load8f(p.in[I_STPOOL] + (size_t)(sb * 15 + j) * 512 + gi * 128 + c8, v);
            }
            *(LAS f32x4*)(araw + j * 128 + c8) = (f32x4){v[0], v[1], v[2], v[3]}; *(LAS f32x4*)(araw + j * 128 + c8 + 4) = (f32x4){v[4], v[5], v[6], v[7]}; }
        __syncthreads();
        if (lasttile) { for (int it = tid; it < 15 * 128; it += 512) { const int j = it >> 7, c = it & 127, t = nvalid - 15 + j;
                const size_t o = (sb >= 0) ? O_POOLS + (size_t)(sb * 15 + j) * 512 + gi * 128 + c : O_POOLP + (size_t)(b * 15 + j) * 512 + gi * 128 + c;
                p.out[o] = araw[(15 + t) * 128 + c]; } }
        const int w = 2 << gi;
        for (int it = tid; it < 64 * 128; it += 512) { const int t = it >> 7, c = it & 127; float s = 0.f;
            for (int k = 0; k < w; ++k) s += araw[(15 + t - k) * 128 + c];
            const int cnt = first ? (w < t + 1 ? w : t + 1) : w;
            dA[t * 136 + c] = (bf16_t)f2bf(s / (float)cnt - araw[(15 + t) * 128 + c]); }
        __syncthreads();
        { const int tt = wv & 3, eb = (wv >> 2) * 4; f32x4 acc[4];
#pragma unroll
            for (int q = 0; q < 4; ++q) acc[q] = (f32x4){0.f, 0.f, 0.f, 0.f};
#pragma unroll
            for (int ks = 0; ks < 4; ++ks) { const bf16x8 af = *(const LAS bf16x8*)(dA + (tt * 16 + (lane & 15)) * 136 + ks * 32 + 8 * (lane >> 4));
#pragma unroll
                for (int q = 0; q < 4; ++q) { const bf16x8 bf = *(const bf16x8*)(poolT + gi * 16384 + ((eb + q) * 16 + (lane & 15)) * 128 + ks * 32 + 8 * (lane >> 4)); acc[q] = mfma16(bf, af, acc[q]); } }
            const int t = tt * 16 + (lane & 15);
            if (t < nvalid) {
#pragma unroll
                for (int q = 0; q < 4; ++q) { const int e0 = (eb + q) * 16 + (lane >> 4) * 4; const f32x4 sc = *(const f32x4*)(p.in[I_POOLSC] + gi * 128 + e0);
                    u32x2 o; o.x = pk2(acc[q][0] * sc[0], acc[q][1] * sc[1]); o.y = pk2(acc[q][2] * sc[2], acc[q][3] * sc[3]);
                    *(u32x2*)(MIX + (size_t)(row0 + t) * D + gi * 128 + e0) = o; } } }
        __syncthreads();
    }
    if (part < 4) return;
    const float* cw = p.in[I_CONVW];
    for (int it = tid; it < nvalid * 32; it += 512) { const int t = it >> 5, c8 = (part - 4) * 256 + (it & 31) * 8; float cg[3][8];
#pragma unroll
        for (int dk = 0; dk < 3; ++dk) { const int tok = t - 2 + dk;
            if (tok >= 0 || (sb < 0 && !first)) { float cgt[8], hv[8]; load8bf(H0 + (size_t)(row0 + tok) * NH0 + 1024 + c8, cgt); load8bf(H0 + (size_t)(row0 + tok) * NH0 + 1536 + c8, hv);
#pragma unroll
                for (int q = 0; q < 8; ++q) cg[dk][q] = cgt[q] * hv[q]; }
            else if (sb >= 0) { float hv[8]; load8f(p.in[I_STCONV] + (size_t)(sb * 2 + 2 + tok) * 512 + c8, hv);
#pragma unroll
                for (int q = 0; q < 8; ++q) cg[dk][q] = hv[q]; }
            else {
#pragma unroll
                for (int q = 0; q < 8; ++q) cg[dk][q] = 0.f; } }
        float bg[8], w0[8], w1[8], w2[8], y[8];
        load8bf(H0 + (size_t)(row0 + t) * NH0 + 512 + c8, bg); load8f(cw + c8, w0); load8f(cw + 512 + c8, w1); load8f(cw + 1024 + c8, w2);
#pragma unroll
        for (int q = 0; q < 8; ++q) y[q] = bg[q] * (w0[q] * cg[0][q] + w1[q] * cg[1][q] + w2[q] * cg[2][q]);
        *(u32x4*)(MIX + (size_t)(row0 + t) * D + 512 + c8) = pack8(y);
        if (lasttile && t >= nvalid - 2) { const int j = t - (nvalid - 2); float* o = p.out + ((sb >= 0) ? O_CONVS + (size_t)(sb * 2 + j) * 512 + c8 : O_CONVP + (size_t)(b * 2 + j) * 512 + c8);
            *(f32x4*)o = (f32x4){cg[2][0], cg[2][1], cg[2][2], cg[2][3]}; *(f32x4*)(o + 4) = (f32x4){cg[2][4], cg[2][5], cg[2][6], cg[2][7]}; }
    }
    __syncthreads();
}

__device__ __forceinline__ void sgu_block(int wid_s, const CAS Params& p, LAS unsigned char* lds, int bi) {
    const int lane = lane_id_(), wv = wid_s, tid = wv * 64 + lane;
    int row0, nvalid, sb = -1;
    if (bi < 128) { row0 = bi * 128; nvalid = 128; } else { sb = bi - 128; row0 = MP + sb * 32; nvalid = 32; }
    const bf16_t* H1 = (const bf16_t*)(p.ws + WS_REGA); bf16_t* MIX = (bf16_t*)(p.ws + WS_MIX); const bf16_t* sguW = (const bf16_t*)(p.ws + WS_WSGU);
    LAS float* stats = (LAS float*)lds; LAS bf16_t* vT = (LAS bf16_t*)(lds + 1024);
    { const int t = wv * 16 + (lane >> 2), sub = lane & 3;
        float s = 0.f, s2 = 0.f;
        if (t < nvalid) {
#pragma unroll 4
            for (int i = 0; i < 16; ++i) { float v[8]; load8bf(H1 + (size_t)(row0 + t) * NH1 + 512 + sub * 128 + i * 8, v);
#pragma unroll
                for (int q = 0; q < 8; ++q) { const float gv = geluf_(v[q]); s += gv; s2 += gv * gv; } } }
        s += __shfl_xor(s, 1); s += __shfl_xor(s, 2); s2 += __shfl_xor(s2, 1); s2 += __shfl_xor(s2, 2);
        const float mean = s * (1.f / 512.f), var = fmaxf(s2 * (1.f / 512.f) - mean * mean, 0.f);
        if (t < nvalid && sub == 0) { stats[2 * t] = mean; stats[2 * t + 1] = 1.f / sqrtf(var + LN_EPS); } }
    __syncthreads();
    for (int g = 0; g < 4; ++g) {
#pragma unroll 4
    for (int it = tid; it < 128 * 16; it += 512) { const int blk = it >> 6, s = (blk & 15) * 8 + (lane >> 3), d8 = ((blk >> 4) * 8 + (lane & 7)) * 8;
            if (s < nvalid) { float v[8], lg[8], lb[8]; load8bf(H1 + (size_t)(row0 + s) * NH1 + 512 + g * 128 + d8, v); load8f(p.in[I_SGULNG] + g * 128 + d8, lg); load8f(p.in[I_SGULNB] + g * 128 + d8, lb);
                const float mean = stats[2 * s], rstd = stats[2 * s + 1];
#pragma unroll
                for (int q = 0; q < 8; ++q) { v[q] = (geluf_(v[q]) - mean) * rstd * lg[q] + lb[q]; vT[(d8 + q) * 136 + swz(d8 + q, s)] = (bf16_t)f2bf(v[q]); }
                if (sb >= 0) { float* o = p.out + O_SGUV + (size_t)(sb * 32 + s) * 512 + g * 128 + d8; *(f32x4*)o = (f32x4){v[0], v[1], v[2], v[3]}; *(f32x4*)(o + 4) = (f32x4){v[4], v[5], v[6], v[7]}; }
            } else {
#pragma unroll
                for (int q = 0; q < 8; ++q) vT[(d8 + q) * 136 + swz(d8 + q, s)] = (bf16_t)0; } }
        __syncthreads();
        if (wv * 16 < nvalid) {
            f32x4 acc[8];
#pragma unroll
            for (int q = 0; q < 8; ++q) acc[q] = (f32x4){0.f, 0.f, 0.f, 0.f};
            const int nks = (wv + 2) >> 1;
            for (int ks = 0; ks < nks; ++ks) { const bf16x8 wf = *(const bf16x8*)(sguW + g * 16384 + (wv * 16 + (lane & 15)) * 128 + ks * 32 + 8 * (lane >> 4));
#pragma unroll
                for (int q = 0; q < 8; ++q) { const int dr = q * 16 + (lane & 15); const bf16x8 vf = *(const LAS bf16x8*)(vT + dr * 136 + swz(dr, ks * 32 + 8 * (lane >> 4))); acc[q] = mfma16(vf, wf, acc[q]); } }
            const int t = wv * 16 + (lane & 15);
            if (t < nvalid) { const float bias = p.in[I_SGUB][g * 128 + t];
#pragma unroll
                for (int q = 0; q < 8; ++q) { const int d0 = q * 16 + (lane >> 4) * 4; const u32x2 uw = *(const u32x2*)(H1 + (size_t)(row0 + t) * NH1 + g * 128 + d0);
                    const float u0 = geluf_(bf2f(uw.x & 0xffffu)), u1 = geluf_(__uint_as_float(uw.x & 0xffff0000u)), u2 = geluf_(bf2f(uw.y & 0xffffu)), u3 = geluf_(__uint_as_float(uw.y & 0xffff0000u));
                    u32x2 o; o.x = pk2(u0 * (acc[q][0] + bias), u1 * (acc[q][1] + bias)); o.y = pk2(u2 * (acc[q][2] + bias), u3 * (acc[q][3] + bias));
                    *(u32x2*)(MIX + (size_t)(row0 + t) * D + g * 128 + d0) = o; } } }
        __syncthreads();
    }
}

__device__ __forceinline__ void ssm_conv8(const CAS Params& p, const bf16_t* H1, int row0, int t, int col8, int sb, bool first, float (&o)[8]) {
    float a[8]; load8f(p.in[I_SSMCB] + col8, a);
    float xv[4][8], wk[4][8];
#pragma unroll
    for (int k = 0; k < 4; ++k) { const int tok = t - 3 + k; const int tokc = (tok < 0 && (first || sb >= 0)) ? 0 : tok;
        load8bf(H1 + (size_t)(row0 + tokc) * NH1 + 1536 + col8, xv[k]); load8f(p.in[I_SSMCW] + k * 1024 + col8, wk[k]); }
    if (sb >= 0) {
#pragma unroll
        for (int k = 0; k < 3; ++k) { const int tok = t - 3 + k; if (tok < 0) load8f(p.in[I_STSSMCONV] + (size_t)(sb * 3 + 3 + tok) * 1024 + col8, xv[k]); }
    } else if (first) {
#pragma unroll
        for (int k = 0; k < 3; ++k) { const bool hist = (t - 3 + k) < 0;
#pragma unroll
            for (int q = 0; q < 8; ++q) xv[k][q] = hist ? 0.f : xv[k][q]; }
    }
#pragma unroll
    for (int k = 0; k < 4; ++k)
#pragma unroll
        for (int q = 0; q < 8; ++q) a[q] += wk[k][q] * xv[k][q];
#pragma unroll
    for (int q = 0; q < 8; ++q) o[q] = siluf_(a[q]);
}
__device__ __forceinline__ void ssd_dt(int wid_s, const CAS Params& p, int row0, int nvalid, int g, LAS float* acum, LAS float* dtv, float* dec_out  ) {
    const int lane = lane_id_(), wv = wid_s, tid = wv * 64 + lane;
    if (wv < 4) { const int h = 4 * g + wv; const float* DT = (const float*)(p.ws + WS_DT);
        float dt = 0.f; if (lane < nvalid) dt = softplusf_(DT[(size_t)(row0 + lane) * 8 + h] + p.in[I_DTB][h]);
        const float a = -__expf(p.in[I_ALOG][h]); float v = dt * a;
#pragma unroll
        for (int o = 1; o < 64; o <<= 1) { const float t = __shfl_up(v, o); if (lane >= o) v += t; }
        acum[wv * 64 + lane] = v; dtv[wv * 64 + lane] = dt;
        if (dec_out != nullptr && lane == 63) dec_out[h] = __expf(v); }
}
__device__ __forceinline__ void ssd_chunk_geom(int ci, int& row0, int& nvalid, int& sb, bool& first) {
    if (ci < 256) { row0 = ci * 64; nvalid = 64; sb = -1; first = (ci & 127) == 0; } else { sb = ci - 256; row0 = MP + sb * 32; nvalid = 32; first = false; }
}
__device__ __forceinline__ void ssd_stepA(int wid_s, const CAS Params& p, LAS unsigned char* lds, int task) {
    const int lane = lane_id_(), wv = wid_s, tid = wv * 64 + lane;
    const int ci = task >> 1, g = task & 1; int row0, nvalid, sb; bool first; ssd_chunk_geom(ci, row0, nvalid, sb, first);
    const bf16_t* H1 = (const bf16_t*)(p.ws + WS_REGA);
    LAS bf16_t* xT = (LAS bf16_t*)lds; LAS bf16_t* BT = (LAS bf16_t*)(lds + 36864); LAS float* acum = (LAS float*)(lds + 55296); LAS float* dtv = (LAS float*)(lds + 56320);
    ssd_dt(wid_s, p, row0, nvalid, g, acum, dtv, (float*)(p.ws + WS_DEC) + ci * 8);
    float vv[6][8];
#pragma unroll
    for (int j = 0; j < 6; ++j) { const int blk = (tid >> 6) + 8 * j, t = (blk & 7) * 8 + (lane >> 3), cc = (blk >> 3) * 8 + (lane & 7);
        const int col = (cc < 32) ? 256 * g + cc * 8 : 512 + 128 * g + (cc - 32) * 8;
        if (t < nvalid) ssm_conv8(p, H1, row0, t, col, sb, first, vv[j]);
        else {
#pragma unroll
            for (int q = 0; q < 8; ++q) vv[j][q] = 0.f; } }
    __syncthreads();
#pragma unroll
    for (int j = 0; j < 6; ++j) { const int blk = (tid >> 6) + 8 * j, t = (blk & 7) * 8 + (lane >> 3), cc = (blk >> 3) * 8 + (lane & 7);
        if (cc < 32) { const int c8 = cc * 8, hh = c8 >> 6; const float te = __expf(acum[hh * 64 + 63] - acum[hh * 64 + t]) * dtv[hh * 64 + t];
#pragma unroll
            for (int q = 0; q < 8; ++q) xT[(c8 + q) * 72 + swz(c8 + q, t)] = (bf16_t)f2bf(vv[j][q] * te);
        } else { const int c8 = (cc - 32) * 8;
#pragma unroll
            for (int q = 0; q < 8; ++q) BT[(c8 + q) * 72 + swz(c8 + q, t)] = (bf16_t)f2bf(vv[j][q]); } }
    __syncthreads();
    f32x4 acc[2][8];
#pragma unroll
    for (int q = 0; q < 2; ++q)
#pragma unroll
        for (int nt = 0; nt < 8; ++nt) acc[q][nt] = (f32x4){0.f, 0.f, 0.f, 0.f};
#pragma unroll
    for (int ks = 0; ks < 2; ++ks) { bf16x8 xf[2];
#pragma unroll
        for (int q = 0; q < 2; ++q) { const int pr = (2 * wv + q) * 16 + (lane & 15); xf[q] = *(const LAS bf16x8*)(xT + pr * 72 + swz(pr, ks * 32 + 8 * (lane >> 4))); }
#pragma unroll
        for (int nt = 0; nt < 8; ++nt) { const int nr = nt * 16 + (lane & 15); const bf16x8 bf = *(const LAS bf16x8*)(BT + nr * 72 + swz(nr, ks * 32 + 8 * (lane >> 4)));
#pragma unroll
            for (int q = 0; q < 2; ++q) acc[q][nt] = mfma16(bf, xf[q], acc[q][nt]); } }
    float* Sb = (float*)(p.ws + WS_SSAMP) + (size_t)(sb >= 0 ? sb : 0) * 65536; bf16_t* Sb16 = (bf16_t*)(p.ws + WS_XB) + (size_t)ci * 65536;
#pragma unroll
    for (int q = 0; q < 2; ++q) { const int pall = (2 * wv + q) * 16 + (lane & 15), h = 4 * g + (pall >> 6), pp = pall & 63;
#pragma unroll
        for (int nt = 0; nt < 8; ++nt) { const size_t o = (size_t)(h * 64 + pp) * 128 + nt * 16 + (lane >> 4) * 4;
            if (sb >= 0) *(f32x4*)(Sb + o) = acc[q][nt];
            else { u32x2 w; w.x = pk2(acc[q][nt][0], acc[q][nt][1]); w.y = pk2(acc[q][nt][2], acc[q][nt][3]); *(u32x2*)(Sb16 + o) = w; } } }
    __syncthreads();
}
__device__ __forceinline__ void ssd_stepB(int wid_s, const CAS Params& p) {
    const size_t gtid = (size_t)blockIdx.x * 512 + TIDX, gstride = (size_t)gridDim.x * 512;
    const float* DEC = (const float*)(p.ws + WS_DEC);
    for (size_t e = gtid; e < 131072; e += gstride) { const int b = (int)(e >> 16), rem = (int)(e & 65535), h = rem >> 13;
        bf16_t* sp = (bf16_t*)(p.ws + WS_XB) + (size_t)b * 128 * 65536 + rem; float st = 0.f;
        for (int c0 = 0; c0 < 128; c0 += 8) { float s[8], dc[8];
#pragma unroll
            for (int i = 0; i < 8; ++i) { s[i] = bf2f((unsigned)sp[(size_t)(c0 + i) * 65536]); dc[i] = DEC[(b * 128 + c0 + i) * 8 + h]; }
#pragma unroll
            for (int i = 0; i < 8; ++i) { sp[(size_t)(c0 + i) * 65536] = (bf16_t)f2bf(st); st = st * dc[i] + s[i]; } }
        p.out[O_SSMP + e] = st; }
    const float* SS = (const float*)(p.ws + WS_SSAMP);
    for (size_t e = gtid; e < 524288; e += gstride) { const int sb = (int)(e >> 16), h = (int)(e & 65535) >> 13;
        p.out[O_SSMS + e] = p.in[I_STSSM][e] * DEC[(256 + sb) * 8 + h] + SS[e]; }
    const bf16_t* H1 = (const bf16_t*)(p.ws + WS_REGA);
    for (size_t e = gtid; e < 6144 + 24576; e += gstride) {
        if (e < 6144) { const int b = (int)e / 3072, j = ((int)e % 3072) >> 10, c = (int)e & 1023; p.out[O_SCP + e] = bf2f(H1[(size_t)(b * SEQ + SEQ - 3 + j) * NH1 + 1536 + c]); }
        else { const int e2 = (int)e - 6144, sb = e2 / 3072, j = (e2 % 3072) >> 10, c = e2 & 1023; p.out[O_SCS + e2] = bf2f(H1[(size_t)(MP + sb * 32 + 29 + j) * NH1 + 1536 + c]); } }
}
__device__ __forceinline__ void ssd_stepC(int wid_s, const CAS Params& p, LAS unsigned char* lds, int task) {
    const int lane = lane_id_(), wv = wid_s, tid = wv * 64 + lane;
    const int ci = task >> 1, g = task & 1; int row0, nvalid, sb; bool first; ssd_chunk_geom(ci, row0, nvalid, sb, first);
    const bf16_t* H1 = (const bf16_t*)(p.ws + WS_REGA); bf16_t* MIX = (bf16_t*)(p.ws + WS_MIX);
    LAS bf16_t* xT = (LAS bf16_t*)lds; LAS bf16_t* Bm = (LAS bf16_t*)(lds + 36864); LAS bf16_t* Cm = (LAS bf16_t*)(lds + 54272); LAS bf16_t* Mm = (LAS bf16_t*)(lds + 71680);
    LAS float* acum = (LAS float*)(lds + 108544); LAS float* dtv = (LAS float*)(lds + 109568); LAS float* ssq = (LAS float*)(lds + 110592);
    bf16x8 hfp[4][2];
#pragma unroll
    for (int ks = 0; ks < 4; ++ks)
#pragma unroll
        for (int q = 0; q < 2; ++q) { const int pall = (2 * wv + q) * 16 + (lane & 15), pp = pall & 63; const size_t o = (size_t)((4 * g + (wv >> 1)) * 64 + pp) * 128 + ks * 32 + 8 * (lane >> 4);
            if (sb >= 0) { float hv[8]; load8f(p.in[I_STSSM] + (size_t)sb * 65536 + o, hv); const u32x4 w = pack8(hv); hfp[ks][q] = __builtin_bit_cast(bf16x8, w); }
            else hfp[ks][q] = *(const bf16x8*)((const bf16_t*)(p.ws + WS_XB) + (size_t)ci * 65536 + o); }
    ssd_dt(wid_s, p, row0, nvalid, g, acum, dtv, nullptr);
    { float vv[8][8];
#pragma unroll
        for (int j = 0; j < 8; ++j) { const int blk = (tid >> 6) + 8 * j, t = (blk & 7) * 8 + (lane >> 3), cc = (blk >> 3) * 8 + (lane & 7);
            const int col = (cc < 32) ? 256 * g + cc * 8 : (cc < 48) ? 512 + 128 * g + (cc - 32) * 8 : 768 + 128 * g + (cc - 48) * 8;
            if (t < nvalid) ssm_conv8(p, H1, row0, t, col, sb, first, vv[j]);
            else {
#pragma unroll
                for (int q = 0; q < 8; ++q) vv[j][q] = 0.f; } }
#pragma unroll
        for (int j = 0; j < 8; ++j) { const int blk = (tid >> 6) + 8 * j, t = (blk & 7) * 8 + (lane >> 3), cc = (blk >> 3) * 8 + (lane & 7);
            if (cc < 32) {
#pragma unroll
                for (int q = 0; q < 8; ++q) xT[(cc * 8 + q) * 72 + swz(cc * 8 + q, t)] = (bf16_t)f2bf(vv[j][q]); }
            else if (cc < 48) *(LAS u32x4*)(Bm + t * 136 + (cc - 32) * 8) = pack8(vv[j]);
            else *(LAS u32x4*)(Cm + t * 136 + (cc - 48) * 8) = pack8(vv[j]); } }
    __syncthreads();
    { const int tt = wv >> 1;
#pragma unroll
        for (int q = 0; q < 2; ++q) { const int st = (wv & 1) * 2 + q; f32x4 acc = (f32x4){0.f, 0.f, 0.f, 0.f};
            if (st <= tt) {
#pragma unroll
                for (int ks = 0; ks < 4; ++ks) { const bf16x8 cf = *(const LAS bf16x8*)(Cm + (tt * 16 + (lane & 15)) * 136 + ks * 32 + 8 * (lane >> 4));
                    const bf16x8 bf = *(const LAS bf16x8*)(Bm + (st * 16 + (lane & 15)) * 136 + ks * 32 + 8 * (lane >> 4)); acc = mfma16(cf, bf, acc); } }
            const int s = st * 16 + (lane & 15);
#pragma unroll
            for (int hh = 0; hh < 4; ++hh) { const float as = acum[hh * 64 + s], ds = dtv[hh * 64 + s];
#pragma unroll
                for (int r = 0; r < 4; ++r) { const int t = tt * 16 + (lane >> 4) * 4 + r; const float val = (s <= t) ? acc[r] * __expf(acum[hh * 64 + t] - as) * ds : 0.f;
                    Mm[(hh * 64 + t) * 72 + s] = (bf16_t)f2bf(val); } } } }
    __syncthreads();
    const int hh = wv >> 1, h = 4 * g + hh;
    f32x4 yi[4][2], yo[4][2];
#pragma unroll
    for (int tt = 0; tt < 4; ++tt)
#pragma unroll
        for (int q = 0; q < 2; ++q) { yi[tt][q] = (f32x4){0.f, 0.f, 0.f, 0.f}; yo[tt][q] = (f32x4){0.f, 0.f, 0.f, 0.f}; }
#pragma unroll
    for (int ks = 0; ks < 2; ++ks) { bf16x8 xf[2];
#pragma unroll
        for (int q = 0; q < 2; ++q) { const int pr = (2 * wv + q) * 16 + (lane & 15); xf[q] = *(const LAS bf16x8*)(xT + pr * 72 + swz(pr, ks * 32 + 8 * (lane >> 4))); }
#pragma unroll
        for (int tt = 0; tt < 4; ++tt) { const bf16x8 mf = *(const LAS bf16x8*)(Mm + (hh * 64 + tt * 16 + (lane & 15)) * 72 + ks * 32 + 8 * (lane >> 4));
#pragma unroll
            for (int q = 0; q < 2; ++q) yi[tt][q] = mfma16(xf[q], mf, yi[tt][q]); } }
#pragma unroll
    for (int ks = 0; ks < 4; ++ks) {
#pragma unroll
        for (int tt = 0; tt < 4; ++tt) { const bf16x8 cf = *(const LAS bf16x8*)(Cm + (tt * 16 + (lane & 15)) * 136 + ks * 32 + 8 * (lane >> 4));
#pragma unroll
            for (int q = 0; q < 2; ++q) yo[tt][q] = mfma16(hfp[ks][q], cf, yo[tt][q]); } }
    const float dsk = p.in[I_SSMD][h];
#pragma unroll
    for (int tt = 0; tt < 4; ++tt) { const int t = tt * 16 + (lane & 15); const float ea = __expf(acum[hh * 64 + t]); float sq = 0.f;
#pragma unroll
        for (int q = 0; q < 2; ++q) { const int pall = (2 * wv + q) * 16 + (lane >> 4) * 4;
            const u32x2 zw = *(const u32x2*)(H1 + (size_t)(row0 + (t < nvalid ? t : nvalid - 1)) * NH1 + 1024 + 256 * g + pall);
            const float z0 = bf2f(zw.x & 0xffffu), z1 = __uint_as_float(zw.x & 0xffff0000u), z2 = bf2f(zw.y & 0xffffu), z3 = __uint_as_float(zw.y & 0xffff0000u);
            const float zz[4] = {z0, z1, z2, z3};
#pragma unroll
            for (int r = 0; r < 4; ++r) { const float xv = bf2f((unsigned)xT[(pall + r) * 72 + swz(pall + r, t)]); const float y = yi[tt][q][r] + ea * yo[tt][q][r] + dsk * xv; const float gv = y * siluf_(zz[r]); yi[tt][q][r] = gv; sq += gv * gv; } }
        sq += __shfl_xor(sq, 16); sq += __shfl_xor(sq, 32);
        if ((lane >> 4) == 0) ssq[t * 8 + wv] = sq; }
    __syncthreads();
#pragma unroll
    for (int tt = 0; tt < 4; ++tt) { const int t = tt * 16 + (lane & 15);
        const f32x4 s0 = *(const LAS f32x4*)(ssq + t * 8), s1 = *(const LAS f32x4*)(ssq + t * 8 + 4);
        const float tot = (s0[0] + s0[1]) + (s0[2] + s0[3]) + (s1[0] + s1[1]) + (s1[2] + s1[3]); const float rs = 1.f / sqrtf(tot * (1.f / 256.f) + 1e-5f);
        if (t < nvalid) {
#pragma unroll
            for (int q = 0; q < 2; ++q) { const int pall = (2 * wv + q) * 16 + (lane >> 4) * 4; const f32x4 nw = *(const f32x4*)(p.in[I_SSMNW] + 256 * g + pall);
                u32x2 o; o.x = pk2(yi[tt][q][0] * rs * nw[0], yi[tt][q][1] * rs * nw[1]); o.y = pk2(yi[tt][q][2] * rs * nw[2], yi[tt][q][3] * rs * nw[3]);
                *(u32x2*)(MIX + (size_t)(row0 + t) * D + 512 + 256 * g + pall) = o; } } }
    __syncthreads();
}

#define XB_TMO      128
#define XB_XCNT(j)  (256  + 64 * (j))
#define XB_XSUB(j)  (1280 + 64 * (j))
#define XB_XGEN(j)  (2304 + 64 * (j))
#define XB_TOP      3328
#define XB_TOPGEN   3392
#define XCD_BAR_WORDS 3456
#define XB_SPIN_CAP (1u << 18)

__device__ __forceinline__ unsigned xb_ld(unsigned* p)              { return __hip_atomic_load(p, __ATOMIC_RELAXED, __HIP_MEMORY_SCOPE_AGENT); }
__device__ __forceinline__ unsigned xb_add(unsigned* p, unsigned v) { return __hip_atomic_fetch_add(p, v, __ATOMIC_RELAXED, __HIP_MEMORY_SCOPE_AGENT); }
__device__ __forceinline__ unsigned xb_xcc_id() { return (unsigned)__builtin_amdgcn_s_getreg((3 << 11) | 20) & 0xFu; }
#define XB_SPIN(cond, bar) do { unsigned _sp = 0; while (cond) { __builtin_amdgcn_s_sleep(1); \
    if ((++_sp & 255u) == 0u) { if (xb_ld(&(bar)[XB_TMO])) break; if (_sp > XB_SPIN_CAP) { atomicAdd(&(bar)[XB_TMO], 1u); break; } } } } while (0)

struct XcdBarrier {
    unsigned* bar; unsigned x;
    volatile LAS unsigned* st;
};

__device__ __forceinline__ XcdBarrier xcd_barrier_post(int wid_s, unsigned* bar, volatile LAS unsigned* st) {
    XcdBarrier b; b.bar = bar; b.x = xb_xcc_id(); b.st = st;
    if (TIDX == 0) (void)xb_add(&bar[XB_XCNT(b.x)], 1u);
    return b;
}
__device__ __forceinline__ void xcd_barrier_complete(unsigned* bar, unsigned x, unsigned& nloc, unsigned& nx) {
    const unsigned G = gridDim.x * gridDim.y * gridDim.z;
    unsigned sum, cnt, mine, sp = 0u;
    for (;;) {
        sum = 0u; cnt = 0u; mine = 0u;
#pragma unroll
        for (unsigned j = 0; j < 16; ++j) { const unsigned c = xb_ld(&bar[XB_XCNT(j)]); sum += c; cnt += (c > 0u) ? 1u : 0u; mine = (j == x) ? c : mine; }
        if (sum == G) break;
        __builtin_amdgcn_s_sleep(1);
        if ((++sp & 255u) == 0u) { if (xb_ld(&bar[XB_TMO])) break; if (sp > XB_SPIN_CAP) { atomicAdd(&bar[XB_TMO], 1u); break; } }
    }
    nloc = mine > 0u ? mine : 1u; nx = cnt > 0u ? cnt : 1u;
}

__device__ __forceinline__ void xcd_barrier(int wid_s, const XcdBarrier& b) {
    asm volatile("s_waitcnt vmcnt(0)" ::: "memory");
    __syncthreads();
    if (TIDX == 0) {
        unsigned* bar = b.bar;
        __builtin_amdgcn_s_waitcnt(0);
        unsigned nloc = b.st[0], nx = b.st[1];
        if (nloc == 0u) { xcd_barrier_complete(bar, b.x, nloc, nx); b.st[0] = nloc; b.st[1] = nx; }
        const unsigned old = xb_add(&bar[XB_XSUB(b.x)], 1u);
        const unsigned gen = old / nloc;
        if (old + 1u == (gen + 1u) * nloc) {
            __builtin_amdgcn_fence(__ATOMIC_RELEASE, "agent");
            asm volatile("s_waitcnt vmcnt(0)" ::: "memory");
            const unsigned og = xb_add(&bar[XB_TOP], 1u);
            const unsigned tg = og / nx;
            if (og + 1u == (tg + 1u) * nx) xb_add(&bar[XB_TOPGEN], 1u);
            else XB_SPIN(xb_ld(&bar[XB_TOPGEN]) == tg, bar);
            __builtin_amdgcn_fence(__ATOMIC_ACQUIRE, "agent");
            xb_add(&bar[XB_XGEN(b.x)], 1u);
            asm volatile("s_waitcnt vmcnt(0)" ::: "memory");
        } else {
            XB_SPIN(xb_ld(&bar[XB_XGEN(b.x)]) == gen, bar);
            __builtin_amdgcn_fence(__ATOMIC_ACQUIRE, "agent");
            asm volatile("s_waitcnt vmcnt(0)" ::: "memory");
        }
    }
    __syncthreads();
}

__global__ void __launch_bounds__(512, 2) mega_fwd(Params p_unused) {
    extern __shared__ __attribute__((aligned(16))) unsigned char lds_raw[];
    LAS unsigned char* lds = (LAS unsigned char*)lds_raw;
    cg::grid_group grid = cg::this_grid();
    const int wid_s = __builtin_amdgcn_readfirstlane((int)(__builtin_amdgcn_workitem_id_x() >> 6));
    { LAS unsigned* z = (LAS unsigned*)(lds + 131072); if (TIDX < 128) z[TIDX] = 0u; }
    __syncthreads();
    XcdBarrier bar = xcd_barrier_post(wid_s, (unsigned*)(kargs().ws + WS_CTL) + 4096, (volatile LAS unsigned*)(lds + 131072 + 32));
#define SEAM() xcd_barrier(wid_s, bar)
#define WSP(off) (kargs().ws + (off))
#define XFP (kargs().out + O_Y)
    p0_prep<0>(wid_s, kargs(), lds);
    if (gridDim.x == 0x7fffffffu) grid.sync();
    SEAM();
    { pg8::EpiStore E{(bf16_t*)WSP(WS_REGA), NH0, -1, nullptr}; run_gemm(wid_s, lds, (const bf16_t*)WSP(WS_XB), (const bf16_t*)WSP(WS_WINE), MP, NH0, D, E);
      FinStore F{(bf16_t*)WSP(WS_REGA), NH0}; mini_gemm_tail<4>(wid_s, lds, (const bf16_t*)WSP(WS_XB), (const bf16_t*)WSP(WS_WINE), D, F); }
    { pg8::EpiStore E{(bf16_t*)WSP(WS_PB), D, -1, nullptr}; run_gemm(wid_s, lds, (const bf16_t*)WSP(WS_PLEB), (const bf16_t*)WSP(WS_WPLE), MP, D, 256, E);
      FinStore F{(bf16_t*)WSP(WS_PB), D}; mini_gemm_tail<2>(wid_s, lds, (const bf16_t*)WSP(WS_PLEB), (const bf16_t*)WSP(WS_WPLE), 256, F); }
    SEAM();
    for (int ti = blockIdx.x; ti < 256; ti += gridDim.x) even_mixer_tile(wid_s, kargs(), lds, ti);
    for (int tt = blockIdx.x; tt < 48; tt += gridDim.x) even_mixer_part(wid_s, kargs(), lds, 256 + (tt & 7), tt >> 3);
    p0_prep<1>(wid_s, kargs(), lds);
    { const CAS Params& p = kargs(); const size_t gtid = (size_t)blockIdx.x * 512 + TIDX, gstride = (size_t)gridDim.x * 512; bf16_t* PLEB = (bf16_t*)(p.ws + WS_PLEB);
      cvt_f32_bf16(p.in[I_PP] + (size_t)MP * 256, PLEB, (size_t)MP * 256 / 4, gtid, gstride);
      cvt_f32_bf16(p.in[I_PS] + (size_t)MSAMP * 256, PLEB + (size_t)MP * 256, (size_t)MSAMP * 256 / 4, gtid, gstride); }
    SEAM();
    { pg8::EpiRes3<1> E{nullptr, (const bf16_t*)WSP(WS_XB), (bf16_t*)WSP(WS_XB), ((float*)WSP(WS_STATS) + 0 * MT), ((float*)WSP(WS_STATS) + 1 * MT), nullptr, nullptr, nullptr, nullptr}; run_gemm(wid_s, lds, (const bf16_t*)WSP(WS_MIX), (const bf16_t*)WSP(WS_WOUTE), MP, D, D, E);
      FinRes F{1, nullptr, (const bf16_t*)WSP(WS_XB), (bf16_t*)WSP(WS_XB), ((float*)WSP(WS_STATS) + 0 * MT), ((float*)WSP(WS_STATS) + 1 * MT), nullptr, nullptr, nullptr, nullptr}; mini_gemm_tail<2>(wid_s, lds, (const bf16_t*)WSP(WS_MIX), (const bf16_t*)WSP(WS_WOUTE), D, F); }
    SEAM();
    { pg8::EpiSwiGLU2 E{(bf16_t*)WSP(WS_REGA), ((float*)WSP(WS_STATS) + 0 * MT), ((float*)WSP(WS_STATS) + 1 * MT), (const float*)WSP(WS_CS13), (const float*)WSP(WS_CB13)}; run_gemm(wid_s, lds, (const bf16_t*)WSP(WS_XB), (const bf16_t*)WSP(WS_W13), MT, 2 * FF, D, E); }
    SEAM();
    { pg8::EpiRes3<2> E{nullptr, (const bf16_t*)WSP(WS_XB), (bf16_t*)WSP(WS_XB), ((float*)WSP(WS_STATS) + 2 * MT), ((float*)WSP(WS_STATS) + 3 * MT), ((float*)WSP(WS_STATS) + 0 * MT), ((float*)WSP(WS_STATS) + 1 * MT), kargs().in[I_LN1G], kargs().in[I_LN1B]}; run_gemm(wid_s, lds, (const bf16_t*)WSP(WS_REGA), (const bf16_t*)WSP(WS_W2), MP, D, FF, E);
      FinRes F{2, nullptr, (const bf16_t*)WSP(WS_XB), (bf16_t*)WSP(WS_XB), ((float*)WSP(WS_STATS) + 2 * MT), ((float*)WSP(WS_STATS) + 3 * MT), ((float*)WSP(WS_STATS) + 0 * MT), ((float*)WSP(WS_STATS) + 1 * MT), kargs().in[I_LN1G], kargs().in[I_LN1B]}; mini_gemm_tail<2>(wid_s, lds, (const bf16_t*)WSP(WS_REGA), (const bf16_t*)WSP(WS_W2), FF, F); }
    SEAM();
    { pg8::EpiGate3<false> E{(const bf16_t*)WSP(WS_XB), (const bf16_t*)WSP(WS_PB), nullptr, (bf16_t*)WSP(WS_MIX), (bf16_t*)(kargs().out + O_Y), ((float*)WSP(WS_STATS) + 2 * MT), ((float*)WSP(WS_STATS) + 3 * MT), (const float*)WSP(WS_CSG), (const float*)WSP(WS_CBG), kargs().in[I_LN2G], kargs().in[I_LN2B]}; run_gemm(wid_s, lds, (const bf16_t*)WSP(WS_XB), (const bf16_t*)WSP(WS_WG), MP, D, D, E);
      FinGate F{false, E.xr, E.P, nullptr, E.ob1, E.ob2, E.ssum, E.ssq, E.cs, E.cb, E.g, E.b}; mini_gemm_tail<2>(wid_s, lds, (const bf16_t*)WSP(WS_XB), (const bf16_t*)WSP(WS_WG), D, F); }
    SEAM();
    { pg8::EpiStore E{(bf16_t*)WSP(WS_REGA), NH1, 10, (float*)WSP(WS_DT)}; run_gemm(wid_s, lds, (const bf16_t*)WSP(WS_MIX), (const bf16_t*)WSP(WS_WINO), MT, NINO, D, E); }
    SEAM();
    if (gridDim.x == 256) {
        const int b = blockIdx.x;
        if (b < 136) { sgu_block(wid_s, kargs(), lds, b); ssd_stepA(wid_s, kargs(), lds, b); }
        else { for (int t = b; t < 528; t += 120) ssd_stepA(wid_s, kargs(), lds, t); if (b >= 240) ssd_stepC(wid_s, kargs(), lds, 512 + (b - 240)); }
    } else {
        for (int t = blockIdx.x; t < 136 + 528 + 16; t += gridDim.x) { if (t < 136) sgu_block(wid_s, kargs(), lds, t); else if (t < 664) ssd_stepA(wid_s, kargs(), lds, t - 136); else ssd_stepC(wid_s, kargs(), lds, 512 + (t - 664)); }
    }
    SEAM();
    ssd_stepB(wid_s, kargs());
    SEAM();
    for (int t = blockIdx.x; t < 512; t += gridDim.x) ssd_stepC(wid_s, kargs(), lds, t);
    SEAM();
    { pg8::EpiRes3<1> E{nullptr, (const bf16_t*)(kargs().out + O_Y), (bf16_t*)WSP(WS_XB), ((float*)WSP(WS_STATS) + 4 * MT), ((float*)WSP(WS_STATS) + 5 * MT), nullptr, nullptr, nullptr, nullptr}; run_gemm(wid_s, lds, (const bf16_t*)WSP(WS_MIX), (const bf16_t*)WSP(WS_WOUTO), MP, D, D, E);
      FinRes F{1, nullptr, (const bf16_t*)(kargs().out + O_Y), (bf16_t*)WSP(WS_XB), ((float*)WSP(WS_STATS) + 4 * MT), ((float*)WSP(WS_STATS) + 5 * MT), nullptr, nullptr, nullptr, nullptr}; mini_gemm_tail<2>(wid_s, lds, (const bf16_t*)WSP(WS_MIX), (const bf16_t*)WSP(WS_WOUTO), D, F); }
    { pg8::EpiStore E{(bf16_t*)WSP(WS_PB), D, -1, nullptr}; run_gemm(wid_s, lds, (const bf16_t*)WSP(WS_PLEB), (const bf16_t*)WSP(WS_WPLE + WPLE_BYTES), MP, D, 256, E);
      FinStore F{(bf16_t*)WSP(WS_PB), D}; mini_gemm_tail<2>(wid_s, lds, (const bf16_t*)WSP(WS_PLEB), (const bf16_t*)WSP(WS_WPLE + WPLE_BYTES), 256, F); }
    SEAM();
    { pg8::EpiSwiGLU2 E{(bf16_t*)WSP(WS_REGA), ((float*)WSP(WS_STATS) + 4 * MT), ((float*)WSP(WS_STATS) + 5 * MT), (const float*)WSP(WS_CS13) + 5632, (const float*)WSP(WS_CB13) + 5632}; run_gemm(wid_s, lds, (const bf16_t*)WSP(WS_XB), (const bf16_t*)WSP(WS_W13 + W13_BYTES), MT, 2 * FF, D, E); }
    SEAM();
    { pg8::EpiRes3<2> E{nullptr, (const bf16_t*)WSP(WS_XB), (bf16_t*)WSP(WS_XB), ((float*)WSP(WS_STATS) + 6 * MT), ((float*)WSP(WS_STATS) + 7 * MT), ((float*)WSP(WS_STATS) + 4 * MT), ((float*)WSP(WS_STATS) + 5 * MT), kargs().in[I_LN1G] + D, kargs().in[I_LN1B] + D}; run_gemm(wid_s, lds, (const bf16_t*)WSP(WS_REGA), (const bf16_t*)WSP(WS_W2 + W2_BYTES), MP, D, FF, E);
      FinRes F{2, nullptr, (const bf16_t*)WSP(WS_XB), (bf16_t*)WSP(WS_XB), ((float*)WSP(WS_STATS) + 6 * MT), ((float*)WSP(WS_STATS) + 7 * MT), ((float*)WSP(WS_STATS) + 4 * MT), ((float*)WSP(WS_STATS) + 5 * MT), kargs().in[I_LN1G] + D, kargs().in[I_LN1B] + D}; mini_gemm_tail<2>(wid_s, lds, (const bf16_t*)WSP(WS_REGA), (const bf16_t*)WSP(WS_W2 + W2_BYTES), FF, F); }
    SEAM();
    { pg8::EpiGate3<true> E{(const bf16_t*)WSP(WS_XB), (const bf16_t*)WSP(WS_PB), XFP, nullptr, nullptr, ((float*)WSP(WS_STATS) + 6 * MT), ((float*)WSP(WS_STATS) + 7 * MT), (const float*)WSP(WS_CSG) + D, (const float*)WSP(WS_CBG) + D, kargs().in[I_LN2G] + D, kargs().in[I_LN2B] + D}; run_gemm(wid_s, lds, (const bf16_t*)WSP(WS_XB), (const bf16_t*)WSP(WS_WG + WG_BYTES), MP, D, D, E);
      FinGate F{true, E.xr, E.P, E.outf, nullptr, nullptr, E.ssum, E.ssq, E.cs, E.cb, E.g, E.b}; mini_gemm_tail<2>(wid_s, lds, (const bf16_t*)WSP(WS_XB), (const bf16_t*)WSP(WS_WG + WG_BYTES), D, F); }
}

extern "C" void kernel_launch(void* const* d_in, const int* in_sizes, int n_in, void* d_out, int out_size, void* d_ws, size_t ws_size, hipStream_t stream) {
    static int grid = 0;
    if (grid == 0) {
        if (n_in != 34 || ws_size < WS_END2) { fprintf(stderr, "kernel_launch: unexpected n_in %d or ws_size %zu (need %zu)\n", n_in, ws_size, (size_t)WS_END2); grid = -1; return; }
        int dev = 0, cus = 0, per_cu = 0;
        hipGetDevice(&dev); hipDeviceGetAttribute(&cus, hipDeviceAttributeMultiprocessorCount, dev);
        hipFuncSetAttribute((const void*)mega_fwd, hipFuncAttributeMaxDynamicSharedMemorySize, LDS_BYTES);
        hipOccupancyMaxActiveBlocksPerMultiprocessor(&per_cu, (const void*)mega_fwd, 512, LDS_BYTES);
        (void)hipGetLastError();
        if (per_cu < 1) per_cu = 1;
        grid = cus;
        fprintf(stderr, "kernel_launch: cus %d per_cu %d grid %d\n", cus, per_cu, grid);
    }
    if (grid < 0) return;
    if (hipMemsetAsync((char*)d_ws + WS_CTL, 0, WS_STATS, stream) != hipSuccess) { fprintf(stderr, "memset failed\n"); return; }
    Params prm{};
    for (int i = 0; i < 34; ++i) prm.in[i] = (const float*)d_in[i];
    prm.out = (float*)d_out; prm.ws = (unsigned char*)d_ws;
    void* args[] = {&prm};
    hipError_t e = hipLaunchCooperativeKernel((const void*)mega_fwd, dim3(grid), dim3(512), args, LDS_BYTES, stream);
    if (e != hipSuccess) fprintf(stderr, "cooperative launch failed: %s (grid %d)\n", hipGetErrorString(e), grid);
}
```
